# Optimizing an MI355X kernel written in HIP

```python
import math
import jax, jax.numpy as jnp
from jax import lax
import numpy as np

D_MODEL = 1024
BATCH = 8
SEQ = 4096
DEPTH = 2

MLA_HEADS = 4
QK_NOPE_DIM = 128
QK_ROPE_DIM = 64
V_HEAD_DIM = 128
Q_LORA_RANK = 384
KV_LORA_RANK = 256
CONV_CHANNELS = D_MODEL - MLA_HEADS * V_HEAD_DIM
CONV_WIDTH = 31
MLA_IN_DIM = Q_LORA_RANK + KV_LORA_RANK + QK_ROPE_DIM + 2 * CONV_CHANNELS
DIFF_HEAD_DIM = 128
DIFF_HEADS = D_MODEL // (2 * DIFF_HEAD_DIM)
DIFF_QKV_DIM = 3 * DIFF_HEADS * 2 * DIFF_HEAD_DIM
N_EXPERTS = 32
TOP_K = 4
D_EXPERT = D_MODEL
SWIGLU_LIMIT = 7.0
SWIGLU_ALPHA = 1.702
EXPERT_BLOCK = 256
ROPE_THETA = 10000.0
Q_BLOCK = 128
DN_ALPHA = (2 * DEPTH) ** 0.25
DN_BETA = (8 * DEPTH) ** -0.25
LN_EPS = 1e-5
RMS_EPS = 1e-6

kernel_name = 'hybrid_mla_conformer_diffattn_moe'


def layer_norm(x, g, b):
    xf = x.astype(jnp.float32)
    mu = jnp.mean(xf, -1, keepdims=True)
    var = jnp.mean(jnp.square(xf - mu), -1, keepdims=True)
    y = (xf - mu) * lax.rsqrt(var + LN_EPS)
    return (y * g.astype(jnp.float32) + b.astype(jnp.float32)).astype(x.dtype)


def rms_norm(x, g):
    xf = x.astype(jnp.float32)
    y = xf * lax.rsqrt(jnp.mean(jnp.square(xf), -1, keepdims=True) + RMS_EPS)
    return (y * g.astype(jnp.float32)).astype(x.dtype)


def apply_rope(x):
    seq, dim = x.shape[1], x.shape[-1]
    inv_freq = 1.0 / (ROPE_THETA ** (jnp.arange(0, dim, 2, dtype=jnp.float32) / dim))
    ang = jnp.arange(seq, dtype=jnp.float32)[:, None] * inv_freq[None, :]
    cos = jnp.cos(ang)[:, None, :]
    sin = jnp.sin(ang)[:, None, :]
    xf = x.astype(jnp.float32)
    x1, x2 = xf[..., : dim // 2], xf[..., dim // 2:]
    return jnp.concatenate([x1 * cos - x2 * sin, x2 * cos + x1 * sin], -1).astype(x.dtype)


def causal_multi_map_attention(q, k, v, coef, scale):
    b, h, m, s, dk = q.shape
    nb = s // Q_BLOCK
    q_blocks = jnp.moveaxis(q.reshape(b, h, m, nb, Q_BLOCK, dk), 3, 0)
    k_pos = jnp.arange(s)

    def one_block(args):
        q_blk, blk = args
        scores = jnp.einsum('bhmqd,bhmkd->bhmqk', q_blk, k).astype(jnp.float32) * scale
        q_pos = blk * Q_BLOCK + jnp.arange(Q_BLOCK)
        causal = k_pos[None, :] <= q_pos[:, None]
        probs = jax.nn.softmax(jnp.where(causal, scores, -1e30), axis=-1)
        weights = jnp.einsum('bhmqk,m->bhqk', probs, coef)
        return jnp.einsum('bhqk,bhkd->bhqd', weights.astype(v.dtype), v)

    out = lax.map(one_block, (q_blocks, jnp.arange(nb)))
    return jnp.moveaxis(out, 0, 2).reshape(b, h, s, v.shape[-1])


def mla_conv_mixer(h, w_in, q_norm_g, w_q_up, kv_norm_g, w_kv_up, conv_w, conv_b,
                   conv_ln_g, conv_ln_b, w_o):
    b, s, _ = h.shape
    proj = h @ w_in
    o1 = Q_LORA_RANK
    o2 = o1 + KV_LORA_RANK
    o3 = o2 + QK_ROPE_DIM
    q_lat, kv_lat, k_rope, conv_in = proj[..., :o1], proj[..., o1:o2], proj[..., o2:o3], proj[..., o3:]
    q = (rms_norm(q_lat, q_norm_g) @ w_q_up).reshape(b, s, MLA_HEADS, QK_NOPE_DIM + QK_ROPE_DIM)
    q = jnp.concatenate([q[..., :QK_NOPE_DIM], apply_rope(q[..., QK_NOPE_DIM:])], -1)
    kv = (rms_norm(kv_lat, kv_norm_g) @ w_kv_up).reshape(b, s, MLA_HEADS, QK_NOPE_DIM + V_HEAD_DIM)
    k_nope, v = kv[..., :QK_NOPE_DIM], kv[..., QK_NOPE_DIM:]
    k_rope = jnp.broadcast_to(apply_rope(k_rope[:, :, None, :]), (b, s, MLA_HEADS, QK_ROPE_DIM))
    k = jnp.concatenate([k_nope, k_rope], -1)
    attn = causal_multi_map_attention(
        q.transpose(0, 2, 1, 3)[:, :, None], k.transpose(0, 2, 1, 3)[:, :, None],
        v.transpose(0, 2, 1, 3), jnp.ones((1,), jnp.float32),
        (QK_NOPE_DIM + QK_ROPE_DIM) ** -0.5)
    attn = attn.transpose(0, 2, 1, 3).reshape(b, s, MLA_HEADS * V_HEAD_DIM)
    a, gate = conv_in[..., :CONV_CHANNELS], conv_in[..., CONV_CHANNELS:]
    u = a * jax.nn.sigmoid(gate)
    u = lax.conv_general_dilated(
        u, conv_w[:, None, :], window_strides=(1,), padding=[(CONV_WIDTH - 1, 0)],
        dimension_numbers=('NWC', 'WIO', 'NWC'), feature_group_count=CONV_CHANNELS) + conv_b
    u = jax.nn.silu(layer_norm(u, conv_ln_g, conv_ln_b))
    return jnp.concatenate([attn, u], -1) @ w_o


def diff_attn_mixer(h, w_qkv, lambda_q1, lambda_k1, lambda_q2, lambda_k2, subln_g, w_o, lambda_init):
    b, s, _ = h.shape
    qk_w = DIFF_HEADS * 2 * DIFF_HEAD_DIM
    proj = h @ w_qkv
    q = apply_rope(proj[..., :qk_w].reshape(b, s, 2 * DIFF_HEADS, DIFF_HEAD_DIM))
    k = apply_rope(proj[..., qk_w:2 * qk_w].reshape(b, s, 2 * DIFF_HEADS, DIFF_HEAD_DIM))
    v = proj[..., 2 * qk_w:].reshape(b, s, DIFF_HEADS, 2 * DIFF_HEAD_DIM)
    q = q.reshape(b, s, DIFF_HEADS, 2, DIFF_HEAD_DIM).transpose(0, 2, 3, 1, 4)
    k = k.reshape(b, s, DIFF_HEADS, 2, DIFF_HEAD_DIM).transpose(0, 2, 3, 1, 4)
    f32 = jnp.float32
    lam = (jnp.exp(jnp.sum(lambda_q1.astype(f32) * lambda_k1.astype(f32)))
           - jnp.exp(jnp.sum(lambda_q2.astype(f32) * lambda_k2.astype(f32))) + lambda_init)
    coef = jnp.stack([jnp.ones_like(lam), -lam])
    attn = causal_multi_map_attention(q, k, v.transpose(0, 2, 1, 3), coef, DIFF_HEAD_DIM ** -0.5)
    attn = rms_norm(attn, subln_g) * (1.0 - lambda_init)
    return attn.transpose(0, 2, 1, 3).reshape(b, s, DIFF_HEADS * 2 * DIFF_HEAD_DIM) @ w_o


def moe_ffn(h, router_w, router_b, w_gu, b_gu, w_dn, b_dn):
    b, s, d = h.shape
    t = b * s
    xf = h.reshape(t, d)
    logits = (xf @ router_w + router_b).astype(jnp.float32)
    top_val, top_idx = lax.top_k(logits, TOP_K)
    gates = jax.nn.softmax(top_val, axis=-1)
    n_assign = t * TOP_K
    flat_e = top_idx.reshape(-1)
    flat_g = gates.reshape(-1)
    flat_tok = jnp.arange(n_assign, dtype=jnp.int32) // TOP_K
    order = jnp.argsort(flat_e)
    se, stok, sg = flat_e[order], flat_tok[order], flat_g[order]
    counts = jnp.bincount(flat_e, length=N_EXPERTS)
    padded = ((counts + EXPERT_BLOCK - 1) // EXPERT_BLOCK) * EXPERT_BLOCK
    pend = jnp.cumsum(padded)
    pstart = pend - padded
    ustart = jnp.cumsum(counts) - counts
    dest = pstart[se] + jnp.arange(n_assign, dtype=jnp.int32) - ustart[se]
    n_rows = ((n_assign + EXPERT_BLOCK - 1) // EXPERT_BLOCK) * EXPERT_BLOCK + N_EXPERTS * EXPERT_BLOCK
    n_blk = n_rows // EXPERT_BLOCK
    row_tok = jnp.zeros((n_rows,), jnp.int32).at[dest].set(stok)
    row_gate = jnp.zeros((n_rows,), jnp.float32).at[dest].set(sg)
    blk_start = jnp.arange(n_blk, dtype=jnp.int32) * EXPERT_BLOCK
    blk_e = jnp.minimum(jnp.searchsorted(pend, blk_start, side='right'), N_EXPERTS - 1)

    def expert_block(args):
        tok, g, e = args
        hgu = xf[tok] @ w_gu[e] + b_gu[e]
        gate = jnp.minimum(hgu[:, :D_EXPERT], SWIGLU_LIMIT)
        up = jnp.clip(hgu[:, D_EXPERT:], -SWIGLU_LIMIT, SWIGLU_LIMIT)
        act = (up + 1.0) * gate * jax.nn.sigmoid(SWIGLU_ALPHA * gate)
        y = act @ w_dn[e] + b_dn[e]
        return y * g[:, None].astype(y.dtype)

    ys = lax.map(expert_block, (row_tok.reshape(n_blk, EXPERT_BLOCK),
                                row_gate.reshape(n_blk, EXPERT_BLOCK), blk_e))
    out = jnp.zeros((t, d), h.dtype).at[row_tok].add(ys.reshape(n_rows, d).astype(h.dtype))
    return out.reshape(b, s, d)


def setup_inputs(seed: int = 0) -> dict:
    key = jax.random.key(seed)
    keys = iter(jax.random.split(key, 64))

    def nrm(shape, scale):
        return jax.random.normal(next(keys), shape, jnp.float32) * scale

    def gain(n):
        return 1.0 + nrm((n,), 0.02)

    def bias(shape):
        return nrm(shape, 0.01)

    def add_moe(p, pre):
        p[pre + 'router_w'] = nrm((D_MODEL, N_EXPERTS), D_MODEL ** -0.5)
        p[pre + 'router_b'] = bias((N_EXPERTS,))
        p[pre + 'w_gu'] = nrm((N_EXPERTS, D_MODEL, 2 * D_EXPERT), D_MODEL ** -0.5)
        p[pre + 'b_gu'] = bias((N_EXPERTS, 2 * D_EXPERT))
        p[pre + 'w_dn'] = nrm((N_EXPERTS, D_EXPERT, D_MODEL), DN_BETA * D_EXPERT ** -0.5)
        p[pre + 'b_dn'] = bias((N_EXPERTS, D_MODEL))

    p = {'x': nrm((BATCH, SEQ, D_MODEL), 1.0)}
    p['l0_w_in'] = nrm((D_MODEL, MLA_IN_DIM), D_MODEL ** -0.5)
    p['l0_q_norm_g'] = gain(Q_LORA_RANK)
    p['l0_w_q_up'] = nrm((Q_LORA_RANK, MLA_HEADS * (QK_NOPE_DIM + QK_ROPE_DIM)), Q_LORA_RANK ** -0.5)
    p['l0_kv_norm_g'] = gain(KV_LORA_RANK)
    p['l0_w_kv_up'] = nrm((KV_LORA_RANK, MLA_HEADS * (QK_NOPE_DIM + V_HEAD_DIM)), KV_LORA_RANK ** -0.5)
    p['l0_conv_w'] = nrm((CONV_WIDTH, CONV_CHANNELS), CONV_WIDTH ** -0.5)
    p['l0_conv_b'] = bias((CONV_CHANNELS,))
    p['l0_conv_ln_g'] = gain(CONV_CHANNELS)
    p['l0_conv_ln_b'] = bias((CONV_CHANNELS,))
    p['l0_w_o'] = nrm((MLA_HEADS * V_HEAD_DIM + CONV_CHANNELS, D_MODEL), DN_BETA * D_MODEL ** -0.5)
    p['l0_ln1_g'] = gain(D_MODEL)
    p['l0_ln1_b'] = bias((D_MODEL,))
    add_moe(p, 'l0_')
    p['l0_ln2_g'] = gain(D_MODEL)
    p['l0_ln2_b'] = bias((D_MODEL,))
    p['l1_w_qkv'] = nrm((D_MODEL, DIFF_QKV_DIM), D_MODEL ** -0.5)
    p['l1_lambda_q1'] = nrm((DIFF_HEAD_DIM,), 0.1)
    p['l1_lambda_k1'] = nrm((DIFF_HEAD_DIM,), 0.1)
    p['l1_lambda_q2'] = nrm((DIFF_HEAD_DIM,), 0.1)
    p['l1_lambda_k2'] = nrm((DIFF_HEAD_DIM,), 0.1)
    p['l1_subln_g'] = gain(2 * DIFF_HEAD_DIM)
    p['l1_w_o'] = nrm((DIFF_HEADS * 2 * DIFF_HEAD_DIM, D_MODEL), DN_BETA * D_MODEL ** -0.5)
    p['l1_ln1_g'] = gain(D_MODEL)
    p['l1_ln1_b'] = bias((D_MODEL,))
    add_moe(p, 'l1_')
    p['l1_ln2_g'] = gain(D_MODEL)
    p['l1_ln2_b'] = bias((D_MODEL,))
    return p


def reference(x,
              l0_w_in, l0_q_norm_g, l0_w_q_up, l0_kv_norm_g, l0_w_kv_up, l0_conv_w, l0_conv_b,
              l0_conv_ln_g, l0_conv_ln_b, l0_w_o, l0_ln1_g, l0_ln1_b,
              l0_router_w, l0_router_b, l0_w_gu, l0_b_gu, l0_w_dn, l0_b_dn, l0_ln2_g, l0_ln2_b,
              l1_w_qkv, l1_lambda_q1, l1_lambda_k1, l1_lambda_q2, l1_lambda_k2, l1_subln_g, l1_w_o,
              l1_ln1_g, l1_ln1_b,
              l1_router_w, l1_router_b, l1_w_gu, l1_b_gu, l1_w_dn, l1_b_dn, l1_ln2_g, l1_ln2_b):
    layer_params = (
        ((l0_w_in, l0_q_norm_g, l0_w_q_up, l0_kv_norm_g, l0_w_kv_up, l0_conv_w, l0_conv_b,
          l0_conv_ln_g, l0_conv_ln_b, l0_w_o),
         (l0_ln1_g, l0_ln1_b),
         (l0_router_w, l0_router_b, l0_w_gu, l0_b_gu, l0_w_dn, l0_b_dn),
         (l0_ln2_g, l0_ln2_b)),
        ((l1_w_qkv, l1_lambda_q1, l1_lambda_k1, l1_lambda_q2, l1_lambda_k2, l1_subln_g, l1_w_o),
         (l1_ln1_g, l1_ln1_b),
         (l1_router_w, l1_router_b, l1_w_gu, l1_b_gu, l1_w_dn, l1_b_dn),
         (l1_ln2_g, l1_ln2_b)),
    )
    for i in range(DEPTH):
        mixer_p, ln1, moe_p, ln2 = layer_params[i]
        if i % 2 == 0:
            mix = mla_conv_mixer(x, *mixer_p)
        else:
            mix = diff_attn_mixer(x, *mixer_p, lambda_init=0.8 - 0.6 * math.exp(-0.3 * i))
        x = layer_norm(DN_ALPHA * x + mix, *ln1)
        x = layer_norm(DN_ALPHA * x + moe_ffn(x, *moe_p), *ln2)
    return x
```

```cpp
#include <hip/hip_runtime.h>
#include <cstdio>
#include <cstdint>
__device__ __forceinline__ int tid_opaque() { int t = threadIdx.x; asm volatile("" : "+v"(t)); return t; }
namespace pg8 {
#define PG8_LAS __attribute__((address_space(3)))
typedef unsigned short bf16_t;
typedef short bf16x8 __attribute__((ext_vector_type(8)));
typedef short bf16x16 __attribute__((ext_vector_type(16)));
typedef int v8i __attribute__((ext_vector_type(8)));
typedef int v4i __attribute__((ext_vector_type(4)));
typedef float f32x4 __attribute__((ext_vector_type(4)));
typedef unsigned u32x4 __attribute__((ext_vector_type(4)));
constexpr int BM = 256, BK = 64, HALF = 128, HTB = HALF * BK * 2  , STAGE_BYTES = 8 * HTB, NXCD = 8, WGM = 8;

__host__ __device__ __forceinline__ int lds_byte(int r, int c) { const int st = (r >> 4) * 2 + (c >> 5), rr = r & 15, cc = c & 31, ob = rr * 64 + cc * 2; return st * 1024 + (ob ^ (((ob >> 9) & 1) << 5)); }
__host__ __device__ __forceinline__ void stage_rc(int b, int& R, int& C) { const int st = b / 1024, sb = b % 1024, swz = sb ^ (((sb >> 9) & 1) << 5); R = (st >> 1) * 16 + swz / 64; C = (st & 1) * 32 + (swz % 64) / 2; }
__host__ __device__ __forceinline__ int perm32(int rho) { const int n = rho >> 4, i = rho & 15; return 8 * (i >> 2) + 4 * n + (i & 3); }

struct Unit { int pm, pn; };
struct Gemm { const bf16_t* A; const bf16_t* Bt; int M, N, K; };

struct StaticOrder {
    int nM, nN, nwg, G, c;
    __host__ __device__ void init(int M, int N, int G_, int c_) { nM = M / BM; nN = N / BM; nwg = nM * nN; G = G_; c = c_; }
    __host__ __device__ bool next(int i, Unit& u) const {
        const long L = (long)i * G + c; if (L >= nwg) return false;
        int wgid = (int)L; { const int q = nwg / NXCD, r = nwg % NXCD, xcd = wgid % NXCD, off = wgid / NXCD; wgid = (xcd < r ? xcd * (q + 1) : r * (q + 1) + (xcd - r) * q) + off; }
        const int nig = WGM * nN, gid = wgid / nig, fm = gid * WGM, gsz = (nM - fm) < WGM ? (nM - fm) : WGM;
        u.pm = fm + ((wgid % nig) % gsz); u.pn = (wgid % nig) / gsz; return true;
    }
    __device__ __forceinline__ void a_ready(const Unit&) const {}
    __device__ __forceinline__ void done(const Unit&) const {}
};

__device__ __forceinline__ unsigned cvt_pk_bf16(float lo, float hi) { unsigned r; asm volatile("v_cvt_pk_bf16_f32 %0, %1, %2" : "=v"(r) : "v"(lo), "v"(hi)); return r; }
typedef float f32x2 __attribute__((ext_vector_type(2)));
__device__ __forceinline__ u32x4 pack8_bf16(const f32x4 v0, const f32x4 v1) { u32x4 w; w.x = cvt_pk_bf16(v0[0], v0[1]); w.y = cvt_pk_bf16(v0[2], v0[3]); w.z = cvt_pk_bf16(v1[0], v1[1]); w.w = cvt_pk_bf16(v1[2], v1[3]); return w; }
constexpr int TB_STRIDE = 528, TB_BYTES = 32 * TB_STRIDE;
#define PG8_LBAR() asm volatile("s_waitcnt lgkmcnt(0)\n\ts_barrier" ::: "memory")
template <class RowFn>
__device__ __forceinline__ void tile_rows_step_at(PG8_LAS unsigned char* tb, int wr, int fr, int piece0, int dist, int wid, int lane, const u32x4 w0, const u32x4 w1, const RowFn& rowfn) {
    PG8_LAS unsigned char* wp = tb + (wr * 16 + fr) * TB_STRIDE + piece0;
    *(PG8_LAS u32x4*)wp = w0; *(PG8_LAS u32x4*)(wp + dist) = w1;
    PG8_LBAR();
#pragma unroll
    for (int j = 0; j < 2; ++j) { const int rl = 4 * wid + 2 * j + (lane >> 5), ch = lane & 31;
        const u32x4 d = *(const PG8_LAS u32x4*)(tb + rl * TB_STRIDE + ch * 16);
        rowfn(j, rl, ch, d); }
    PG8_LBAR();
}
template <class RowFn>
__device__ __forceinline__ void tile_rows_step(PG8_LAS unsigned char* tb, int wr, int wc, int fr, int fq, const u32x4 w0, const u32x4 w1, const RowFn& rowfn) {
    tile_rows_step_at(tb, wr, fr, wc * 64 + fq * 16, 256, wr * 4 + wc, fq * 16 + fr, w0, w1, rowfn);
}
__device__ __forceinline__ int tile_row(int pm, int ai, int m, int rl) { return pm * BM + ai * HALF + (rl >> 4) * 64 + m * 16 + (rl & 15); }
struct EpiBf16 {
    static constexpr bool PERM = true, AFTER_DRAIN = false, LDS_BIAS = false;
    bf16_t* O; int ldc; float sc;
    __device__ __forceinline__ void operator()(const f32x4 (&acc)[2][2][4][2], const Unit& u, int wr, int wc, int fr, int fq) const {
        const int row0 = u.pm * BM + wr * 64 + fr, col0 = u.pn * BM + wc * 32 + 8 * fq;
#pragma unroll
        for (int ai = 0; ai < 2; ++ai)
#pragma unroll
            for (int m = 0; m < 4; ++m) { bf16_t* rowp = O + (size_t)(row0 + ai * HALF + m * 16) * ldc + col0;
#pragma unroll
                for (int bj = 0; bj < 2; ++bj) *(u32x4*)(rowp + bj * HALF) = pack8_bf16(acc[ai][bj][m][0] * sc, acc[ai][bj][m][1] * sc); }
    }
};
struct EpiInProj {
    static constexpr bool PERM = true, AFTER_DRAIN = false, LDS_BIAS = false;
    bf16_t* proj; bf16_t* ug; float sc;
    __device__ __forceinline__ void operator()(const f32x4 (&acc)[2][2][4][2], const Unit& u, int wr, int wc, int fr, int fq) const {
        const int row0 = u.pm * BM + wr * 64 + fr;
        if (u.pn < 3) {
            const int col0 = u.pn * BM + wc * 32 + 8 * fq;
#pragma unroll
            for (int ai = 0; ai < 2; ++ai)
#pragma unroll
                for (int m = 0; m < 4; ++m) { bf16_t* rowp = proj + (size_t)(row0 + ai * HALF + m * 16) * 768 + col0;
#pragma unroll
                    for (int bj = 0; bj < 2; ++bj) *(u32x4*)(rowp + bj * HALF) = pack8_bf16(acc[ai][bj][m][0] * sc, acc[ai][bj][m][1] * sc); }
        } else {
            const int col0 = (u.pn - 3) * HALF + wc * 32 + 8 * fq; const float ks = -1.4426950408889634f * sc;
#pragma unroll
            for (int ai = 0; ai < 2; ++ai)
#pragma unroll
                for (int m = 0; m < 4; ++m) { f32x4 o[2];
#pragma unroll
                    for (int n = 0; n < 2; ++n)
#pragma unroll
                        for (int q = 0; q < 4; ++q) o[n][q] = acc[ai][0][m][n][q] * sc * __builtin_amdgcn_rcpf(1.0f + __builtin_amdgcn_exp2f(acc[ai][1][m][n][q] * ks));
                    *(u32x4*)(ug + (size_t)(row0 + ai * HALF + m * 16) * 512 + col0) = pack8_bf16(o[0], o[1]); }
        }
    }
};
struct EpiQKV {
    static constexpr bool PERM = true, AFTER_DRAIN = false, LDS_BIAS = false;
    bf16_t* O; const float* cs; const float* sn; float sc; PG8_LAS unsigned char* tb;
    __device__ __forceinline__ void operator()(const f32x4 (&acc)[2][2][4][2], const Unit& u, int wr, int wc, int fr, int fq) const {
        const int row0 = u.pm * BM + wr * 64 + fr, pm = u.pm; const float s_ = sc; PG8_LAS unsigned char* const tb_ = tb; const float* const cs_ = cs; const float* const sn_ = sn;
        if (u.pn < 8) {
            const int dim = (wc & 1) * 32 + 8 * fq; bf16_t* const Ot = O + u.pn * BM;
            const int wcx = (wc >> 1) * 4 + (wc & 1);
            f32x4 cq[3][4];
#define PG8_ROPE_LD(st) do { const int pos_ = (row0 + ((st) >> 2) * HALF + ((st) & 3) * 16) & 4095; const float* cp_ = cs_ + pos_ * 64 + dim; const float* sp_ = sn_ + pos_ * 64 + dim; \
                cq[(st) % 3][0] = *(const f32x4*)cp_; cq[(st) % 3][1] = *(const f32x4*)(cp_ + 4); cq[(st) % 3][2] = *(const f32x4*)sp_; cq[(st) % 3][3] = *(const f32x4*)(sp_ + 4); } while (0)
            PG8_ROPE_LD(0); PG8_ROPE_LD(1);
#pragma unroll
            for (int st = 0; st < 8; ++st) { const int ai = st >> 2, m = st & 3;
                if (st + 2 < 8) PG8_ROPE_LD(st + 2);
                const f32x4 c0 = cq[st % 3][0], c1 = cq[st % 3][1], s0 = cq[st % 3][2], s1 = cq[st % 3][3];
                const f32x4 a0 = acc[ai][0][m][0] * s_, a1 = acc[ai][0][m][1] * s_, b0 = acc[ai][1][m][0] * s_, b1 = acc[ai][1][m][1] * s_;
                bf16_t* rowp = O + (size_t)(row0 + ai * HALF + m * 16) * 3072 + (2 * u.pn + (wc >> 1)) * 128 + dim;
                *(u32x4*)rowp = pack8_bf16(a0 * c0 - b0 * s0, a1 * c1 - b1 * s1);
                *(u32x4*)(rowp + 64) = pack8_bf16(b0 * c0 + a0 * s0, b1 * c1 + a1 * s1); }
#undef PG8_ROPE_LD
        } else {
            const int col0 = u.pn * BM + wc * 32 + 8 * fq;
#pragma unroll
            for (int ai = 0; ai < 2; ++ai)
#pragma unroll
                for (int m = 0; m < 4; ++m) { bf16_t* rowp = O + (size_t)(row0 + ai * HALF + m * 16) * 3072 + col0;
#pragma unroll
                    for (int bj = 0; bj < 2; ++bj) *(u32x4*)(rowp + bj * HALF) = pack8_bf16(acc[ai][bj][m][0] * s_, acc[ai][bj][m][1] * s_); }
        }
    }
};
struct EpiResBf16 {
    static constexpr bool PERM = true, AFTER_DRAIN = false, LDS_BIAS = false;
    const bf16_t* res; bf16_t* vb; float alpha, sc;
    __device__ __forceinline__ void operator()(const f32x4 (&acc)[2][2][4][2], const Unit& u, int wr, int wc, int fr, int fq) const {
        const int row0 = u.pm * BM + wr * 64 + fr, col0 = u.pn * BM + wc * 32 + 8 * fq;
#pragma unroll
        for (int ai = 0; ai < 2; ++ai)
#pragma unroll
            for (int m = 0; m < 4; ++m) { const size_t off = (size_t)(row0 + ai * HALF + m * 16) * 1024 + col0;
#pragma unroll
                for (int bj = 0; bj < 2; ++bj) { const u32x4 r = *(const u32x4*)(res + off + bj * HALF);
                    f32x4 v0, v1;
                    v0[0] = __uint_as_float(r.x << 16); v0[1] = __uint_as_float(r.x & 0xffff0000u); v0[2] = __uint_as_float(r.y << 16); v0[3] = __uint_as_float(r.y & 0xffff0000u);
                    v1[0] = __uint_as_float(r.z << 16); v1[1] = __uint_as_float(r.z & 0xffff0000u); v1[2] = __uint_as_float(r.w << 16); v1[3] = __uint_as_float(r.w & 0xffff0000u);
                    *(u32x4*)(vb + off + bj * HALF) = pack8_bf16(v0 * alpha + acc[ai][bj][m][0] * sc, v1 * alpha + acc[ai][bj][m][1] * sc); } }
    }
};
struct EpiRouter {
    static constexpr bool PERM = false, AFTER_DRAIN = false, LDS_BIAS = false;
    float* lg; const float* bias;
    __device__ __forceinline__ void operator()(const f32x4 (&acc)[2][2][4][2], const Unit& u, int wr, int wc, int fr, int fq) const {
        if (wc != 0) return;
        const int row0 = u.pm * BM + wr * 64 + fr;
        const f32x4 b0 = *(const f32x4*)(bias + 4 * fq), b1 = *(const f32x4*)(bias + 16 + 4 * fq);
#pragma unroll
        for (int ai = 0; ai < 2; ++ai)
#pragma unroll
            for (int m = 0; m < 4; ++m) { float* p = lg + (size_t)(row0 + ai * HALF + m * 16) * 32 + 4 * fq;
                *(f32x4*)p = acc[ai][0][m][0] + b0; *(f32x4*)(p + 16) = acc[ai][0][m][1] + b1; }
    }
};
typedef unsigned u32x2 __attribute__((ext_vector_type(2)));
__device__ __forceinline__ float clamp448(float v) { return fminf(fmaxf(v, -448.0f), 448.0f); }
__device__ __forceinline__ unsigned pk4_fp8(float a, float b, float c, float d) { int w = __builtin_amdgcn_cvt_pk_fp8_f32(clamp448(a), clamp448(b), 0, false); w = __builtin_amdgcn_cvt_pk_fp8_f32(clamp448(c), clamp448(d), w, true); return (unsigned)w; }
struct EpiSwiGLU {
    static constexpr bool PERM = true, AFTER_DRAIN = false, LDS_BIAS = true;
    unsigned char* act; const float* bgu; float in_scale, out_scale; PG8_LAS float* bl;
    __device__ __forceinline__ const float* bias_src(const Unit& u, int lane) const { return bgu + (size_t)(u.pn >> 3) * 2048 + (lane >> 5) * 1024 + (u.pn & 7) * HALF + (lane & 31) * 4; }
    __device__ __forceinline__ void operator()(const f32x4 (&acc)[2][2][4][2], const Unit& u, int wr, int wc, int fr, int fq, int par) const {
        constexpr float C = 1.702f * 1.4426950408889634f;
        const int j = u.pn & 7, row0 = u.pm * BM + wr * 64 + fr, cw = j * HALF + wc * 32 + 8 * fq;
        const PG8_LAS float* bg = bl + par * 256 + wc * 32 + 8 * fq;
        const f32x4 bg0 = *(const PG8_LAS f32x4*)bg, bg1 = *(const PG8_LAS f32x4*)(bg + 4), bu0 = *(const PG8_LAS f32x4*)(bg + 128), bu1 = *(const PG8_LAS f32x4*)(bg + 132);
        const float k1 = -C * in_scale, K2 = -out_scale / C;
        f32x2 bgs[2][2], bu[2][2];
#pragma unroll
        for (int p = 0; p < 2; ++p) { bgs[0][p] = (f32x2){bg0[2 * p], bg0[2 * p + 1]} * -C; bgs[1][p] = (f32x2){bg1[2 * p], bg1[2 * p + 1]} * -C; bu[0][p] = (f32x2){bu0[2 * p], bu0[2 * p + 1]}; bu[1][p] = (f32x2){bu1[2 * p], bu1[2 * p + 1]}; }
#pragma unroll
        for (int ai = 0; ai < 2; ++ai)
#pragma unroll
            for (int m = 0; m < 4; ++m) {
                f32x2 g2[4], u2[4], d2[4], s2[4], a2[4];
#pragma unroll
                for (int i = 0; i < 4; ++i) { const int n = i >> 1, p = i & 1;
                    g2[i] = (f32x2){acc[ai][0][m][n][2 * p], acc[ai][0][m][n][2 * p + 1]} * k1 + bgs[n][p];
                    u2[i] = (f32x2){acc[ai][1][m][n][2 * p], acc[ai][1][m][n][2 * p + 1]} * in_scale + bu[n][p]; }
#pragma unroll
                for (int i = 0; i < 4; ++i) { g2[i].x = __builtin_amdgcn_fmed3f(g2[i].x, -7.0f * C, 30.0f); g2[i].y = __builtin_amdgcn_fmed3f(g2[i].y, -7.0f * C, 30.0f); }
#pragma unroll
                for (int i = 0; i < 4; ++i) d2[i] = (f32x2){__builtin_amdgcn_exp2f(g2[i].x), __builtin_amdgcn_exp2f(g2[i].y)};
#pragma unroll
                for (int i = 0; i < 4; ++i) { u2[i].x = __builtin_amdgcn_fmed3f(u2[i].x, -7.0f, 7.0f); u2[i].y = __builtin_amdgcn_fmed3f(u2[i].y, -7.0f, 7.0f); }
#pragma unroll
                for (int i = 0; i < 4; ++i) d2[i] = d2[i] + 1.0f;
#pragma unroll
                for (int i = 0; i < 4; ++i) a2[i] = (u2[i] * K2 + K2) * g2[i];
                { const f32x2 p01 = d2[0] * d2[1], p23 = d2[2] * d2[3], pp = p01 * p23; const f32x2 r = (f32x2){__builtin_amdgcn_rcpf(pp.x), __builtin_amdgcn_rcpf(pp.y)};
                  const f32x2 r01 = r * p23, r23 = r * p01;
                  s2[0] = r01 * d2[1]; s2[1] = r01 * d2[0]; s2[2] = r23 * d2[3]; s2[3] = r23 * d2[2]; }
#pragma unroll
                for (int i = 0; i < 4; ++i) a2[i] = a2[i] * s2[i];
                int w0 = __builtin_amdgcn_cvt_pk_fp8_f32(a2[0].x, a2[0].y, 0, false); w0 = __builtin_amdgcn_cvt_pk_fp8_f32(a2[1].x, a2[1].y, w0, true);
                int w1 = __builtin_amdgcn_cvt_pk_fp8_f32(a2[2].x, a2[2].y, 0, false); w1 = __builtin_amdgcn_cvt_pk_fp8_f32(a2[3].x, a2[3].y, w1, true);
                *(u32x2*)(act + (size_t)(row0 + ai * HALF + m * 16) * 1024 + cw) = (u32x2){(unsigned)w0, (unsigned)w1}; }
    }
};
struct EpiDown {
    static constexpr bool PERM = true, AFTER_DRAIN = false, LDS_BIAS = true;
    unsigned char* ys; const float* bdn; float in_scale, out_scale; PG8_LAS float* bl;
    __device__ __forceinline__ const float* bias_src(const Unit& u, int lane) const { return bdn + (size_t)(u.pn >> 2) * 1024 + (u.pn & 3) * BM + lane * 4; }
    __device__ __forceinline__ void operator()(const f32x4 (&acc)[2][2][4][2], const Unit& u, int wr, int wc, int fr, int fq, int par) const {
        const int row0 = u.pm * BM + wr * 64 + fr, col0 = (u.pn & 3) * BM + wc * 32 + 8 * fq;
        f32x4 bv[2][2];
#pragma unroll
        for (int bj = 0; bj < 2; ++bj)
#pragma unroll
            for (int n = 0; n < 2; ++n) bv[bj][n] = *(const PG8_LAS f32x4*)(bl + par * 256 + bj * HALF + wc * 32 + 8 * fq + 4 * n) * out_scale;
        const float sc = in_scale * out_scale;
#pragma unroll
        for (int ai = 0; ai < 2; ++ai)
#pragma unroll
            for (int m = 0; m < 4; ++m) { const int row = row0 + ai * HALF + m * 16;
#pragma unroll
                for (int bj = 0; bj < 2; ++bj) { const f32x4 a = acc[ai][bj][m][0] * sc + bv[bj][0], b = acc[ai][bj][m][1] * sc + bv[bj][1];
                    *(u32x2*)(ys + (size_t)row * 1024 + col0 + bj * HALF) = (u32x2){pk4_fp8(a[0], a[1], a[2], a[3]), pk4_fp8(b[0], b[1], b[2], b[3])}; } }
    }
};
struct MoeOrder {
    int nM, nN, nwg, G, c; const PG8_LAS int* blk_e;
    __device__ void init(int nblk, int nN_, int G_, int c_, const PG8_LAS int* be) { nM = nblk; nN = nN_; nwg = nM * nN; G = G_; c = c_; blk_e = be; }
    __device__ bool next(int i, Unit& u) const {
        const long L = (long)i * G + c; if (L >= nwg) return false;
        int wgid = (int)L; { const int q = nwg / NXCD, r = nwg % NXCD, xcd = wgid % NXCD, off = wgid / NXCD; wgid = (xcd < r ? xcd * (q + 1) : r * (q + 1) + (xcd - r) * q) + off; }
        const int nig = WGM * nN, gid = wgid / nig, fm = gid * WGM, gsz = (nM - fm) < WGM ? (nM - fm) : WGM;
        u.pm = fm + ((wgid % nig) % gsz); const int pl = (wgid % nig) / gsz; u.pn = blk_e[u.pm] * nN + pl; return true;
    }
    __device__ __forceinline__ void a_ready(const Unit&) const {}
    __device__ __forceinline__ void done(const Unit&) const {}
};
struct GatherA { const int* rowtok; PG8_LAS int* idx; int maxrow; const PG8_LAS int* tb; int estride;
    __device__ __forceinline__ const int* src(int pm) const { if (tb == nullptr) return rowtok + (size_t)pm * BM; const int e = tb[64 + pm]; return rowtok + (size_t)e * estride + (pm * BM - tb[e]); } };
template <class Epi, class Sched, bool ALIGN_EPI = false, bool SP2 = false, bool FP8 = false, bool GATH = false>
__device__ __forceinline__ void gemm_phase(PG8_LAS unsigned char* lds, const Gemm g, const Sched& S, const Epi& E, const GatherA ga = GatherA{nullptr, nullptr, 0, nullptr, 0}) {
    static_assert(!GATH || SP2, "gathered A rows: SP2 loop only");
    const int tid = tid_opaque(), wid = __builtin_amdgcn_readfirstlane(tid >> 6), lane = tid & 63, wr = wid >> 2, wc = wid & 3, fr = lane & 15, fq = lane >> 4;
    const int K = g.K, nt = K / BK;
    unsigned voffA[2], voffB[2];
#pragma unroll
    for (int i = 0; i < 2; ++i) { int R, C; stage_rc(tid * 16 + i * 8192, R, C); const int Rb = Epi::PERM ? ((R & ~31) + perm32(R & 31)) : R;
        voffA[i] = GATH ? (unsigned)(R * 65536 + C * 2) : (unsigned)(R * K + C) * 2u; voffB[i] = (unsigned)(Rb * K + C) * 2u; }
    const size_t kstep = (size_t)(BK * 2);
    const size_t hstep = (size_t)HALF * K * 2;
    const size_t tstep = 2 * hstep;
    const unsigned ldsw = (unsigned)wid * 1024u;
    const int aoff = lds_byte(wr * 64 + fr, fq * 8), boff = lds_byte(wc * 32 + fr, fq * 8);
#define PG8_SA(b, h) (((b) * 2 + (h)) * HTB)
#define PG8_SB(b, h) ((4 + (b) * 2 + (h)) * HTB)
#define PG8_STAGE(bufoff, gbase, voff) do { _Pragma("unroll") for (int _i = 0; _i < 2; ++_i) \
        __builtin_amdgcn_global_load_lds((const unsigned*)((const char*)(gbase) + (voff)[_i]), (PG8_LAS unsigned*)(lds + (bufoff) + ldsw + _i * 8192), 16, 0, 0); } while (0)
#define PG8_STAGE2(bufoff, gbase, o0, o1) do { \
        __builtin_amdgcn_global_load_lds((const unsigned*)((const char*)(gbase) + (o0)), (PG8_LAS unsigned*)(lds + (bufoff) + ldsw), 16, 0, 0); \
        __builtin_amdgcn_global_load_lds((const unsigned*)((const char*)(gbase) + (o1)), (PG8_LAS unsigned*)(lds + (bufoff) + ldsw + 8192), 16, 0, 0); } while (0)
#define PG8_STA(bufoff, bcont, bgath, o0, o1) do { if constexpr (GATH) PG8_STAGE2(bufoff, bgath, o0, o1); else PG8_STAGE(bufoff, bcont, voffA); } while (0)
#define PG8_GOFF(ix, d00, d01, d10, d11) do { const int r0_ = (int)(voffA[0] >> 16), r1_ = (int)(voffA[1] >> 16); const unsigned c0_ = voffA[0] & 0xffffu, c1_ = voffA[1] & 0xffffu; \
        const unsigned rb_ = (unsigned)K * 2u; const unsigned mx_ = (unsigned)ga.maxrow; \
        const unsigned t00_ = (unsigned)(ix)[r0_], t01_ = (unsigned)(ix)[r1_], t10_ = (unsigned)(ix)[128 + r0_], t11_ = (unsigned)(ix)[128 + r1_]; \
        d00 = (t00_ < mx_ ? t00_ : mx_) * rb_ + c0_; d01 = (t01_ < mx_ ? t01_ : mx_) * rb_ + c1_; d10 = (t10_ < mx_ ? t10_ : mx_) * rb_ + c0_; d11 = (t11_ < mx_ ? t11_ : mx_) * rb_ + c1_; } while (0)
#define PG8_LD8(p) __builtin_shufflevector(*(const PG8_LAS v4i*)(p), *(const PG8_LAS v4i*)((p) + 1024), 0, 1, 2, 3, 4, 5, 6, 7)
#define PG8_LDA(dst, b, h) do { if constexpr (FP8) { _Pragma("unroll") for (int m = 0; m < 4; ++m) dst##8[m] = PG8_LD8(lds + PG8_SA(b, h) + aoff + m * 2048); } \
        else { _Pragma("unroll") for (int m = 0; m < 4; ++m) _Pragma("unroll") for (int k = 0; k < 2; ++k) dst[m][k] = *(const PG8_LAS bf16x8*)(lds + PG8_SA(b, h) + aoff + m * 2048 + k * 1024); } } while (0)
#define PG8_LDB(dst, b, h) do { if constexpr (FP8) { _Pragma("unroll") for (int n = 0; n < 2; ++n) dst##8[n] = PG8_LD8(lds + PG8_SB(b, h) + boff + n * 2048); } \
        else { _Pragma("unroll") for (int n = 0; n < 2; ++n) _Pragma("unroll") for (int k = 0; k < 2; ++k) dst[n][k] = *(const PG8_LAS bf16x8*)(lds + PG8_SB(b, h) + boff + n * 2048 + k * 1024); } } while (0)
#define PG8_MMA(ai, bj, At, Bt) do { __builtin_amdgcn_s_setprio(1); if constexpr (FP8) { _Pragma("unroll") for (int m = 0; m < 4; ++m) _Pragma("unroll") for (int n = 0; n < 2; ++n) \
        asm volatile("v_mfma_f32_16x16x128_f8f6f4 %0, %1, %2, %0" : "+v"(acc[ai][bj][m][n]) : "v"(Bt##8[n]), "v"(At##8[m])); } \
    else { _Pragma("unroll") for (int m = 0; m < 4; ++m) _Pragma("unroll") for (int n = 0; n < 2; ++n) _Pragma("unroll") for (int k = 0; k < 2; ++k) \
        acc[ai][bj][m][n] = __builtin_amdgcn_mfma_f32_16x16x32_bf16(Bt[n][k], At[m][k], acc[ai][bj][m][n], 0, 0, 0); } __builtin_amdgcn_s_setprio(0); } while (0)
#define PG8_MMAZ(ai, bj, At, Bt, zf) do { if constexpr (FP8) { if (zf) { __builtin_amdgcn_s_setprio(1); _Pragma("unroll") for (int m = 0; m < 4; ++m) _Pragma("unroll") for (int n = 0; n < 2; ++n) \
        asm volatile("v_mfma_f32_16x16x128_f8f6f4 %0, %1, %2, 0" : "=v"(acc[ai][bj][m][n]) : "v"(Bt##8[n]), "v"(At##8[m])); __builtin_amdgcn_s_setprio(0); } else PG8_MMA(ai, bj, At, Bt); } \
    else PG8_MMA(ai, bj, At, Bt); } while (0)
#define PG8_WAIT_V(n) asm volatile("s_waitcnt vmcnt(" #n ")" ::: "memory")
#define PG8_WAIT_L(n) asm volatile("s_waitcnt lgkmcnt(" #n ")" ::: "memory")
#define PG8_BAR __builtin_amdgcn_s_barrier()
#define PG8_BAR_() __builtin_amdgcn_s_barrier()
#define PG8_SCHED __builtin_amdgcn_sched_barrier(0)
    Unit cur, nxt; int ui = 0;
    if (!S.next(0, cur)) return;
    f32x4 acc[2][2][4][2];
#pragma unroll
    for (int a = 0; a < 2; ++a)
#pragma unroll
        for (int b = 0; b < 2; ++b)
#pragma unroll
            for (int m = 0; m < 4; ++m)
#pragma unroll
                for (int n = 0; n < 2; ++n) { if constexpr (!(FP8 && SP2)) acc[a][b][m][n] = (f32x4){0.f, 0.f, 0.f, 0.f}; }
    bf16x8 At[4][2], B0[2][2], B1[2][2]; v8i At8[4], B08[2], B18[2];
    const char* cA = (const char*)g.A + (GATH ? (size_t)0 : (size_t)cur.pm * tstep); const char* cB = (const char*)g.Bt + (size_t)cur.pn * tstep;
    S.a_ready(cur);
    unsigned cv00 = 0, cv01 = 0, cv10 = 0, cv11 = 0, nv00 = 0, nv01 = 0, nv10 = 0, nv11 = 0;
    if constexpr (GATH) {
        if (wid == 0) __builtin_amdgcn_global_load_lds((const unsigned*)(ga.src(cur.pm) + lane * 4), (PG8_LAS unsigned*)ga.idx, 16, 0, 0);
        asm volatile("s_waitcnt vmcnt(0)" ::: "memory"); PG8_BAR_();
        PG8_GOFF(ga.idx, cv00, cv01, cv10, cv11);
    }
    if constexpr (SP2) {
        PG8_STAGE(PG8_SB(0, 0), cB, voffB); PG8_STAGE(PG8_SB(0, 1), cB + hstep, voffB); PG8_STA(PG8_SA(0, 0), cA, cA, cv00, cv01); PG8_STA(PG8_SA(0, 1), cA + hstep, cA, cv10, cv11);
        if (wr == 1) PG8_BAR;
        PG8_WAIT_V(2); PG8_BAR;
        PG8_STAGE(PG8_SB(1, 0), cB + kstep, voffB); PG8_STA(PG8_SA(1, 0), cA + kstep, cA + kstep, cv00, cv01); PG8_STAGE(PG8_SB(1, 1), cB + hstep + kstep, voffB);
        PG8_WAIT_V(6); PG8_BAR;
    } else {
        PG8_STAGE(PG8_SB(0, 0), cB, voffB); PG8_STAGE(PG8_SA(0, 0), cA, voffA); PG8_STAGE(PG8_SB(0, 1), cB + hstep, voffB); PG8_STAGE(PG8_SA(0, 1), cA + hstep, voffA);
        if (wr == 1) PG8_BAR;
        PG8_WAIT_V(4); PG8_BAR;
        PG8_STAGE(PG8_SB(1, 0), cB + kstep, voffB); PG8_STAGE(PG8_SA(1, 0), cA + kstep, voffA); PG8_STAGE(PG8_SB(1, 1), cB + hstep + kstep, voffB);
        PG8_WAIT_V(6); PG8_BAR;
    }
    for (;;) {
        const bool has_next = S.next(ui + 1, nxt);
        if constexpr (Epi::LDS_BIAS) { if (wid == 1) __builtin_amdgcn_global_load_lds((const unsigned*)E.bias_src(cur, lane), (PG8_LAS unsigned*)(E.bl + (ui & 1) * 256), 16, 0, 0); }
        const char* nA = (has_next && !GATH) ? (const char*)g.A + (size_t)nxt.pm * tstep : cA; const char* nB = has_next ? (const char*)g.Bt + (size_t)nxt.pn * tstep : cB;
        if constexpr (GATH) { if (has_next && wid == 0) __builtin_amdgcn_global_load_lds((const unsigned*)(ga.src(nxt.pm) + lane * 4), (PG8_LAS unsigned*)(ga.idx + ((ui + 1) & 1) * BM), 16, 0, 0); }
#pragma nounroll
        for (int t = 0; t < nt; t += 2) {
            const bool last = (t == nt - 2);
            const char* a1 = cA + (size_t)(t + 1) * kstep;
            const char* a2 = last ? nA : cA + (size_t)(t + 2) * kstep; const char* b2 = last ? nB : cB + (size_t)(t + 2) * kstep;
            const char* a3 = a2 + kstep; const char* b3 = b2 + kstep;
            if (last && has_next) S.a_ready(nxt);
            unsigned x00 = cv00, x01 = cv01, x10 = cv10, x11 = cv11;
            if constexpr (GATH) { if (last) { if (has_next) { PG8_GOFF(ga.idx + ((ui + 1) & 1) * BM, nv00, nv01, nv10, nv11); } else { nv00 = cv00; nv01 = cv01; nv10 = cv10; nv11 = cv11; }
                x00 = nv00; x01 = nv01; x10 = nv10; x11 = nv11; } }
            if constexpr (SP2) {
            PG8_LDB(B0, 0, 0); PG8_LDB(B1, 0, 1); PG8_SCHED; PG8_LDA(At, 0, 0); PG8_STA(PG8_SA(1, 1), a1 + hstep, a1, cv10, cv11);
            PG8_WAIT_V(8); PG8_WAIT_L(0); PG8_BAR; PG8_MMAZ(0, 0, At, B0, t == 0); PG8_MMAZ(0, 1, At, B1, t == 0); PG8_BAR; PG8_SCHED;
            PG8_LDA(At, 0, 1); PG8_STAGE(PG8_SB(0, 0), b2, voffB); PG8_STAGE(PG8_SB(0, 1), b2 + hstep, voffB); PG8_STA(PG8_SA(0, 0), a2, a2, x00, x01);
            PG8_WAIT_V(8); PG8_WAIT_L(0); PG8_BAR; PG8_MMAZ(1, 0, At, B0, t == 0); PG8_MMAZ(1, 1, At, B1, t == 0); PG8_BAR; PG8_SCHED;
            PG8_LDB(B0, 1, 0); PG8_LDB(B1, 1, 1); PG8_SCHED; PG8_LDA(At, 1, 0); PG8_STA(PG8_SA(0, 1), a2 + hstep, a2, x10, x11);
            PG8_WAIT_V(8); PG8_WAIT_L(0); PG8_BAR; PG8_MMA(0, 0, At, B0); PG8_MMA(0, 1, At, B1); PG8_BAR; PG8_SCHED;
            PG8_LDA(At, 1, 1); PG8_STAGE(PG8_SB(1, 0), b3, voffB); PG8_STAGE(PG8_SB(1, 1), b3 + hstep, voffB); PG8_STA(PG8_SA(1, 0), a3, a3, x00, x01);
            PG8_WAIT_V(8); PG8_WAIT_L(0); PG8_BAR; PG8_MMA(1, 0, At, B0); PG8_MMA(1, 1, At, B1); PG8_BAR; PG8_SCHED;
            } else {
            PG8_LDB(B0, 0, 0); PG8_SCHED; PG8_LDA(At, 0, 0); PG8_STAGE(PG8_SA(1, 1), a1 + hstep, voffA);
            PG8_WAIT_L(8); PG8_BAR; PG8_WAIT_L(0); PG8_MMA(0, 0, At, B0); PG8_BAR; PG8_SCHED;
            PG8_LDB(B1, 0, 1); PG8_STAGE(PG8_SB(0, 0), b2, voffB);
            PG8_BAR; PG8_WAIT_L(0); PG8_MMA(0, 1, At, B1); PG8_BAR;
            PG8_LDA(At, 0, 1); PG8_STAGE(PG8_SA(0, 0), a2, voffA);
            PG8_BAR; PG8_WAIT_L(0); PG8_MMA(1, 0, At, B0); PG8_BAR; PG8_SCHED;
            PG8_STAGE(PG8_SB(0, 1), b2 + hstep, voffB);
            PG8_WAIT_V(6); PG8_BAR; PG8_MMA(1, 1, At, B1); PG8_BAR;
            PG8_LDB(B0, 1, 0); PG8_SCHED; PG8_LDA(At, 1, 0); PG8_STAGE(PG8_SA(0, 1), a2 + hstep, voffA);
            PG8_WAIT_L(8); PG8_BAR; PG8_WAIT_L(0); PG8_MMA(0, 0, At, B0); PG8_BAR; PG8_SCHED;
            PG8_LDB(B1, 1, 1); PG8_STAGE(PG8_SB(1, 0), b3, voffB);
            PG8_BAR; PG8_WAIT_L(0); PG8_MMA(0, 1, At, B1); PG8_BAR;
            PG8_LDA(At, 1, 1); PG8_STAGE(PG8_SA(1, 0), a3, voffA);
            PG8_BAR; PG8_WAIT_L(0); PG8_MMA(1, 0, At, B0); PG8_BAR; PG8_SCHED;
            PG8_STAGE(PG8_SB(1, 1), b3 + hstep, voffB);
            PG8_WAIT_V(6); PG8_BAR; PG8_MMA(1, 1, At, B1); PG8_BAR;
            }
        }
        if constexpr (ALIGN_EPI) { if (wr == 0) PG8_BAR; }
        if constexpr (FP8) asm volatile("s_nop 15\n\ts_nop 15" ::: "memory");
        if constexpr (!Epi::AFTER_DRAIN) { if constexpr (Epi::LDS_BIAS) E(acc, cur, wr, wc, fr, fq, ui & 1); else E(acc, cur, wr, wc, fr, fq); S.done(cur); }
        if (!has_next) break;
#pragma unroll
        for (int a = 0; a < 2; ++a)
#pragma unroll
            for (int b = 0; b < 2; ++b)
#pragma unroll
                for (int m = 0; m < 4; ++m)
#pragma unroll
                    for (int n = 0; n < 2; ++n) { if constexpr (!(FP8 && SP2)) acc[a][b][m][n] = (f32x4){0.f, 0.f, 0.f, 0.f}; }
        cur = nxt; cA = nA; cB = nB; ++ui; cv00 = nv00; cv01 = nv01; cv10 = nv10; cv11 = nv11;
        if constexpr (ALIGN_EPI) { if (wr == 1) PG8_BAR; }
    }
    PG8_WAIT_V(0);
    if constexpr (!ALIGN_EPI) { if (wr == 0) PG8_BAR; }
    PG8_BAR;
    if constexpr (Epi::AFTER_DRAIN) { E.fused(acc, cur, wr, wc, fr, fq, lds, wid, lane); S.done(cur); }
#undef PG8_SA
#undef PG8_SB
#undef PG8_STAGE
#undef PG8_STAGE2
#undef PG8_STA
#undef PG8_GOFF
#undef PG8_BAR_
#undef PG8_LDA
#undef PG8_LDB
#undef PG8_MMA
#undef PG8_MMAZ
#undef PG8_LD8
#undef PG8_WAIT_V
#undef PG8_WAIT_L
#undef PG8_BAR
#undef PG8_SCHED
}
}
namespace att {
constexpr float O8_SCALE = 64.0f;
typedef short bf16x8 __attribute__((ext_vector_type(8)));
typedef short s16x4 __attribute__((ext_vector_type(4)));
typedef float f32x16 __attribute__((ext_vector_type(16)));
typedef float f32x4 __attribute__((ext_vector_type(4)));
typedef unsigned u32x4 __attribute__((ext_vector_type(4)));
typedef unsigned short bf16;
constexpr int NW = 8, QBLK = 32, KVBLK = 64, QB = NW * QBLK, DV = 128;
constexpr int SHM_V = KVBLK * DV * 2;
constexpr float THR = 8.f;
#define ATT_SBAR() __builtin_amdgcn_sched_barrier(0)
#define ATT_LD16(base, uoff, voff) (*reinterpret_cast<const bf16x8*>((const char*)(base) + (size_t)(uoff) + (voff)))
__device__ __forceinline__ int v_st(int k, int c) { const int kk = (k & ~0xC) | ((k & 4) << 1) | ((k & 8) >> 1); return ((kk >> 3) * 4 + (c >> 5)) * 512 + ((kk & 7) * 32 + (c & 31)) * 2; }
__device__ __forceinline__ int v_rd_base(int lane) { return ((lane & 3) << 3) | (((lane >> 2) & 3) << 6) | (((lane >> 4) & 1) << 5) | (((lane >> 5) & 1) << 8); }
constexpr int v_rd_off(int d0, int ks, int half) { return d0 * 512 + ks * 4096 + half * 2048; }
__device__ __forceinline__ int crow(int r, int hi) { return (r & 3) + 8 * (r >> 2) + 4 * hi; }
__device__ __forceinline__ unsigned cvtpk(float lo, float hi) { unsigned r; asm volatile("v_cvt_pk_bf16_f32 %0, %1, %2" : "=v"(r) : "v"(lo), "v"(hi)); return r; }
__device__ __forceinline__ bf16x8 pack8(f32x4 a, f32x4 b) { u32x4 w = {cvtpk(a[0], a[1]), cvtpk(a[2], a[3]), cvtpk(b[0], b[1]), cvtpk(b[2], b[3])}; return *reinterpret_cast<bf16x8*>(&w); }
__device__ __forceinline__ bf16x8 load8(const bf16* p) { return *reinterpret_cast<const bf16x8*>(p); }
__device__ __forceinline__ void mask_tile(f32x16& p0, f32x16& p1, int dq, unsigned W) {
    const float NEG = -__builtin_inff();
#pragma unroll
    for (int r = 0; r < 16; ++r) {
        const int c = (r & 3) + 8 * (r >> 2);
        if ((unsigned)(dq - c) >= W) p0[r] = NEG;
        if ((unsigned)(dq - c - 32) >= W) p1[r] = NEG;
    }
}
template <int SCALE_E6>
__device__ __forceinline__ void partialSM(f32x16& p0, f32x16& p1, float& m_reg, float& mn, float& alpha) {
    constexpr float SCALE = SCALE_E6 * 1e-6f;
    float pmax = p0[0]; for (int r = 1; r < 16; ++r) pmax = fmaxf(pmax, p0[r]); for (int r = 0; r < 16; ++r) pmax = fmaxf(pmax, p1[r]);
    { auto rr = __builtin_amdgcn_permlane32_swap(__float_as_uint(pmax), __float_as_uint(pmax), false, false);
      pmax = fmaxf(__uint_as_float(rr[0]), __uint_as_float(rr[1])); }
    constexpr float C2 = 1.4426950408889634f * SCALE;
    if (__builtin_expect(__all((pmax - m_reg) * SCALE <= THR), 1)) { mn = m_reg; alpha = 1.f; }
    else { mn = fmaxf(m_reg, pmax); alpha = __builtin_amdgcn_exp2f((m_reg - mn) * C2); m_reg = mn; }
    const float mnL = -mn * C2;
    for (int r = 0; r < 16; ++r) p0[r] = fmaf(p0[r], C2, mnL); for (int r = 0; r < 16; ++r) p1[r] = fmaf(p1[r], C2, mnL);
    for (int r = 0; r < 16; ++r) p0[r] = __builtin_amdgcn_exp2f(p0[r]);
}
__device__ __forceinline__ void finishSM(f32x16& p0, f32x16& p1, float alpha, float& l_reg, bf16x8& pa0, bf16x8& pa1, bf16x8& pa2, bf16x8& pa3) {
    for (int r = 0; r < 16; ++r) p1[r] = __builtin_amdgcn_exp2f(p1[r]);
    float ps = 0; for (int r = 0; r < 16; ++r) ps += p0[r]; for (int r = 0; r < 16; ++r) ps += p1[r];
    { auto rr = __builtin_amdgcn_permlane32_swap(__float_as_uint(ps), __float_as_uint(ps), false, false);
      ps = __uint_as_float(rr[0]) + __uint_as_float(rr[1]); }
    l_reg = l_reg * alpha + ps;
#define ATT_PK4(P, B_, OUT) do { unsigned a0 = cvtpk(P[B_+0], P[B_+1]), a1 = cvtpk(P[B_+2], P[B_+3]);                          \
        unsigned b0 = cvtpk(P[B_+4], P[B_+5]), b1 = cvtpk(P[B_+6], P[B_+7]);                                             \
        auto r0 = __builtin_amdgcn_permlane32_swap(a0, b0, false, false); auto r1 = __builtin_amdgcn_permlane32_swap(a1, b1, false, false); \
        u32x4 w = {r0[0], r1[0], r0[1], r1[1]}; OUT = *reinterpret_cast<bf16x8*>(&w); } while (0)
    ATT_PK4(p0, 0, pa0); ATT_PK4(p0, 8, pa1); ATT_PK4(p1, 0, pa2); ATT_PK4(p1, 8, pa3);
#undef ATT_PK4
}
template <int DK> __device__ __forceinline__ int kswz(int row, int colB) { return row * (DK * 2 + 16) + colB; }
template <int DK, int KB, int NREG>
__device__ __forceinline__ void qkt(f32x16& p0, f32x16& p1, const char* K_lds, int r32, int hi, const bf16x8* qr, const char* qx) {
    constexpr int KSTR = DK * 2 + 16, SHM_K = KVBLK * KSTR, NCH = DK / 16;
    p0 = f32x16{}; p1 = f32x16{};
    const char* kb = K_lds + KB * SHM_K + kswz<DK>(r32, hi * 16);
#pragma unroll
    for (int d0 = 0; d0 < NCH; ++d0) { const char* a = kb + d0 * 32;
        bf16x8 b0 = *reinterpret_cast<const bf16x8*>(a);
        bf16x8 b1 = *reinterpret_cast<const bf16x8*>(a + 32 * KSTR);
        const bf16x8 qv = d0 < NREG ? qr[d0] : *reinterpret_cast<const bf16x8*>(qx + (d0 - NREG) * 1024);
        p0 = __builtin_amdgcn_mfma_f32_32x32x16_bf16(b0, qv, p0, 0, 0, 0);
        p1 = __builtin_amdgcn_mfma_f32_32x32x16_bf16(b1, qv, p1, 0, 0, 0); }
}
template <int VB>
__device__ __forceinline__ void pv_tile(f32x16* o, int vb0, bf16x8 pa0, bf16x8 pa1, bf16x8 pa2, bf16x8 pa3) {
#define ATT_TRRD(dst, off) asm volatile("ds_read_b64_tr_b16 %0, %1 offset:%2" : "=&v"(dst) : "v"(vb0), "i"(off) : "memory")
#define ATT_PV_D0(d0) do { s16x4 l0, l1, l2, l3, h0, h1, h2, h3; constexpr int b_ = VB * SHM_V + v_rd_off(d0, 0, 0); \
        ATT_TRRD(l0, b_); ATT_TRRD(h0, b_ + 2048); ATT_TRRD(l1, b_ + 4096); ATT_TRRD(h1, b_ + 6144); ATT_TRRD(l2, b_ + 8192); ATT_TRRD(h2, b_ + 10240); ATT_TRRD(l3, b_ + 12288); ATT_TRRD(h3, b_ + 14336); \
        asm volatile("s_waitcnt lgkmcnt(0)" ::: "memory"); ATT_SBAR();   \
        o[d0] = __builtin_amdgcn_mfma_f32_32x32x16_bf16(pa0, (bf16x8){l0[0], l0[1], l0[2], l0[3], h0[0], h0[1], h0[2], h0[3]}, o[d0], 0, 0, 0);   \
        o[d0] = __builtin_amdgcn_mfma_f32_32x32x16_bf16(pa1, (bf16x8){l1[0], l1[1], l1[2], l1[3], h1[0], h1[1], h1[2], h1[3]}, o[d0], 0, 0, 0);   \
        o[d0] = __builtin_amdgcn_mfma_f32_32x32x16_bf16(pa2, (bf16x8){l2[0], l2[1], l2[2], l2[3], h2[0], h2[1], h2[2], h2[3]}, o[d0], 0, 0, 0);   \
        o[d0] = __builtin_amdgcn_mfma_f32_32x32x16_bf16(pa3, (bf16x8){l3[0], l3[1], l3[2], l3[3], h3[0], h3[1], h3[2], h3[3]}, o[d0], 0, 0, 0); } while (0)
    ATT_PV_D0(0); ATT_PV_D0(1); ATT_PV_D0(2); ATT_PV_D0(3);
#undef ATT_PV_D0
#undef ATT_TRRD
}
template <int DK_, int QS_, int KS_, int VS_, int OS_, int ROFF_, int RH_, int SCALE_E6_> struct Cfg {
    static constexpr int DK = DK_, QS = QS_, KS = KS_, VS = VS_, OS = OS_, ROFF = ROFF_, RH = RH_, SCALE_E6 = SCALE_E6_;
    static constexpr int NCH = DK / 16, KSTR = DK * 2 + 16, SHM_K = KVBLK * KSTR, NREG = DK > 128 ? 7 : NCH  , QX_OFF = 2 * SHM_V + 2 * SHM_K + NW * 64 * 4, QX_WAVE = (NCH - NREG) * 1024, LDS_BYTES = QX_OFF + NW * QX_WAVE;
    static constexpr bool HAS_KR = DK > 128;
};
struct BlockRef { const bf16* Q; const bf16* K; const bf16* KR; const bf16* V; bf16* O; int P0; };
template <int NCH> struct Seam { bf16x8 qr[NCH]; bf16x8 st_v0, st_v1, st_k0, st_k1, st_k2; };

__device__ __forceinline__ float bf_lo(unsigned w) { return __uint_as_float(w << 16); }
__device__ __forceinline__ float bf_hi(unsigned w) { return __uint_as_float(w & 0xffff0000u); }
template <class C> __device__ __forceinline__ void rope_q(bf16x8* qr, const float* cs, const float* sn, int pos, int hi) {
#pragma unroll
    for (int i = 0; i < C::RH; ++i) {
        const unsigned toff = (unsigned)(pos * (C::RH * 16) + hi * 8) * 4u;
#define ATT_LDF4(base, uoff) (*reinterpret_cast<const f32x4*>((const char*)(base) + (size_t)(uoff) + toff))
        const f32x4 c0 = ATT_LDF4(cs, i * 64), c1 = ATT_LDF4(cs, i * 64 + 16), s0 = ATT_LDF4(sn, i * 64), s1 = ATT_LDF4(sn, i * 64 + 16);
#undef ATT_LDF4
        const u32x4 a = *reinterpret_cast<const u32x4*>(&qr[C::ROFF + i]), b = *reinterpret_cast<const u32x4*>(&qr[C::ROFF + C::RH + i]);
        u32x4 ya, yb;
#pragma unroll
        for (int w = 0; w < 4; ++w) {
            const float cl = w < 2 ? c0[2 * w] : c1[2 * w - 4], ch = w < 2 ? c0[2 * w + 1] : c1[2 * w - 3];
            const float sl = w < 2 ? s0[2 * w] : s1[2 * w - 4], sh = w < 2 ? s0[2 * w + 1] : s1[2 * w - 3];
            const float x1l = bf_lo(a[w]), x1h = bf_hi(a[w]), x2l = bf_lo(b[w]), x2h = bf_hi(b[w]);
            ya[w] = cvtpk(x1l * cl - x2l * sl, x1h * ch - x2h * sh);
            yb[w] = cvtpk(x2l * cl + x1l * sl, x2h * ch + x1h * sh);
        }
        qr[C::ROFF + i] = *reinterpret_cast<bf16x8*>(&ya); qr[C::ROFF + C::RH + i] = *reinterpret_cast<bf16x8*>(&yb);
    }
}
#define ATT_VMW() asm volatile("s_waitcnt vmcnt(0)" ::: "memory")
#define ATT_VMWN(n) asm volatile("s_waitcnt vmcnt(%0)" :: "i"(n) : "memory")
#define ATT_SLOAD(R, k0) do { S.st_v0 = ATT_LD16((R).V, (size_t)(k0) * (C::VS * 2), kvoff); S.st_v1 = ATT_LD16((R).V, (size_t)((k0) + 32) * (C::VS * 2), kvoff);              \
                         S.st_k0 = ATT_LD16((R).K, (size_t)(k0) * (C::KS * 2), kvoff); S.st_k1 = ATT_LD16((R).K, (size_t)((k0) + 32) * (C::KS * 2), kvoff);              \
                         if constexpr (C::HAS_KR) S.st_k2 = ATT_LD16((R).KR, (size_t)(k0) * 128, kroff); } while (0)
#define ATT_SWRITE_K(bf) do { *(bf16x8*)(K_lds + (bf) * C::SHM_K + kws) = S.st_k0; *(bf16x8*)(K_lds + (bf) * C::SHM_K + kws + 32 * C::KSTR) = S.st_k1; \
                         if constexpr (C::HAS_KR) *(bf16x8*)(K_lds + (bf) * C::SHM_K + kws2) = S.st_k2; } while (0)
#define ATT_SWRITE_V(bf) do { *(bf16x8*)(V_lds + (bf) * SHM_V + vst0) = S.st_v0; *(bf16x8*)(V_lds + (bf) * SHM_V + vst1) = S.st_v1; } while (0)
#define ATT_SWRITE(bf) do { ATT_SWRITE_V(bf); ATT_SWRITE_K(bf); } while (0)
template <class C>
__device__ __forceinline__ void prime(const BlockRef& cur, char* lds, Seam<C::NCH>& S) {
    const int tid = tid_opaque(), wid = __builtin_amdgcn_readfirstlane(tid >> 6), lane = tid & 63, r32 = lane & 31, hi = lane >> 5;
    const int sr = tid >> 4, sc = (tid & 15) * 8, kws = kswz<C::DK>(sr, sc * 2); char* K_lds = lds;
    const int kr = tid >> 3, kc = (tid & 7) * 8, kws2 = kswz<C::DK>(kr, (128 + kc) * 2);
    static_assert(C::KS == C::VS, "K and V share one per-lane offset");
    const unsigned kvoff = (unsigned)(sr * C::KS + sc) * 2u, kroff = (unsigned)(kr * 64 + kc) * 2u;
    const unsigned qoff = (unsigned)((wid * QBLK + r32) * C::QS + hi * 8) * 2u;
#pragma unroll
    for (int d0 = 0; d0 < C::NCH; ++d0) S.qr[d0] = ATT_LD16(cur.Q, d0 * 32, qoff);
    ATT_SLOAD(cur, 0); ATT_VMW(); ATT_SWRITE_K(0);
    __syncthreads();
}
template <class C>
__device__ __forceinline__ void block(const BlockRef& cur, const BlockRef& nxt, char* lds, Seam<C::NCH>& S, const float* rcos, const float* rsin) {
    const int tid = tid_opaque(), wid = __builtin_amdgcn_readfirstlane(tid >> 6), lane = tid & 63, r32 = lane & 31, hi = lane >> 5;
    const int NT = (cur.P0 + QB) / KVBLK;
    const unsigned W = 1u << 30;
    const int qlo = cur.P0 + wid * QBLK, qm = qlo + r32 - 4 * hi;
    char* V_lds = lds + 2 * C::SHM_K; char* K_lds = lds;
    float* ws = (float*)(lds + 2 * SHM_V + 2 * C::SHM_K) + wid * 64; float* li_l = ws, * al_l = ws + 32;
    float m_reg = -1e30f, l_reg = 0; f32x16 o[4] = {};
    const int sr = tid >> 4, sc = (tid & 15) * 8, vst0 = v_st(sr, sc), vst1 = v_st(32 + sr, sc), kws = kswz<C::DK>(sr, sc * 2);
    const int kr = tid >> 3, kc = (tid & 7) * 8, kws2 = kswz<C::DK>(kr, (128 + kc) * 2);
    const unsigned kvoff = (unsigned)(sr * C::KS + sc) * 2u, kroff = (unsigned)(kr * 64 + kc) * 2u;
    const int vb0 = (int)(uintptr_t)V_lds + v_rd_base(lane);
    rope_q<C>(S.qr, rcos, rsin, qlo + r32, hi);
    char* qx = lds + C::QX_OFF + wid * C::QX_WAVE + lane * 16;
    if constexpr (C::NREG < C::NCH) {
#pragma unroll
        for (int i = 0; i < C::NCH - C::NREG; ++i) *reinterpret_cast<bf16x8*>(qx + i * 1024) = S.qr[C::NREG + i];
    }
#define ATT_RESC(a) do { if (__any((a) < 1.f)) { if (hi == 0) al_l[r32] = (a); asm volatile("s_waitcnt lgkmcnt(0)" ::: "memory");              \
                     for (int d_ = 0; d_ < 4; ++d_) for (int r = 0; r < 16; ++r) o[d_][r] *= al_l[crow(r, hi)]; } } while (0)
#define ATT_KBASE(t) ((t) * KVBLK)
#define ATT_MASKT(P0_, P1_, t) do { const int kb_ = ATT_KBASE(t); if (kb_ + KVBLK - 1 > qlo) mask_tile(P0_, P1_, qm - kb_, W); } while (0)
#define ATT_SEAM_K0() do { ATT_VMWN(C::NCH == 8 ? 8 : C::NCH - 8); ATT_SWRITE_K(0); ATT_SBAR(); } while (0)
    f32x16 pA0, pA1, pB0, pB1; float mnA, mnB, alA, alB; bf16x8 pa0, pa1, pa2, pa3;
    ATT_SWRITE_V(0); ATT_SBAR();
    if (NT > 1) { ATT_SLOAD(cur, ATT_KBASE(1)); }
    ATT_SBAR(); qkt<C::DK, 0, C::NREG>(pA0, pA1, K_lds, r32, hi, S.qr, qx);
    ATT_MASKT(pA0, pA1, 0); partialSM<C::SCALE_E6>(pA0, pA1, m_reg, mnA, alA);
    if (NT > 1) { ATT_VMW(); ATT_SWRITE(1); }
    __syncthreads();
#define ATT_HALF_STEP(PX0, PX1, mnX, alX, PY0, PY1, alY, t, KB, VB, SB) do {                                                      \
        ATT_SBAR(); qkt<C::DK, KB, C::NREG>(PX0, PX1, K_lds, r32, hi, S.qr, qx);                                             \
        finishSM(PY0, PY1, alY, l_reg, pa0, pa1, pa2, pa3); ATT_SBAR();                                                           \
        if ((t) + 1 < NT) { ATT_SLOAD(cur, ATT_KBASE((t) + 1)); ATT_SBAR(); }                                               \
        pv_tile<VB>(o, vb0, pa0, pa1, pa2, pa3); ATT_MASKT(PX0, PX1, (t)); partialSM<C::SCALE_E6>(PX0, PX1, m_reg, mnX, alX);                                        \
        __syncthreads();                                                                                                      \
        if ((t) + 1 < NT) { ATT_VMW(); ATT_SWRITE(SB); }                                                                          \
        ATT_RESC(alX); __syncthreads(); } while (0)
    for (int t = 1; t + 1 < NT; t += 2) {
        ATT_HALF_STEP(pB0, pB1, mnB, alB, pA0, pA1, alA, t, 1, 0, 0);
        ATT_HALF_STEP(pA0, pA1, mnA, alA, pB0, pB1, alB, t + 1, 0, 1, 1);
    }
    ATT_SBAR(); qkt<C::DK, 1, C::NREG>(pB0, pB1, K_lds, r32, hi, S.qr, qx); ATT_SBAR();
    const unsigned qoff = (unsigned)((wid * QBLK + r32) * C::QS + hi * 8) * 2u;
    if constexpr (C::NCH == 8) { ATT_SLOAD(nxt, 0); ATT_SBAR(); }
#pragma unroll
    for (int d0 = 0; d0 < 8; ++d0) S.qr[d0] = ATT_LD16(nxt.Q, d0 * 32, qoff);
    ATT_SBAR();
    finishSM(pA0, pA1, alA, l_reg, pa0, pa1, pa2, pa3); ATT_SBAR();
    if constexpr (C::NCH > 8) {
        ATT_SLOAD(nxt, 0); ATT_SBAR();
#pragma unroll
        for (int d0 = 8; d0 < C::NCH; ++d0) S.qr[d0] = ATT_LD16(nxt.Q, d0 * 32, qoff);
        ATT_SBAR(); }
    pv_tile<0>(o, vb0, pa0, pa1, pa2, pa3);
    ATT_MASKT(pB0, pB1, NT - 1); partialSM<C::SCALE_E6>(pB0, pB1, m_reg, mnB, alB); __syncthreads(); ATT_RESC(alB);
    finishSM(pB0, pB1, alB, l_reg, pa0, pa1, pa2, pa3); ATT_SBAR(); pv_tile<1>(o, vb0, pa0, pa1, pa2, pa3);
    ATT_SBAR(); ATT_SEAM_K0();
    if (hi == 0) li_l[r32] = l_reg; asm volatile("s_waitcnt lgkmcnt(0)" ::: "memory");
    float rli[16];
#pragma unroll
    for (int r = 0; r < 16; ++r) rli[r] = __builtin_amdgcn_rcpf(li_l[crow(r, hi)]);
    const unsigned ooff = (unsigned)((wid * QBLK + 4 * hi) * C::OS + r32);
#pragma unroll
    for (int r = 0; r < 16; ++r) {
#pragma unroll
        for (int d0 = 0; d0 < 4; ++d0) { const float v = fminf(fmaxf(o[d0][r] * rli[r] * O8_SCALE, -448.f), 448.f);
            *reinterpret_cast<unsigned char*>((char*)cur.O + (size_t)(((r & 3) + 8 * (r >> 2)) * C::OS + d0 * 32) + ooff) = (unsigned char)(__builtin_amdgcn_cvt_pk_fp8_f32(v, v, 0, false) & 0xff); } }
    __syncthreads();
#undef ATT_RESC
#undef ATT_KBASE
#undef ATT_MASKT
#undef ATT_SEAM_K0
#undef ATT_HALF_STEP
}
struct Item { int bh, qb0, qb1; };
template <class C, class RefFn>
__device__ __forceinline__ void phase(char* lds, int vcu, int G, int total  , const RefFn& ref, const float* rcos, const float* rsin) {
    int L = vcu; if (L >= total) return;
    Item it{L >> 3, L & 7, 15 - (L & 7)}; int pass = 0;
    BlockRef cur = ref(it.bh, it.qb0);
    Seam<C::NCH> S;
    prime<C>(cur, lds, S);
    for (;;) {
        const bool more_pass = pass == 0, more_item = L + G < total, last = !more_pass && !more_item;
        Item itn = it; int passn = pass + 1, Ln = L;
        if (!more_pass) { passn = 0; Ln = more_item ? L + G : L; itn = Item{Ln >> 3, Ln & 7, 15 - (Ln & 7)}; }
        const BlockRef nxt = last ? cur : ref(itn.bh, passn ? itn.qb1 : itn.qb0);
        block<C>(cur, nxt, lds, S, rcos, rsin);
        if (last) break;
        cur = nxt; it = itn; pass = passn; L = Ln;
    }
}
}
namespace att2 {
using att::bf16x8; using att::s16x4; using att::f32x16; using att::f32x4; using att::u32x4; using att::bf16;
using att::v_st; using att::v_rd_base; using att::crow; using att::cvtpk; using att::mask_tile;
constexpr int KVBLK = 64, QB = 128, SHM_V = 64 * 128 * 2  , DK = 128, KSTR = DK * 2 + 16, SHM_K = KVBLK * KSTR;
constexpr int OFF_K = 0, OFF_V0 = 2 * SHM_K, OFF_V1 = OFF_V0 + 2 * SHM_V, OFF_WS = OFF_V1 + 2 * SHM_V, OFF_P = OFF_WS + 2048, LDS_BYTES = OFF_P + 4 * 4096;
constexpr int QS = 3072, KS = 3072, VS = 3072, OS = 2048, RH = 4, SCALE_E6 = 88388;
struct BlockRef { const bf16* Q; const bf16* K; const bf16* V; bf16* O; int P0; };
struct Seam { bf16x8 q0, q1, q2, q3, q4, q5, q6, q7; bf16x8 st0, st1, st2, st3; };
#define A2_SBAR() __builtin_amdgcn_sched_barrier(0)
#define A2_SG(mask, n) __builtin_amdgcn_sched_group_barrier(mask, n, 0)
#define A2_QK_G1() do { A2_SG(0x008, 2); A2_SG(0x100, 2); A2_SG(0x002, 24); } while (0)
#define A2_QK_G2() do { A2_SG(0x008, 2); A2_SG(0x002, 24); } while (0)
#define A2_QK_SCHED() do { A2_SG(0x100, 6); A2_QK_G1(); A2_QK_G1(); A2_QK_G1(); A2_QK_G1(); A2_QK_G1(); A2_QK_G2(); A2_QK_G2(); A2_QK_G2(); } while (0)
#define A2_LD16(base, uoff, voff) (*reinterpret_cast<const bf16x8*>((const char*)(base) + (size_t)(uoff) + (voff)))
#define A2_QLOAD(R) do { S.q0 = A2_LD16((R).Q, 0, qoff); S.q1 = A2_LD16((R).Q, 32, qoff); S.q2 = A2_LD16((R).Q, 64, qoff); S.q3 = A2_LD16((R).Q, 96, qoff); \
        S.q4 = A2_LD16((R).Q, 128, qoff); S.q5 = A2_LD16((R).Q, 160, qoff); S.q6 = A2_LD16((R).Q, 192, qoff); S.q7 = A2_LD16((R).Q, 224, qoff); } while (0)
#define A2_VMW() asm volatile("s_waitcnt vmcnt(0)" ::: "memory")
#define A2_VMWN(n) asm volatile("s_waitcnt vmcnt(%0)" :: "i"(n) : "memory")
#define A2_MIDBAR() asm volatile("s_waitcnt lgkmcnt(0)\n\ts_barrier" ::: "memory")
#define A2_SLOAD_K(R, k0) do { S.st0 = A2_LD16((R).K, (size_t)(k0) * (KS * 2), koff); S.st1 = A2_LD16((R).K, (size_t)((k0) + 16) * (KS * 2), koff); S.st2 = A2_LD16((R).K, (size_t)((k0) + 32) * (KS * 2), koff); S.st3 = A2_LD16((R).K, (size_t)((k0) + 48) * (KS * 2), koff); } while (0)
#define A2_SLOAD_V(R, k0) do { S.st0 = A2_LD16((R).V, (size_t)(k0) * (VS * 2), voff); S.q0 = A2_LD16((R).V, (size_t)(k0) * (VS * 2) + 256, voff); \
        S.st1 = A2_LD16((R).V, (size_t)((k0) + 16) * (VS * 2), voff); S.q1 = A2_LD16((R).V, (size_t)((k0) + 16) * (VS * 2) + 256, voff); \
        S.st2 = A2_LD16((R).V, (size_t)((k0) + 32) * (VS * 2), voff); S.q2 = A2_LD16((R).V, (size_t)((k0) + 32) * (VS * 2) + 256, voff); \
        S.st3 = A2_LD16((R).V, (size_t)((k0) + 48) * (VS * 2), voff); S.q3 = A2_LD16((R).V, (size_t)((k0) + 48) * (VS * 2) + 256, voff); } while (0)
#define A2_SLOAD_KQ(R, k0) do { S.q4 = A2_LD16((R).K, (size_t)(k0) * (KS * 2), koff); S.q5 = A2_LD16((R).K, (size_t)((k0) + 16) * (KS * 2), koff); S.q6 = A2_LD16((R).K, (size_t)((k0) + 32) * (KS * 2), koff); S.q7 = A2_LD16((R).K, (size_t)((k0) + 48) * (KS * 2), koff); } while (0)
#define A2_SWRITE_KQ(bf) do { char* kp_ = lds + OFF_K + (bf) * SHM_K + kws; *(bf16x8*)(kp_) = S.q4; *(bf16x8*)(kp_ + 16 * KSTR) = S.q5; *(bf16x8*)(kp_ + 32 * KSTR) = S.q6; *(bf16x8*)(kp_ + 48 * KSTR) = S.q7; } while (0)
#define A2_SWRITE_K(bf) do { char* kp_ = lds + OFF_K + (bf) * SHM_K + kws; *(bf16x8*)(kp_) = S.st0; *(bf16x8*)(kp_ + 16 * KSTR) = S.st1; *(bf16x8*)(kp_ + 32 * KSTR) = S.st2; *(bf16x8*)(kp_ + 48 * KSTR) = S.st3; } while (0)
#define A2_SWRITE_V(bf) do { char* v0_ = lds + OFF_V0 + (bf) * SHM_V; char* v1_ = lds + OFF_V1 + (bf) * SHM_V; \
        *(bf16x8*)(v0_ + vst0) = S.st0; *(bf16x8*)(v1_ + vst0) = S.q0; *(bf16x8*)(v0_ + vst1) = S.st1; *(bf16x8*)(v1_ + vst1) = S.q1; \
        *(bf16x8*)(v0_ + vst2) = S.st2; *(bf16x8*)(v1_ + vst2) = S.q2; *(bf16x8*)(v0_ + vst3) = S.st3; *(bf16x8*)(v1_ + vst3) = S.q3; } while (0)
template <int KB> __device__ __forceinline__ void qkt(f32x16& p0, f32x16& p1, const char* lds, int r32, int hi, const Seam& S) {
    const bf16x8 qr[8] = {S.q0, S.q1, S.q2, S.q3, S.q4, S.q5, S.q6, S.q7};
    p0 = f32x16{}; p1 = f32x16{};
    const char* kb = lds + OFF_K + KB * SHM_K + r32 * KSTR + hi * 16;
    bf16x8 ka[3], kc[3];
#pragma unroll
    for (int d0 = 0; d0 < 3; ++d0) { ka[d0] = *reinterpret_cast<const bf16x8*>(kb + d0 * 32); kc[d0] = *reinterpret_cast<const bf16x8*>(kb + d0 * 32 + 32 * KSTR); }
#pragma unroll
    for (int d0 = 0; d0 < 8; ++d0) {
        p0 = __builtin_amdgcn_mfma_f32_32x32x16_bf16(ka[d0 % 3], qr[d0], p0, 0, 0, 0);
        p1 = __builtin_amdgcn_mfma_f32_32x32x16_bf16(kc[d0 % 3], qr[d0], p1, 0, 0, 0);
        if (d0 + 3 < 8) { ka[d0 % 3] = *reinterpret_cast<const bf16x8*>(kb + (d0 + 3) * 32); kc[d0 % 3] = *reinterpret_cast<const bf16x8*>(kb + (d0 + 3) * 32 + 32 * KSTR); } }
}
typedef att::Cfg<128, QS, KS, VS, OS, 0, RH, SCALE_E6> RopeCfg;
constexpr int OFF_CV = LDS_BYTES, CV_WAVE = 64 * 33 * 4, LDS_BYTES_CV = OFF_CV + 4 * CV_WAVE;
constexpr int CV_ITEMS = 32768 + 16384;
struct Conv { const float* wgu; const float* wdn; unsigned char* dgu; unsigned char* ddn; int it, stride, tick, pend;
    float c0, c1, c2, c3, c4, c5, c6, c7, c8, c9, c10, c11, c12, c13, c14, c15, c16, c17, c18, c19, c20, c21, c22, c23, c24, c25, c26, c27, c28, c29, c30, c31; };
struct CvItem { const float* W; unsigned char* WT; int N, k0, n0, dst; float scale; };
__device__ __forceinline__ CvItem cv_decode(const Conv& C) {
    CvItem I; const int it = C.it;
    if (it < 32768) { const int e = it >> 10, r = it & 1023, kb = r >> 6, nb = r & 63, n0 = 32 * nb, up = n0 >= 1024, nn = n0 & 1023;
        I.W = C.wgu + (size_t)e * 1024 * 2048; I.WT = C.dgu + (size_t)e * 2048 * 1024; I.N = 2048; I.k0 = 64 * kb; I.n0 = n0; I.dst = 256 * (nn >> 7) + 128 * up + (nn & 127); I.scale = 256.0f; }
    else { const int j = it - 32768, e = j >> 9, r = j & 511, kb = r >> 5, nb = r & 31;
        I.W = C.wdn + (size_t)e * 1024 * 1024; I.WT = C.ddn + (size_t)e * 1024 * 1024; I.N = 1024; I.k0 = 64 * kb; I.n0 = 32 * nb; I.dst = 32 * nb; I.scale = 512.0f; }
    return I;
}
#define A2_CV_ALL(M) M(0) M(1) M(2) M(3) M(4) M(5) M(6) M(7) M(8) M(9) M(10) M(11) M(12) M(13) M(14) M(15) M(16) M(17) M(18) M(19) M(20) M(21) M(22) M(23) M(24) M(25) M(26) M(27) M(28) M(29) M(30) M(31)
__device__ __forceinline__ void cv_stage_a(Conv& C, int lane) {
    const CvItem I = cv_decode(C);
    const float* p = I.W + (size_t)(I.k0 + (lane >> 5)) * I.N + I.n0 + (lane & 31);
#define A2_CV_LD(i) C.c##i = p[(size_t)(2 * i) * I.N];
    A2_CV_ALL(A2_CV_LD)
#undef A2_CV_LD
}
__device__ __forceinline__ void cv_stage_b(Conv& C, char* lds, int vw, int lane) {
    const CvItem I = cv_decode(C);
    float* scr = (float*)(lds + OFF_CV + vw * CV_WAVE);
    float* w = scr + (lane >> 5) * 33 + (lane & 31);
#define A2_CV_ST(i) w[(2 * i) * 33] = C.c##i;
    A2_CV_ALL(A2_CV_ST)
#undef A2_CV_ST
    asm volatile("s_waitcnt lgkmcnt(0)" ::: "memory");
    const int c = lane & 3;
#pragma unroll
    for (int j = 0; j < 2; ++j) { const int n = (lane >> 2) + 16 * j; const float* sp = scr + (16 * c) * 33 + n; const float sc = I.scale;
        u32x4 o;
#pragma unroll
        for (int q = 0; q < 4; ++q) o[q] = pg8::pk4_fp8(sp[(4 * q) * 33] * sc, sp[(4 * q + 1) * 33] * sc, sp[(4 * q + 2) * 33] * sc, sp[(4 * q + 3) * 33] * sc);
        *reinterpret_cast<u32x4*>(I.WT + (size_t)(I.dst + n) * 1024 + I.k0 + 16 * c) = o; }
    asm volatile("s_waitcnt lgkmcnt(0)" ::: "memory");
}
__device__ __forceinline__ void cv_tick(Conv& C, char* lds, int vw, int lane) {
    const int ph = C.tick & 3; ++C.tick;
    if (ph == 0) { if (!C.pend && C.it < CV_ITEMS) { cv_stage_a(C, lane); C.pend = 1; } }
    else if (ph == 2) { if (C.pend) { cv_stage_b(C, lds, vw, lane); C.pend = 0; C.it += C.stride; } }
}
__device__ __forceinline__ void cv_finish(Conv& C, char* lds, int vw, int lane) {
    if (C.pend) { cv_stage_b(C, lds, vw, lane); C.pend = 0; C.it += C.stride; }
    while (C.it < CV_ITEMS) { cv_stage_a(C, lane); cv_stage_b(C, lds, vw, lane); C.it += C.stride; }
}
template <bool SW> __device__ __forceinline__ void prime(const BlockRef& cur, char* lds, Seam& S) {
    const int tid = tid_opaque(), wid = __builtin_amdgcn_readfirstlane(tid >> 6), lane = tid & 63, r32 = lane & 31, hi = lane >> 5;
    const int sw = wid & 3, t8 = tid & 255;
    const unsigned koff = (unsigned)((t8 >> 4) * KS + (t8 & 15) * 8) * 2u, voff = (unsigned)((t8 >> 4) * VS + (t8 & 15) * 8) * 2u;
    const int kws = (t8 >> 4) * KSTR + (t8 & 15) * 16;
    if constexpr (SW) {
        const unsigned qoff = (unsigned)((sw * 32 + r32) * QS + hi * 8) * 2u;
        A2_QLOAD(cur);
    } else { A2_SLOAD_KQ(cur, 0); A2_SLOAD_V(cur, 0); A2_VMWN(8); A2_SWRITE_KQ(0); }
    __syncthreads();
}
template <bool SW> __device__ __forceinline__ void block(const BlockRef& cur, const BlockRef& nxt, char* lds, Seam& S, const float* rcos, const float* rsin, Conv& C) {
    const int tid = tid_opaque(), wid = __builtin_amdgcn_readfirstlane(tid >> 6), lane = tid & 63, r32 = lane & 31, hi = lane >> 5;
    const int sw = wid & 3, t8 = tid & 255;
    const int NT = (cur.P0 + QB) / KVBLK;
    const unsigned W = 1u << 30;
    const int qlo = cur.P0 + sw * 32, qm = qlo + r32 - 4 * hi;
    float* ws = (float*)(lds + OFF_WS) + sw * 128; float* li_l = ws, * al_l = ws + 32; float* fl_l = ws + 64;
    char* pb = lds + OFF_P + sw * 4096 + lane * 16;
    float m_reg = -1e30f, l_reg = 0; f32x16 o[4] = {};
    const unsigned koff = (unsigned)((t8 >> 4) * KS + (t8 & 15) * 8) * 2u, voff = (unsigned)((t8 >> 4) * VS + (t8 & 15) * 8) * 2u;
    const int kws = (t8 >> 4) * KSTR + (t8 & 15) * 16;
    const int vst0 = v_st((t8 >> 4), (t8 & 15) * 8), vst1 = v_st((t8 >> 4) + 16, (t8 & 15) * 8), vst2 = v_st((t8 >> 4) + 32, (t8 & 15) * 8), vst3 = v_st((t8 >> 4) + 48, (t8 & 15) * 8);
    const int vb0 = (int)(uintptr_t)(lds + (SW ? OFF_V0 : OFF_V1)) + v_rd_base(lane);
#define A2_KBASE(t) ((t) * KVBLK)
#define A2_MASKT(P0_, P1_, t) do { const int kb_ = A2_KBASE(t); if (kb_ + KVBLK - 1 > qlo) mask_tile(P0_, P1_, qm - kb_, W); } while (0)
#define A2_PUTP() do { *(bf16x8*)(pb) = pa0; *(bf16x8*)(pb + 1024) = pa1; *(bf16x8*)(pb + 2048) = pa2; *(bf16x8*)(pb + 3072) = pa3; } while (0)
#define A2_GETP() do { pa0 = *(const bf16x8*)(pb); pa1 = *(const bf16x8*)(pb + 1024); pa2 = *(const bf16x8*)(pb + 2048); pa3 = *(const bf16x8*)(pb + 3072); } while (0)
#define A2_PUTAL(a) do { const bool any_ = __any((a) < 1.f); if (hi == 0) al_l[r32] = (a); if (lane == 0) fl_l[0] = any_ ? 1.f : 0.f; } while (0)
#define A2_RESC() do { if (fl_l[0] != 0.f) { for (int d_ = 0; d_ < 4; ++d_) for (int r = 0; r < 16; ++r) o[d_][r] *= al_l[crow(r, hi)]; } } while (0)
    f32x16 pA0, pA1, pB0, pB1; float mnA, mnB, alA = 1.f, alB = 1.f; bf16x8 pa0, pa1, pa2, pa3;
    if constexpr (!SW) { A2_SWRITE_V(0); }
    A2_SBAR();
    if (NT > 1) { if constexpr (!SW) { A2_SLOAD_KQ(cur, A2_KBASE(1)); A2_SLOAD_V(cur, A2_KBASE(1)); } }
    A2_SBAR();
    if constexpr (SW) { qkt<0>(pA0, pA1, lds, r32, hi, S); A2_MASKT(pA0, pA1, 0); att::partialSM<SCALE_E6>(pA0, pA1, m_reg, mnA, alA); }
    if (NT > 1) { if constexpr (!SW) { A2_VMW(); A2_SWRITE_KQ(1); A2_SWRITE_V(1); } }
    __syncthreads();
#define A2_STEP(PX0, PX1, mnX, alX, PY0, PY1, alY, t, KB, VB, SB) do {                                                      \
        A2_SBAR();                                                                                                            \
        if constexpr (SW) { qkt<KB>(PX0, PX1, lds, r32, hi, S); att::finishSM(PY0, PY1, alY, l_reg, pa0, pa1, pa2, pa3); A2_QK_SCHED(); A2_PUTP(); A2_SBAR();   \
                  }                                                                                                           \
        else { if ((t) + 1 < NT) { A2_SLOAD_KQ(cur, A2_KBASE((t) + 1)); A2_SLOAD_V(cur, A2_KBASE((t) + 1)); } A2_SBAR(); cv_tick(C, lds, sw, lane); }                \
        A2_SBAR(); A2_MIDBAR();                                                                                               \
        if constexpr (!SW) { A2_GETP(); }                                                                                               \
        att::pv_tile<VB>(o, vb0, pa0, pa1, pa2, pa3);                                                                         \
        if constexpr (SW) { A2_MASKT(PX0, PX1, (t)); att::partialSM<SCALE_E6>(PX0, PX1, m_reg, mnX, alX); A2_PUTAL(alX); }              \
        __syncthreads();                                                                                                      \
        if ((t) + 1 < NT) { if constexpr (!SW) { A2_SWRITE_KQ(SB); A2_SWRITE_V(SB); } }                                            \
        A2_RESC(); __syncthreads(); } while (0)
    for (int t = 1; t + 1 < NT; t += 2) {
        A2_STEP(pB0, pB1, mnB, alB, pA0, pA1, alA, t, 1, 0, 0);
        A2_STEP(pA0, pA1, mnA, alA, pB0, pB1, alB, t + 1, 0, 1, 1);
    }
    A2_SBAR();
    if constexpr (SW) { qkt<1>(pB0, pB1, lds, r32, hi, S); A2_SBAR();
        const unsigned qoff = (unsigned)((sw * 32 + r32) * QS + hi * 8) * 2u;
        A2_QLOAD(nxt);
        A2_SBAR();
        att::finishSM(pA0, pA1, alA, l_reg, pa0, pa1, pa2, pa3); A2_PUTP(); }
    else { A2_SLOAD_KQ(nxt, 0); A2_SLOAD_V(nxt, 0); }
    A2_SBAR(); A2_MIDBAR();
    if constexpr (!SW) { A2_GETP(); }
    att::pv_tile<0>(o, vb0, pa0, pa1, pa2, pa3);
    if constexpr (SW) { A2_MASKT(pB0, pB1, NT - 1); att::partialSM<SCALE_E6>(pB0, pB1, m_reg, mnB, alB); A2_PUTAL(alB); }
    A2_SBAR(); A2_MIDBAR();
    A2_RESC();
    if constexpr (SW) { att::finishSM(pB0, pB1, alB, l_reg, pa0, pa1, pa2, pa3); A2_PUTP(); if (hi == 0) li_l[r32] = l_reg; }
    A2_SBAR(); A2_MIDBAR();
    if constexpr (!SW) { A2_GETP(); }
    att::pv_tile<1>(o, vb0, pa0, pa1, pa2, pa3);
    A2_SBAR();
    if constexpr (!SW) { A2_VMWN(8); A2_SWRITE_KQ(0); A2_SBAR(); }
    float rli[16];
#pragma unroll
    for (int r = 0; r < 16; ++r) rli[r] = __builtin_amdgcn_rcpf(li_l[crow(r, hi)]);
    const unsigned ooff = (unsigned)((sw * 32 + 4 * hi) * OS + (SW ? 0 : 128) + r32) * 2u;
#pragma unroll
    for (int r = 0; r < 16; ++r) {
#pragma unroll
        for (int d0 = 0; d0 < 4; ++d0) { const float v = o[d0][r] * rli[r];
            const float vn = __int_as_float(__builtin_amdgcn_mov_dpp(__float_as_int(v), 0xB1, 0xF, 0xF, true));
            if ((r32 & 1) == 0) *reinterpret_cast<unsigned*>((char*)cur.O + (size_t)((((r & 3) + 8 * (r >> 2)) * OS + d0 * 32) * 2) + ooff) = cvtpk(v, vn); } }
    __syncthreads();
#undef A2_KBASE
#undef A2_MASKT
#undef A2_PUTP
#undef A2_GETP
#undef A2_PUTAL
#undef A2_RESC
#undef A2_STEP
}
template <bool SW, class RefFn>
__device__ __forceinline__ void run(char* lds, int vcu, int G, int total, const RefFn& ref, const float* rcos, const float* rsin, const Conv& C0) {
    int L = vcu;
    int cb = L >> 4, q0 = L & 15, q1 = 31 - (L & 15), pass = 0;
    BlockRef cur = ref(cb, q0);
    Seam S; Conv C = C0;
    prime<SW>(cur, lds, S);
    for (;;) {
        const bool more_pass = pass == 0, more_item = L + G < total, last = !more_pass && !more_item;
        int cbn = cb, q0n = q0, q1n = q1, passn = pass + 1, Ln = L;
        if (!more_pass) { passn = 0; Ln = more_item ? L + G : L; cbn = Ln >> 4; q0n = Ln & 15; q1n = 31 - (Ln & 15); }
        const BlockRef nxt = last ? cur : ref(cbn, passn ? q1n : q0n);
        block<SW>(cur, nxt, lds, S, rcos, rsin, C);
        if (last) break;
        cur = nxt; cb = cbn; q0 = q0n; q1 = q1n; pass = passn; L = Ln;
    }
    if constexpr (!SW) { const int lane = (int)threadIdx.x & 63, vw = __builtin_amdgcn_readfirstlane((int)threadIdx.x >> 6) & 3; cv_finish(C, lds, vw, lane); }
}
template <class RefFn>
__device__ __forceinline__ void phase(char* lds, int vcu, int G, int total, const RefFn& ref, const float* rcos, const float* rsin, const float* wgu, const float* wdn, unsigned char* dgu, unsigned char* ddn) {
    const int wid = __builtin_amdgcn_readfirstlane((int)threadIdx.x >> 6);
    Conv C0{}; C0.wgu = wgu; C0.wdn = wdn; C0.dgu = dgu; C0.ddn = ddn; C0.it = vcu * 4 + (wid & 3); C0.stride = G * 4; C0.tick = 0; C0.pend = 0;
    if (wid < 4) run<true>(lds, vcu, G, total, ref, rcos, rsin, C0); else run<false>(lds, vcu, G, total, ref, rcos, rsin, C0);
}
}
constexpr int NWAVES = 8;
#ifndef MK_PER_PHASE
#define MK_PER_PHASE 0
#endif
constexpr int NPHASE = 25;
constexpr int T = 32768, D = 1024, SEQ = 4096, NPROJ = 1792  , PROJ_LD = 768  , NEXP = 32, TOPK = 4;
constexpr int NASSIGN = T * TOPK, MAXBLK = 544, MAXROWS = MAXBLK * 256;
constexpr float LN_EPS = 1e-5f, RMS_EPS = 1e-6f, DN_ALPHA = 1.4142135623730951f;
constexpr float LAMBDA_INIT1 = 0.35550906759096927f;
constexpr size_t MiB = 1u << 20;
constexpr size_t WS_CTL = 0, CTL_ZERO_BYTES = 64 * 1024;
constexpr size_t WS_COS64 = 1 * MiB, WS_SIN64 = WS_COS64 + 512 * 1024, WS_COS128 = 2 * MiB, WS_SIN128 = 3 * MiB;
constexpr size_t WS_WIN = 4 * MiB, WS_WQU = 8 * MiB, WS_WKVU = 9 * MiB, WS_WO0 = 10 * MiB, WS_WR0 = 12 * MiB, WS_WQKV = 13 * MiB, WS_WO1 = 19 * MiB, WS_WR1 = 21 * MiB;
constexpr int TKR_OFF = 262144;
constexpr size_t WS_LOGIT = 22 * MiB, WS_TKE = 26 * MiB, WS_TKG = WS_TKE + 512 * 1024, WS_TKR = 27 * MiB, WS_TDEST = WS_TKR + 512 * 1024, WS_RGATE = 28 * MiB, WS_ROWTOK = WS_LOGIT  ;
constexpr size_t WS_VB = 224 * MiB;
constexpr size_t WS_XB = 32 * MiB, WS_WGU = 96 * MiB  , WS_WDN = 160 * MiB  , WS_X8 = 192 * MiB  , WS_OV = 288 * MiB;
constexpr size_t WS_XG = WS_OV, WS_ACT = WS_OV + 272 * MiB;
constexpr size_t WS_UG = WS_OV + 48 * MiB  , WS_PROJ = WS_OV, WS_QLN = WS_OV + 112 * MiB, WS_KVLN = WS_OV + 136 * MiB, WS_KROPE = WS_OV + 152 * MiB, WS_Q0 = WS_OV + 156 * MiB, WS_KV0 = WS_OV + 204 * MiB;
constexpr size_t WS_QKV = WS_OV, WS_O2 = WS_OV + 192 * MiB, WS_CAT = WS_OV + 332 * MiB;
constexpr size_t WS_END = WS_OV + 544 * MiB;
static_assert(WS_KV0 + 64 * MiB <= WS_CAT && WS_O2 + 128 * MiB <= WS_CAT && WS_CAT + 64 * MiB <= WS_END && WS_ACT + 272 * MiB <= WS_END, "d_ws map");
constexpr int CW_TMO = 0, CW_BAR = 4096, CW_CNT = 8192;
constexpr int RING_BYTES = 131072  , LDSCTL_OFF = 152576  , MISC_OFF = LDSCTL_OFF, MOE_OFF = LDSCTL_OFF + 256;
constexpr int LDS_BYTES = 155648;

#define GAS __attribute__((address_space(1)))
#define LAS __attribute__((address_space(3)))
typedef unsigned short bf16;
typedef unsigned v4u __attribute__((ext_vector_type(4)));
typedef unsigned v2u __attribute__((ext_vector_type(2)));
typedef float f32x4 __attribute__((ext_vector_type(4)));
typedef float f32x2 __attribute__((ext_vector_type(2)));
typedef GAS unsigned gu32;
#define RLX_AGENT __ATOMIC_RELAXED, __HIP_MEMORY_SCOPE_AGENT
#define LDS_WAIT() asm volatile("s_waitcnt lgkmcnt(0)" ::: "memory")
#define VM_WAIT() asm volatile("s_waitcnt vmcnt(0)" ::: "memory")
__device__ __forceinline__ unsigned pk2(float lo, float hi) { unsigned r; asm volatile("v_cvt_pk_bf16_f32 %0, %1, %2" : "=v"(r) : "v"(lo), "v"(hi)); return r; }
__device__ __forceinline__ float bflo(unsigned w) { return __uint_as_float(w << 16); }
__device__ __forceinline__ float bfhi(unsigned w) { return __uint_as_float(w & 0xffff0000u); }
__device__ __forceinline__ float sigmoidf_(float z) { return __builtin_amdgcn_rcpf(1.0f + __builtin_amdgcn_exp2f(-1.4426950408889634f * z)); }

#define XB_TMO      128
#define XB_XCNT(j)  (256  + 64 * (j))
#define XB_XSUB(j)  (1280 + 64 * (j))
#define XB_XGEN(j)  (2304 + 64 * (j))
#define XB_TOP      3328
#define XB_TOPGEN   3392
#define XCD_BAR_WORDS 3456
#define XB_SPIN_CAP (1u << 18)
__device__ __forceinline__ unsigned xb_ld(unsigned* p)              { return __hip_atomic_load(p, __ATOMIC_RELAXED, __HIP_MEMORY_SCOPE_AGENT); }
__device__ __forceinline__ unsigned xb_add(unsigned* p, unsigned v) { return __hip_atomic_fetch_add(p, v, __ATOMIC_RELAXED, __HIP_MEMORY_SCOPE_AGENT); }
__device__ __forceinline__ unsigned xb_xcc_id() { return (unsigned)__builtin_amdgcn_s_getreg((3 << 11) | 20) & 0xFu; }
#define XB_SPIN(cond, bar) do { unsigned _sp = 0; while (cond) { __builtin_amdgcn_s_sleep(1); \
    if ((++_sp & 255u) == 0u) { if (xb_ld(&(bar)[XB_TMO])) break; if (_sp > XB_SPIN_CAP) { atomicAdd(&(bar)[XB_TMO], 1u); break; } } } } while (0)
struct XcdBarrier { unsigned* bar; unsigned x; volatile LAS unsigned* st; };
__device__ __forceinline__ XcdBarrier xcd_barrier_post(unsigned* bar, volatile LAS unsigned* st) {
    XcdBarrier b; b.bar = bar; b.x = xb_xcc_id(); b.st = st;
    if (threadIdx.x == 0) (void)xb_add(&bar[XB_XCNT(b.x)], 1u);
    return b;
}
__device__ __forceinline__ void xcd_barrier_complete(unsigned* bar, unsigned x, unsigned& nloc, unsigned& nx) {
    const unsigned G = gridDim.x * gridDim.y * gridDim.z;
    unsigned sum, cnt, mine, sp = 0u;
    for (;;) {
        sum = 0u; cnt = 0u; mine = 0u;
#pragma unroll
        for (unsigned j = 0; j < 16; ++j) { const unsigned c = xb_ld(&bar[XB_XCNT(j)]); sum += c; cnt += (c > 0u) ? 1u : 0u; mine = (j == x) ? c : mine; }
        if (sum == G) break;
        __builtin_amdgcn_s_sleep(1);
        if ((++sp & 255u) == 0u) { if (xb_ld(&bar[XB_TMO])) break; if (sp > XB_SPIN_CAP) { atomicAdd(&bar[XB_TMO], 1u); break; } }
    }
    nloc = mine > 0u ? mine : 1u; nx = cnt > 0u ? cnt : 1u;
}
__device__ __forceinline__ void xcd_barrier(const XcdBarrier& b) {
    asm volatile("s_waitcnt vmcnt(0)" ::: "memory");
    __syncthreads();
    if (threadIdx.x == 0) {
        unsigned* bar = b.bar;
        __builtin_amdgcn_s_waitcnt(0);
        unsigned nloc = b.st[0], nx = b.st[1];
        if (nloc == 0u) { xcd_barrier_complete(bar, b.x, nloc, nx); b.st[0] = nloc; b.st[1] = nx; }
        const unsigned old = xb_add(&bar[XB_XSUB(b.x)], 1u);
        const unsigned gen = old / nloc;
        if (old + 1u == (gen + 1u) * nloc) {
            __builtin_amdgcn_fence(__ATOMIC_RELEASE, "agent");
            asm volatile("s_waitcnt vmcnt(0)" ::: "memory");
            const unsigned og = xb_add(&bar[XB_TOP], 1u);
            const unsigned tg = og / nx;
            if (og + 1u == (tg + 1u) * nx) xb_add(&bar[XB_TOPGEN], 1u);
            else XB_SPIN(xb_ld(&bar[XB_TOPGEN]) == tg, bar);
            __builtin_amdgcn_fence(__ATOMIC_ACQUIRE, "agent");
            xb_add(&bar[XB_XGEN(b.x)], 1u);
            asm volatile("s_waitcnt vmcnt(0)" ::: "memory");
        } else {
            XB_SPIN(xb_ld(&bar[XB_XGEN(b.x)]) == gen, bar);
            __builtin_amdgcn_fence(__ATOMIC_ACQUIRE, "agent");
            asm volatile("s_waitcnt vmcnt(0)" ::: "memory");
        }
    }
    __syncthreads();
}

struct Frame {
    LAS unsigned char* lds; gu32* ctl;
    int tid, lane, wave, vcu, G, gw, NGW;
};
__device__ __forceinline__ float wave_sum(float v) {
#define WS_DPP(x, ctrl, rmask) __int_as_float(__builtin_amdgcn_update_dpp(0, __float_as_int(x), ctrl, rmask, 0xF, false))
    v += WS_DPP(v, 0xB1, 0xF);
    v += WS_DPP(v, 0x4E, 0xF);
    v += WS_DPP(v, 0x124, 0xF);
    v += WS_DPP(v, 0x128, 0xF);
    v += WS_DPP(v, 0x142, 0xA);
    v += WS_DPP(v, 0x143, 0xC);
#undef WS_DPP
    return __int_as_float(__builtin_amdgcn_readlane(__float_as_int(v), 63));
}
__device__ __forceinline__ unsigned pk4_fp8(float a, float b, float c, float d) { return pg8::pk4_fp8(a, b, c, d); }
constexpr float XSC = 16.0f, WGU_SC = 256.0f, ACT_SC = 8.0f, WDN_SC = 512.0f, YSC = 64.0f, CAT_SC = 64.0f;
__device__ __forceinline__ void transpose_item(const float* W, int K, int N, bf16* WT, int k0, int n0, int dst_row, LAS float* scr, int lane) {
#pragma unroll 8
    for (int i = 0; i < 32; ++i) { const int kk = 2 * i + (lane >> 5); scr[kk * 33 + (lane & 31)] = W[(size_t)(k0 + kk) * N + n0 + (lane & 31)]; }
    LDS_WAIT(); asm volatile("" ::: "memory");
    const int c = lane & 7;
#pragma unroll
    for (int j = 0; j < 4; ++j) { const int n = (lane >> 3) + 8 * j; const LAS float* s = scr + (8 * c) * 33 + n;
        v4u o; o.x = pk2(s[0 * 33], s[1 * 33]); o.y = pk2(s[2 * 33], s[3 * 33]); o.z = pk2(s[4 * 33], s[5 * 33]); o.w = pk2(s[6 * 33], s[7 * 33]);
        *(GAS v4u*)(WT + (size_t)(dst_row + n) * K + k0 + 8 * c) = o; }
    LDS_WAIT(); asm volatile("" ::: "memory");
}
template <int MODE> __device__ __forceinline__ void convert_matrix(const Frame& F, const float* W, int K, int N, bf16* WT, int nexp) {
    LAS float* scr = (LAS float*)(F.lds + F.wave * 16384);
    const int nblk = N / 32, per = (K / 64) * nblk, total = per * nexp;
    for (int it = F.gw; it < total; it += F.NGW) {
        const int e = it / per, r = it - e * per, kb = r / nblk, nb = r - kb * nblk, n0 = 32 * nb;
        int dst = n0;
        if (MODE == 1) { const int up = n0 >= 1024, nn = n0 & 1023; dst = 256 * (nn >> 7) + 128 * up + (nn & 127); }
        if (MODE == 3 && n0 >= 704) { const int g = n0 >= 1216, cc = n0 - (g ? 1216 : 704); dst = 768 + 256 * (cc >> 7) + 128 * g + (cc & 127); }
        if (MODE == 2 && n0 < 2048) { const int qk = n0 & ~1023, cc = n0 & 1023, h8 = cc >> 7, d0 = cc & 127; dst = qk + (h8 >> 1) * 256 + (d0 >> 6) * 128 + (h8 & 1) * 64 + (d0 & 63); }
        transpose_item(W + (size_t)e * K * N, K, N, WT + (size_t)e * N * K, 64 * kb, n0, dst, scr, F.lane);
    }
}
__device__ __forceinline__ void transpose_item8(const float* W, int K, int N, unsigned char* WT, int k0, int n0, int dst_row, LAS float* scr, int lane, float scale) {
#pragma unroll 8
    for (int i = 0; i < 32; ++i) { const int kk = 2 * i + (lane >> 5); scr[kk * 33 + (lane & 31)] = W[(size_t)(k0 + kk) * N + n0 + (lane & 31)]; }
    LDS_WAIT(); asm volatile("" ::: "memory");
    const int c = lane & 3;
#pragma unroll
    for (int j = 0; j < 2; ++j) { const int n = (lane >> 2) + 16 * j; const LAS float* s = scr + (16 * c) * 33 + n;
        v4u o;
#pragma unroll
        for (int q = 0; q < 4; ++q) o[q] = pk4_fp8(s[(4 * q) * 33] * scale, s[(4 * q + 1) * 33] * scale, s[(4 * q + 2) * 33] * scale, s[(4 * q + 3) * 33] * scale);
        *(GAS v4u*)(WT + (size_t)(dst_row + n) * K + k0 + 16 * c) = o; }
    LDS_WAIT(); asm volatile("" ::: "memory");
}
template <int MODE> __device__ __forceinline__ void convert_matrix8(const Frame& F, const float* W, int K, int N, unsigned char* WT, int nexp, float scale) {
    LAS float* scr = (LAS float*)(F.lds + F.wave * 16384);
    const int nblk = N / 32, per = (K / 64) * nblk, total = per * nexp;
    for (int it = F.gw; it < total; it += F.NGW) {
        const int e = it / per, r = it - e * per, kb = r / nblk, nb = r - kb * nblk, n0 = 32 * nb;
        int dst = n0;
        if (MODE == 1) { const int up = n0 >= 1024, nn = n0 & 1023; dst = 256 * (nn >> 7) + 128 * up + (nn & 127); }
        if (MODE == 3 && n0 >= 704) { const int g = n0 >= 1216, cc = n0 - (g ? 1216 : 704); dst = 768 + 256 * (cc >> 7) + 128 * g + (cc & 127); }
        if (MODE == 2 && n0 < 2048) { const int qk = n0 & ~1023, cc = n0 & 1023, h8 = cc >> 7, d0 = cc & 127; dst = qk + (h8 >> 1) * 256 + (d0 >> 6) * 128 + (h8 & 1) * 64 + (d0 & 63); }
        transpose_item8(W + (size_t)e * K * N, K, N, WT + (size_t)e * N * K, 64 * kb, n0, dst, scr, F.lane, scale);
    }
}
__device__ __forceinline__ void zero_bytes16(const Frame& F, void* p, size_t bytes) {
    GAS v4u* q = (GAS v4u*)p; const size_t n = bytes / 16;
    for (size_t i = (size_t)F.vcu * 512 + F.tid; i < n; i += (size_t)F.G * 512) q[i] = (v4u){0u, 0u, 0u, 0u};
}
__device__ __forceinline__ void rope_tables(const Frame& F, float* cs, float* sn, int half  ) {
    const int n = SEQ * half;
    for (int i = F.vcu * 512 + F.tid; i < n; i += F.G * 512) {
        const int pos = i / half, f = i - pos * half;
        const float inv = __builtin_amdgcn_exp2f(-(float)f / (float)half * 13.287712379549449f);
        const float ang = (float)pos * inv;
        double rev = (double)ang * 0.15915494309189535; rev -= __builtin_floor(rev);
        const float rf = (float)rev;
        cs[i] = __builtin_amdgcn_cosf(rf); sn[i] = __builtin_amdgcn_sinf(rf);
    }
}
__device__ __forceinline__ void rows_to_bf16(const Frame& F, const float* x, bf16* xb, unsigned char* x8) {
    for (int m0 = F.gw * 4; m0 < T; m0 += F.NGW * 4) {
        f32x4 v[4][4];
#pragma unroll
        for (int r = 0; r < 4; ++r)
#pragma unroll
            for (int j = 0; j < 4; ++j) v[r][j] = *((const GAS f32x4*)(x + (size_t)(m0 + r) * D) + F.lane + 64 * j);
#pragma unroll
        for (int r = 0; r < 4; ++r)
#pragma unroll
            for (int j = 0; j < 4; ++j) { *((GAS v2u*)(xb + (size_t)(m0 + r) * D) + F.lane + 64 * j) = (v2u){pk2(v[r][j].x, v[r][j].y), pk2(v[r][j].z, v[r][j].w)};
                *((GAS unsigned*)(x8 + (size_t)(m0 + r) * D) + F.lane + 64 * j) = pk4_fp8(v[r][j].x * XSC, v[r][j].y * XSC, v[r][j].z * XSC, v[r][j].w * XSC); }
    }
}
constexpr int NRM = 8;
__device__ __forceinline__ void mid0_rows(const Frame& F, const bf16* proj, const float* qg, const float* kvg, const float* cs64, const float* sn64, bf16* qln, bf16* kvln, bf16* krope) {
    float gq[3][2], gk[2][2];
#pragma unroll
    for (int j = 0; j < 3; ++j) { const f32x2 g = *(const f32x2*)(qg + 2 * (F.lane + 64 * j)); gq[j][0] = g.x; gq[j][1] = g.y; }
#pragma unroll
    for (int j = 0; j < 2; ++j) { const f32x2 g = *(const f32x2*)(kvg + 2 * (F.lane + 64 * j)); gk[j][0] = g.x; gk[j][1] = g.y; }
    for (int t0 = F.gw * NRM; t0 < T; t0 += F.NGW * NRM) {
        unsigned w[NRM][3], v[NRM][2]; unsigned short kx[NRM]; float cc[NRM], sc[NRM];
#pragma unroll
        for (int r = 0; r < NRM; ++r) { const GAS unsigned* prow = (const GAS unsigned*)(proj + (size_t)(t0 + r) * PROJ_LD);
#pragma unroll
            for (int j = 0; j < 3; ++j) w[r][j] = prow[F.lane + 64 * j];
#pragma unroll
            for (int j = 0; j < 2; ++j) v[r][j] = prow[192 + F.lane + 64 * j];
            kx[r] = ((const GAS bf16*)prow)[640 + F.lane];
            const int pos = (t0 + r) & (SEQ - 1); cc[r] = cs64[pos * 32 + (F.lane & 31)]; sc[r] = sn64[pos * 32 + (F.lane & 31)]; }
#pragma unroll
        for (int r = 0; r < NRM; ++r) { const int t = t0 + r;
            float ss = 0.f;
#pragma unroll
            for (int j = 0; j < 3; ++j) { const float a = bflo(w[r][j]), b = bfhi(w[r][j]); ss += a * a + b * b; }
            float rstd = __builtin_amdgcn_rsqf(wave_sum(ss) * (1.0f / 384.0f) + RMS_EPS);
            GAS unsigned* qo = (GAS unsigned*)(qln + (size_t)t * 384);
#pragma unroll
            for (int j = 0; j < 3; ++j) qo[F.lane + 64 * j] = pk2(bflo(w[r][j]) * rstd * gq[j][0], bfhi(w[r][j]) * rstd * gq[j][1]);
            ss = 0.f;
#pragma unroll
            for (int j = 0; j < 2; ++j) { const float a = bflo(v[r][j]), b = bfhi(v[r][j]); ss += a * a + b * b; }
            rstd = __builtin_amdgcn_rsqf(wave_sum(ss) * (1.0f / 256.0f) + RMS_EPS);
            GAS unsigned* ko = (GAS unsigned*)(kvln + (size_t)t * 256);
#pragma unroll
            for (int j = 0; j < 2; ++j) ko[F.lane + 64 * j] = pk2(bflo(v[r][j]) * rstd * gk[j][0], bfhi(v[r][j]) * rstd * gk[j][1]);
            const float xk = __uint_as_float((unsigned)kx[r] << 16), xp = __shfl_xor(xk, 32);
            const float y = F.lane < 32 ? xk * cc[r] - xp * sc[r] : xk * cc[r] + xp * sc[r];
            ((GAS bf16*)krope)[(size_t)t * 64 + F.lane] = (bf16)(pk2(y, 0.f) & 0xffffu); }
    }
}
#ifndef NHB
#define NHB 1
#endif
__device__ __forceinline__ void conv_stage(const Frame& F, const bf16* ug, int tile, LAS unsigned char* B) {
    const int t0 = tile * 32, pos0 = t0 & (SEQ - 1);
    for (int rr = __builtin_amdgcn_readfirstlane(F.wave); rr < 62; rr += NWAVES) {
        if (pos0 - 30 + rr >= 0) __builtin_amdgcn_global_load_lds((const unsigned*)((const GAS unsigned char*)ug + (size_t)(t0 - 30 + rr) * 1024 + F.lane * 16), (LAS unsigned*)(B + rr * 1024), 16, 0, 0);
        else *(LAS v4u*)(B + rr * 1024 + F.lane * 16) = (v4u){0u, 0u, 0u, 0u};
    }
}
constexpr int CONV_U1 = 66560;
__device__ __forceinline__ void conv_prefetch(const Frame& F, const bf16* ug) { if (F.vcu < T / 32) conv_stage(F, ug, F.vcu, F.lds); }
__device__ __forceinline__ void conv_phase(const Frame& F, const bf16* proj, const float* cw, const float* cb, const float* lg, const float* lb, bf16* cat) {
    LAS float* part = (LAS float*)(F.lds + 65536);
    const int cp = F.tid & 255, th = F.tid >> 8;
    f32x2 wv2[31];
#pragma unroll
    for (int j = 0; j < 31; ++j) wv2[j] = *(const f32x2*)(cw + j * 512 + 2 * cp);
    const f32x2 bia = *(const f32x2*)(cb + 2 * cp), g2 = *(const f32x2*)(lg + 2 * cp), b2 = *(const f32x2*)(lb + 2 * cp);
    int it = 0;
    for (int tile = F.vcu; tile < T / 32; tile += F.G, ++it) {
        const int t0 = tile * 32;
        LAS unsigned char* U = F.lds + (it & 1) * CONV_U1;
        asm volatile("s_waitcnt vmcnt(0)" ::: "memory");
        __syncthreads();
        if (tile + F.G < T / 32) conv_stage(F, proj, tile + F.G, F.lds + ((it + 1) & 1) * CONV_U1);
        f32x2 acc[16];
#pragma unroll
        for (int i = 0; i < 16; ++i) acc[i] = bia;
#pragma unroll
        for (int r = 0; r < 46; ++r) {
            const unsigned uu = *(const LAS unsigned*)(U + (th * 16 + r) * 1024 + cp * 4); const f32x2 u2 = (f32x2){bflo(uu), bfhi(uu)};
#pragma unroll
            for (int i = 0; i < 16; ++i) { const int j = r - i; if (j >= 0 && j <= 30) acc[i] = __builtin_elementwise_fma(wv2[j], u2, acc[i]); }
        }
        {
            float rs[32];
#pragma unroll
            for (int i = 0; i < 16; ++i) { rs[2 * i] = acc[i].x + acc[i].y; rs[2 * i + 1] = acc[i].x * acc[i].x + acc[i].y * acc[i].y; }
#define WS_DPP(x, ctrl, rmask) __int_as_float(__builtin_amdgcn_update_dpp(0, __float_as_int(x), ctrl, rmask, 0xF, false))
#pragma unroll
            for (int k = 0; k < 32; ++k) rs[k] += __int_as_float(__builtin_amdgcn_mov_dpp(__float_as_int(rs[k]), 0xB1, 0xF, 0xF, true));
#pragma unroll
            for (int k = 0; k < 32; ++k) rs[k] += __int_as_float(__builtin_amdgcn_mov_dpp(__float_as_int(rs[k]), 0x4E, 0xF, 0xF, true));
#pragma unroll
            for (int k = 0; k < 32; ++k) rs[k] += __int_as_float(__builtin_amdgcn_mov_dpp(__float_as_int(rs[k]), 0x124, 0xF, 0xF, true));
#pragma unroll
            for (int k = 0; k < 32; ++k) rs[k] += __int_as_float(__builtin_amdgcn_mov_dpp(__float_as_int(rs[k]), 0x128, 0xF, 0xF, true));
#pragma unroll
            for (int k = 0; k < 32; ++k) rs[k] += WS_DPP(rs[k], 0x142, 0xA);
#pragma unroll
            for (int k = 0; k < 32; ++k) rs[k] += WS_DPP(rs[k], 0x143, 0xC);
#undef WS_DPP
            if (F.lane == 63) {
#pragma unroll
                for (int i = 0; i < 16; ++i) *(LAS f32x2*)(part + ((th * 16 + i) * 4 + (F.wave & 3)) * 2) = (f32x2){rs[2 * i], rs[2 * i + 1]}; }
        }
        __syncthreads();
        int cpo_ = cp; asm volatile("" : "+v"(cpo_));
        GAS unsigned char* const cbase_ = (GAS unsigned char*)cat + (size_t)(t0 + th * 16) * D + 512 + 2 * cpo_;
#pragma unroll
        for (int i = 0; i < 16; ++i) {
            const LAS f32x2* pp = (const LAS f32x2*)(part + (th * 16 + i) * 8);
            const f32x2 p0 = pp[0], p1 = pp[1], p2 = pp[2], p3 = pp[3];
            const float mean = ((p0.x + p1.x) + (p2.x + p3.x)) * (1.0f / 512.0f), ex2 = ((p0.y + p1.y) + (p2.y + p3.y)) * (1.0f / 512.0f);
            const float rstd = __builtin_amdgcn_rsqf(fmaxf(ex2 - mean * mean, 0.f) + LN_EPS);
            const float v0 = (acc[i].x - mean) * rstd * g2.x + b2.x, v1 = (acc[i].y - mean) * rstd * g2.y + b2.y;
            *(GAS unsigned short*)(cbase_ + (unsigned)(i * D)) = (unsigned short)__builtin_amdgcn_cvt_pk_fp8_f32(fminf(v0 * sigmoidf_(v0) * CAT_SC, 448.f), fminf(v1 * sigmoidf_(v1) * CAT_SC, 448.f), 0, false);
        }
    }
    __syncthreads();
}
__device__ __forceinline__ f32x4 bf4(v2u w) { f32x4 r; r.x = bflo(w.x); r.y = bfhi(w.x); r.z = bflo(w.y); r.w = bfhi(w.y); return r; }
__device__ __forceinline__ f32x4 fp8x4(unsigned w) { const f32x2 a = __builtin_amdgcn_cvt_pk_f32_fp8((int)w, false), b = __builtin_amdgcn_cvt_pk_f32_fp8((int)w, true); f32x4 r; r.x = a.x; r.y = a.y; r.z = b.x; r.w = b.y; return r; }
template <bool MOE_SUM, bool FINAL, int NRX = 0> __device__ __forceinline__ void ln_phase(const Frame& F, const bf16* vin, const float* g, const float* b, bf16* xb, unsigned char* x8, float* outf, const unsigned char* ys, const int* tok_dest, const float* tok_gate, int row_first = -1, int row_step = 0, int row_end = 0) {
    constexpr int NR = NRX ? NRX : (MOE_SUM ? 2 : 4);
    if (row_first < 0) { row_first = F.gw * NR; row_step = F.NGW * NR; row_end = T; }
    for (int t0 = row_first; t0 < row_end; t0 += row_step) {
        v2u vi[NR][4]; unsigned y4[MOE_SUM ? NR : 1][4][4]; float gt[MOE_SUM ? NR : 1][4];
#pragma unroll
        for (int r = 0; r < NR; ++r) {
#pragma unroll
            for (int j = 0; j < 4; ++j) vi[r][j] = *((const GAS v2u*)(vin + (size_t)(t0 + r) * D) + F.lane + 64 * j);
            if (MOE_SUM) {
#pragma unroll
                for (int k = 0; k < 4; ++k) { const int a_ = 4 * (t0 + r) + k; const int d = ((const LAS int*)(F.lds + MOE_OFF))[tok_dest[a_]] + tok_dest[a_ + TKR_OFF];     gt[r][k] = tok_gate[4 * (t0 + r) + k] * (1.0f / YSC);
#pragma unroll
                    for (int j = 0; j < 4; ++j) y4[r][k][j] = *((const GAS unsigned*)(ys + (size_t)d * D) + F.lane + 64 * j); }
            }
        }
#pragma unroll
        for (int r = 0; r < NR; ++r) { const int t = t0 + r;
            f32x4 v[4];
#pragma unroll
            for (int j = 0; j < 4; ++j) v[j] = bf4(vi[r][j]);
            if (MOE_SUM) {
#pragma unroll
                for (int j = 0; j < 4; ++j) { v[j] = v[j] * DN_ALPHA;
#pragma unroll
                    for (int k = 0; k < 4; ++k) v[j] += fp8x4(y4[r][k][j]) * gt[r][k]; }
            }
            float s = 0.f;
#pragma unroll
            for (int j = 0; j < 4; ++j) s += (v[j].x + v[j].y) + (v[j].z + v[j].w);
            const float mean = wave_sum(s) * (1.f / D); float s2 = 0.f;
#pragma unroll
            for (int j = 0; j < 4; ++j) { v[j] = v[j] - mean; s2 += (v[j].x * v[j].x + v[j].y * v[j].y) + (v[j].z * v[j].z + v[j].w * v[j].w); }
            const float rstd = __builtin_amdgcn_rsqf(wave_sum(s2) * (1.f / D) + LN_EPS);
#pragma unroll
            for (int j = 0; j < 4; ++j) { const f32x4 gg = *((const GAS f32x4*)g + F.lane + 64 * j), bb = *((const GAS f32x4*)b + F.lane + 64 * j);
                const f32x4 y = v[j] * rstd * gg + bb;
                if (FINAL) *((GAS f32x4*)(outf + (size_t)t * D) + F.lane + 64 * j) = y;
                else *((GAS v2u*)(xb + (size_t)t * D) + F.lane + 64 * j) = (v2u){pk2(y.x, y.y), pk2(y.z, y.w)};
                if (!FINAL) *((GAS unsigned*)(x8 + (size_t)t * D) + F.lane + 64 * j) = pk4_fp8(y.x * XSC, y.y * XSC, y.z * XSC, y.w * XSC); }
        }
    }
}
__device__ __forceinline__ void topk_phase(const Frame& F, const bf16* xb, const bf16* wrt, const float* rb, unsigned* cnt, int* tk_e, float* tk_g, int* tk_rank, int* row_tok, const bf16* vb = nullptr, const float* lng = nullptr, const float* lnb = nullptr, unsigned char* x8 = nullptr) {
    typedef short bf16x8 __attribute__((ext_vector_type(8)));
    LAS unsigned char* WL = F.lds;
    LAS float* lgt = (LAS float*)(F.lds + 67584);
    LAS int* se = (LAS int*)(F.lds + 86016); LAS float* sg = (LAS float*)(F.lds + 88064); LAS unsigned* hist = (LAS unsigned*)(F.lds + 90112); LAS unsigned* base = (LAS unsigned*)(F.lds + 90240);
    v4u wreg[8];
#pragma unroll
    for (int j = 0; j < 8; ++j) { const int i = F.tid + 512 * j, row = i >> 7, ch = i & 127; wreg[j] = *(const GAS v4u*)(wrt + (size_t)row * 1024 + ch * 8); }
    bool filled = false;
    const int fr = F.lane & 15, fq = F.lane >> 4;
    for (int ch = F.vcu; ch < T / 128; ch += F.G) {
        if (F.tid < 32) hist[F.tid] = 0u;
        if (vb != nullptr) { const int r0_ = ch * 128 + 16 * F.wave; ln_phase<false, false, 8>(F, vb, lng, lnb, const_cast<bf16*>(xb), x8, nullptr, nullptr, nullptr, nullptr, r0_, 8, r0_ + 16);
            asm volatile("s_waitcnt vmcnt(0)" ::: "memory"); __builtin_amdgcn_fence(__ATOMIC_ACQ_REL, "workgroup"); }
        if (!filled) { filled = true;
#pragma unroll
            for (int j = 0; j < 8; ++j) { const int i = F.tid + 512 * j, row = i >> 7, c16 = i & 127; *(LAS v4u*)(WL + row * 2064 + c16 * 16) = wreg[j]; }
            __syncthreads(); }
        {
            f32x4 acc0 = {0.f, 0.f, 0.f, 0.f}, acc1 = {0.f, 0.f, 0.f, 0.f};
            const bf16* arow = xb + (size_t)(ch * 128 + 16 * F.wave + fr) * D + fq * 8;
            const LAS unsigned char* b0p = WL + fr * 2064 + fq * 16; const LAS unsigned char* b1p = b0p + 16 * 2064;
#pragma unroll
            for (int k0 = 0; k0 < D; k0 += 32) {
                const bf16x8 a = *(const GAS bf16x8*)(arow + k0);
                const bf16x8 b0 = *(const LAS bf16x8*)(b0p + k0 * 2), b1 = *(const LAS bf16x8*)(b1p + k0 * 2);
                acc0 = __builtin_amdgcn_mfma_f32_16x16x32_bf16(b0, a, acc0, 0, 0, 0);
                acc1 = __builtin_amdgcn_mfma_f32_16x16x32_bf16(b1, a, acc1, 0, 0, 0);
            }
            const f32x4 bb0 = *(const GAS f32x4*)(rb + 4 * fq), bb1 = *(const GAS f32x4*)(rb + 16 + 4 * fq);
            LAS float* lp = lgt + (16 * F.wave + fr) * 33 + 4 * fq;
#pragma unroll
            for (int q = 0; q < 4; ++q) { lp[q] = acc0[q] + bb0[q]; lp[16 + q] = acc1[q] + bb1[q]; }
        }
        __syncthreads();
        if (F.tid < 128) {
            float v[32];
#pragma unroll
            for (int e = 0; e < 32; ++e) v[e] = lgt[F.tid * 33 + e];
            float tv[4]; int ti[4];
#pragma unroll
            for (int k = 0; k < 4; ++k) {
                float best = v[0]; int bi = 0;
#pragma unroll
                for (int e = 1; e < 32; ++e) if (v[e] > best) { best = v[e]; bi = e; }
                tv[k] = best; ti[k] = bi;
#pragma unroll
                for (int e = 0; e < 32; ++e) v[e] = (e == bi) ? -__builtin_inff() : v[e];
            }
            const float e1 = __expf(tv[1] - tv[0]), e2 = __expf(tv[2] - tv[0]), e3 = __expf(tv[3] - tv[0]), inv = 1.0f / (1.0f + e1 + e2 + e3);
            se[F.tid * 4 + 0] = ti[0]; se[F.tid * 4 + 1] = ti[1]; se[F.tid * 4 + 2] = ti[2]; se[F.tid * 4 + 3] = ti[3];
            sg[F.tid * 4 + 0] = inv; sg[F.tid * 4 + 1] = e1 * inv; sg[F.tid * 4 + 2] = e2 * inv; sg[F.tid * 4 + 3] = e3 * inv;
        }
        __syncthreads();
        const int e = se[F.tid]; const float gt = sg[F.tid];
        const unsigned lr = __hip_atomic_fetch_add(hist + e, 1u, __ATOMIC_RELAXED, __HIP_MEMORY_SCOPE_WORKGROUP);
        __syncthreads();
        if (F.tid < 32) base[F.tid] = __hip_atomic_fetch_add(cnt + F.tid, hist[F.tid], __ATOMIC_RELAXED, __HIP_MEMORY_SCOPE_AGENT);
        __syncthreads();
        const int a = ch * 512 + F.tid;
        tk_e[a] = e; tk_g[a] = gt; tk_rank[a] = (int)(base[e] + lr); row_tok[e * T + (int)(base[e] + lr)] = a >> 2;
        __syncthreads();
    }
}
__device__ __forceinline__ void moe_tables(const Frame& F, const unsigned* cnt) {
    LAS int* tb = (LAS int*)(F.lds + MOE_OFF);
    if (F.tid < 32) {
        const int pc = (((int)__hip_atomic_load(cnt + F.tid, RLX_AGENT) + 255) >> 8) << 8; int s = pc;
#pragma unroll
        for (int d = 1; d < 32; d <<= 1) { const int t = __shfl_up(s, d, 32); if (F.tid >= d) s += t; }
        tb[F.tid] = s - pc; if (F.tid == 31) { tb[32] = s; tb[33] = s >> 8; } }
    __syncthreads();
    for (int bk = F.tid; bk < MAXBLK; bk += 512) { const int r0 = bk << 8; int e = 0;
        for (int q = 1; q < NEXP; ++q) e += (tb[q] <= r0) ? 1 : 0;
        tb[64 + bk] = e; }
    __syncthreads();
}
__device__ __forceinline__ void gather_phase(const Frame& F, const unsigned char* x8, const int* tk_e, const int* tk_rank, unsigned char* xg, int* tok_dest) {
    const LAS int* tb = (const LAS int*)(F.lds + MOE_OFF);
    for (int a0 = F.gw * 64; a0 < NASSIGN; a0 += F.NGW * 64) {
        const int a = a0 + F.lane, dest = tb[tk_e[a]] + tk_rank[a];
        tok_dest[a] = dest;
        for (int i0 = 0; i0 < 64; i0 += 8) {
            v4u r[8];
#pragma unroll
            for (int i = 0; i < 8; ++i) r[i] = *((const GAS v4u*)(x8 + (size_t)((a0 + i0 + i) >> 2) * D) + F.lane);
#pragma unroll
            for (int i = 0; i < 8; ++i) { const int d = __builtin_amdgcn_readlane(dest, i0 + i); *((GAS v4u*)(xg + (size_t)d * D) + F.lane) = r[i]; }
        }
    }
}
__device__ __forceinline__ void index_phase(const Frame& F, const int* tk_e, const int* tk_rank, int* tok_dest, int* row_tok) {
    const LAS int* tb = (const LAS int*)(F.lds + MOE_OFF);
    for (int a = F.vcu * 512 + F.tid; a < NASSIGN; a += F.G * 512) { const int dest = tb[tk_e[a]] + tk_rank[a]; tok_dest[a] = dest; row_tok[dest] = a >> 2; }
}
__device__ __forceinline__ void ropek_phase(const Frame& F, bf16* qkv, const float* cs, const float* sn) {
    for (int t0 = F.gw * 2; t0 < T; t0 += F.NGW * 2) {
        unsigned short x1[2][8], x2[2][8]; float c[2], s[2];
#pragma unroll
        for (int r = 0; r < 2; ++r) { const int pos = (t0 + r) & (SEQ - 1); c[r] = cs[pos * 64 + F.lane]; s[r] = sn[pos * 64 + F.lane];
            const GAS bf16* kr = (const GAS bf16*)(qkv + (size_t)(t0 + r) * 3072 + 1024);
#pragma unroll
            for (int hh = 0; hh < 8; ++hh) { x1[r][hh] = kr[hh * 128 + F.lane]; x2[r][hh] = kr[hh * 128 + 64 + F.lane]; } }
#pragma unroll
        for (int r = 0; r < 2; ++r) { GAS bf16* kr = (GAS bf16*)(qkv + (size_t)(t0 + r) * 3072 + 1024);
#pragma unroll
            for (int hh = 0; hh < 8; ++hh) { const float a = __uint_as_float((unsigned)x1[r][hh] << 16), b = __uint_as_float((unsigned)x2[r][hh] << 16);
                kr[hh * 128 + F.lane] = (bf16)(pk2(a * c[r] - b * s[r], 0.f) & 0xffffu); kr[hh * 128 + 64 + F.lane] = (bf16)(pk2(b * c[r] + a * s[r], 0.f) & 0xffffu); } }
    }
}
__device__ __forceinline__ void comb_phase(const Frame& F, const bf16* o2, const float* lq1, const float* lk1, const float* lq2, const float* lk2, const float* sg, unsigned char* cat8) {
    const float d1 = wave_sum(lq1[F.lane] * lk1[F.lane] + lq1[64 + F.lane] * lk1[64 + F.lane]), d2 = wave_sum(lq2[F.lane] * lk2[F.lane] + lq2[64 + F.lane] * lk2[64 + F.lane]);
    const float lam = __expf(d1) - __expf(d2) + LAMBDA_INIT1;
    const f32x4 g4 = *((const GAS f32x4*)sg + F.lane);
    for (int t0 = F.gw * 2; t0 < T; t0 += F.NGW * 2) {
        v2u a[2][4], b[2][4];
#pragma unroll
        for (int r = 0; r < 2; ++r)
#pragma unroll
            for (int h = 0; h < 4; ++h) { a[r][h] = *((const GAS v2u*)(o2 + (size_t)(t0 + r) * 2048 + h * 512) + F.lane); b[r][h] = *((const GAS v2u*)(o2 + (size_t)(t0 + r) * 2048 + h * 512 + 256) + F.lane); }
#pragma unroll
        for (int r = 0; r < 2; ++r)
#pragma unroll
            for (int h = 0; h < 4; ++h) {
                f32x4 v; v.x = bflo(a[r][h].x) - lam * bflo(b[r][h].x); v.y = bfhi(a[r][h].x) - lam * bfhi(b[r][h].x); v.z = bflo(a[r][h].y) - lam * bflo(b[r][h].y); v.w = bfhi(a[r][h].y) - lam * bfhi(b[r][h].y);
                const float rstd = __builtin_amdgcn_rsqf(wave_sum((v.x * v.x + v.y * v.y) + (v.z * v.z + v.w * v.w)) * (1.0f / 256.0f) + RMS_EPS) * (1.0f - LAMBDA_INIT1);
                *((GAS unsigned*)(cat8 + (size_t)(t0 + r) * D + h * 256) + F.lane) = pk4_fp8(v.x * rstd * g4.x * CAT_SC, v.y * rstd * g4.y * CAT_SC, v.z * rstd * g4.z * CAT_SC, v.w * rstd * g4.w * CAT_SC);
            }
    }
}
typedef att::Cfg<192, 768, 1024, 1024, 1024, 8, 2, 72169> AttL0;
typedef att::Cfg<128, 3072, 3072, 3072, 2048, 0, 4, 88388> AttL1;
static_assert(AttL0::LDS_BYTES <= LDSCTL_OFF && att2::LDS_BYTES_CV <= LDSCTL_OFF && MOE_OFF + (64 + MAXBLK) * 4 <= LDS_BYTES, "LDS map");
struct Args { const float* in[38]; float* out; unsigned char* ws; int ph_lo, ph_hi, li, pad; };
__global__ void __launch_bounds__(NWAVES * 64, 2) mega_fwd(Args args) {
    extern __shared__ __attribute__((aligned(16))) unsigned char lds[];
    Frame F;
    F.lds = (LAS unsigned char*)lds;
    F.tid = threadIdx.x; F.lane = F.tid & 63; F.wave = __builtin_amdgcn_readfirstlane(F.tid >> 6);
    F.G = gridDim.x; { const int bx = blockIdx.x; F.vcu = (F.G % 8 == 0) ? (bx % 8) * (F.G / 8) + bx / 8 : bx; }
    F.gw = F.vcu * NWAVES + F.wave; F.NGW = F.G * NWAVES;
    unsigned char* ws = args.ws;
    F.ctl = (gu32*)(ws + WS_CTL);
    for (int u = F.tid; u < (LDS_BYTES - LDSCTL_OFF) / 4; u += NWAVES * 64) ((LAS unsigned*)(F.lds + LDSCTL_OFF))[u] = 0u;
    __syncthreads();
    XcdBarrier bar; bar.bar = (unsigned*)(F.ctl + CW_BAR); bar.x = 0; bar.st = nullptr;
    if (!MK_PER_PHASE) bar = xcd_barrier_post((unsigned*)(F.ctl + CW_BAR), (volatile LAS unsigned*)(F.lds + MISC_OFF) + 8);
#define GRID_BAR() do { if (!MK_PER_PHASE) xcd_barrier(bar); } while (0)
#define PH_BEGIN() do { F.tid = tid_opaque(); F.lane = F.tid & 63; } while (0)
    const int lo = args.ph_lo, hi = args.ph_hi;
#define IN(k) (lo <= (k) && (k) < hi)
#define BOTH(k) (IN(k) && IN((k) + 1))
    const float* x = args.in[0]; float* OUT = args.out; bf16* VB = (bf16*)(ws + WS_VB);
    bf16* WIN = (bf16*)(ws + WS_WIN); bf16* WQU = (bf16*)(ws + WS_WQU); bf16* WKVU = (bf16*)(ws + WS_WKVU); bf16* WO0 = (bf16*)(ws + WS_WO0); bf16* WR0 = (bf16*)(ws + WS_WR0);
    bf16* WQKV = (bf16*)(ws + WS_WQKV); bf16* WO1 = (bf16*)(ws + WS_WO1); bf16* WR1 = (bf16*)(ws + WS_WR1); unsigned char* WGU = ws + WS_WGU; unsigned char* WDN = ws + WS_WDN; unsigned char* X8 = ws + WS_X8;
    float* COS64 = (float*)(ws + WS_COS64); float* SIN64 = (float*)(ws + WS_SIN64); float* COS128 = (float*)(ws + WS_COS128); float* SIN128 = (float*)(ws + WS_SIN128);
    bf16* XB = (bf16*)(ws + WS_XB); bf16* PROJ = (bf16*)(ws + WS_PROJ); bf16* UG = (bf16*)(ws + WS_UG); bf16* QLN = (bf16*)(ws + WS_QLN); bf16* KVLN = (bf16*)(ws + WS_KVLN); bf16* KROPE = (bf16*)(ws + WS_KROPE);
    bf16* Q0 = (bf16*)(ws + WS_Q0); bf16* KV0 = (bf16*)(ws + WS_KV0); bf16* CAT = (bf16*)(ws + WS_CAT); bf16* QKV = (bf16*)(ws + WS_QKV); bf16* O2 = (bf16*)(ws + WS_O2);
    unsigned char* YS = ws + WS_XG + 136 * MiB; unsigned char* ACT = ws + WS_ACT;
    int* TKE = (int*)(ws + WS_TKE); float* TKG = (float*)(ws + WS_TKG); int* TKR = (int*)(ws + WS_TKR); int* TDEST = (int*)(ws + WS_TDEST); int* ROWTOK = (int*)(ws + WS_ROWTOK);
    const LAS int* tb = (const LAS int*)(F.lds + MOE_OFF);

    if (IN(0)) { PH_BEGIN();
        convert_matrix8<3>(F, args.in[1], 1024, 1728, (unsigned char*)WIN, 1, WGU_SC);  zero_bytes16(F, (unsigned char*)WIN + (size_t)704 * 1024, (size_t)64 * 1024);
        convert_matrix<0>(F, args.in[3], 384, 768, WQU, 1);
        convert_matrix<0>(F, args.in[5], 256, 1024, WKVU, 1);
        convert_matrix8<0>(F, args.in[10], 1024, 1024, (unsigned char*)WO0, 1, WDN_SC);
        convert_matrix<0>(F, args.in[13], 1024, 32, WR0, 1);
        convert_matrix8<2>(F, args.in[21], 1024, 3072, (unsigned char*)WQKV, 1, WGU_SC);
        convert_matrix8<0>(F, args.in[27], 1024, 1024, (unsigned char*)WO1, 1, WDN_SC);
        convert_matrix<0>(F, args.in[30], 1024, 32, WR1, 1);
        convert_matrix8<1>(F, args.in[15], 1024, 2048, WGU, NEXP, WGU_SC);
        convert_matrix8<0>(F, args.in[17], 1024, 1024, WDN, NEXP, WDN_SC);
        rows_to_bf16(F, x, XB, X8);
        rope_tables(F, COS64, SIN64, 32); rope_tables(F, COS128, SIN128, 64);
        if (BOTH(0)) GRID_BAR();
    }
    if (IN(1)) { PH_BEGIN();
        pg8::Gemm g{(const bf16*)X8, WIN, T, NPROJ, 512}; pg8::StaticOrder S; S.init(T, NPROJ, F.G, (int)blockIdx.x);
        pg8::EpiInProj E{PROJ, UG, 1.0f / (XSC * WGU_SC)};
        pg8::gemm_phase<pg8::EpiInProj, pg8::StaticOrder, true, true, true>(F.lds, g, S, E);
        if (BOTH(1)) GRID_BAR();
    }
    if (IN(2)) { PH_BEGIN();
        conv_prefetch(F, UG);
        mid0_rows(F, PROJ, args.in[2], args.in[4], COS64, SIN64, QLN, KVLN, KROPE);
        conv_phase(F, UG, args.in[6], args.in[7], args.in[8], args.in[9], CAT);
        if (BOTH(2)) GRID_BAR();
    }
    if (IN(3)) { PH_BEGIN();
        { pg8::Gemm g{QLN, WQU, T, 768, 384}; pg8::StaticOrder S; S.init(T, 768, F.G, (int)blockIdx.x); pg8::EpiBf16 E{Q0, 768, 1.0f};
          pg8::gemm_phase<pg8::EpiBf16, pg8::StaticOrder, true, true>(F.lds, g, S, E); }
        { pg8::Gemm g{KVLN, WKVU, T, 1024, 256}; pg8::StaticOrder S; S.init(T, 1024, F.G, (int)blockIdx.x); pg8::EpiBf16 E{KV0, 1024, 1.0f};
          pg8::gemm_phase<pg8::EpiBf16, pg8::StaticOrder, true, true>(F.lds, g, S, E); }
        if (BOTH(3)) GRID_BAR();
    }
    if (IN(4)) { PH_BEGIN();
        const bf16* q = Q0; const bf16* kv = KV0; const bf16* krp = KROPE; bf16* cat = CAT;
        auto ref = [=](int bh, int qb) { const int b = bh >> 2, h = bh & 3; const size_t rb = (size_t)b * SEQ, r0 = rb + (size_t)qb * 256;
            return att::BlockRef{q + r0 * 768 + h * 192, kv + rb * 1024 + h * 256, krp + rb * 64, kv + rb * 1024 + h * 256 + 128, (bf16*)((unsigned char*)cat + r0 * 1024 + h * 128)  , qb * 256}; };
        att::phase<AttL0>((char*)lds, F.vcu, F.G, 8 * 4 * 8, ref, COS64, SIN64);
        if (BOTH(4)) GRID_BAR();
    }
    if (IN(5)) { PH_BEGIN();
        pg8::Gemm g{CAT, WO0, T, D, D / 2}; pg8::StaticOrder S; S.init(T, D, F.G, (int)blockIdx.x); pg8::EpiResBf16 E{XB, VB, DN_ALPHA, 1.0f / (CAT_SC * WDN_SC)};
        pg8::gemm_phase<pg8::EpiResBf16, pg8::StaticOrder, true, true, true>(F.lds, g, S, E);
        if (BOTH(5)) GRID_BAR();
    }
    if (IN(8)) { PH_BEGIN(); topk_phase(F, XB, WR0, args.in[14], (unsigned*)(F.ctl + CW_CNT), TKE, TKG, TKR, ROWTOK, VB, args.in[11], args.in[12], X8); if (BOTH(8)) GRID_BAR(); }
    if (IN(10)) { PH_BEGIN();
        moe_tables(F, (const unsigned*)(F.ctl + CW_CNT));
        pg8::Gemm g{(const bf16*)X8, (const bf16*)WGU, MAXROWS, 2048, D / 2}; const pg8::GatherA GA{ROWTOK, (LAS int*)(F.lds + RING_BYTES), T - 1, tb, T}; pg8::MoeOrder S; S.init(tb[33], 8, F.G, (int)blockIdx.x, tb + 64); pg8::EpiSwiGLU E{ACT, args.in[16], 1.0f / (XSC * WGU_SC), ACT_SC, (LAS float*)(F.lds + RING_BYTES + 2048)};
        pg8::gemm_phase<pg8::EpiSwiGLU, pg8::MoeOrder, true, true, true, true>(F.lds, g, S, E, GA);
        if (BOTH(10)) GRID_BAR();
    }
    if (IN(11)) { PH_BEGIN();
        if (MK_PER_PHASE) moe_tables(F, (const unsigned*)(F.ctl + CW_CNT));
        pg8::Gemm g{(const bf16*)ACT, (const bf16*)WDN, MAXROWS, D, D / 2}; pg8::MoeOrder S; S.init(tb[33], 4, F.G, (int)blockIdx.x, tb + 64); pg8::EpiDown E{YS, args.in[18], 1.0f / (ACT_SC * WDN_SC), YSC, (LAS float*)(F.lds + RING_BYTES + 2048)};
        pg8::gemm_phase<pg8::EpiDown, pg8::MoeOrder, true, true, true>(F.lds, g, S, E);
        if (BOTH(11)) GRID_BAR();
    }
    if (IN(12)) { PH_BEGIN();
        if (MK_PER_PHASE) moe_tables(F, (const unsigned*)(F.ctl + CW_CNT));
        ln_phase<true, false>(F, XB, args.in[19], args.in[20], XB, X8, nullptr, YS, TKE, TKG);
        if (BOTH(12)) GRID_BAR();
    }
    if (IN(13)) { PH_BEGIN();
        pg8::Gemm g{(const bf16*)X8, WQKV, T, 3072, D / 2}; pg8::StaticOrder S; S.init(T, 3072, F.G, (int)blockIdx.x); pg8::EpiQKV E{QKV, COS128, SIN128, 1.0f / (XSC * WGU_SC), F.lds + RING_BYTES + 4096};
        pg8::gemm_phase<pg8::EpiQKV, pg8::StaticOrder, true, true, true>(F.lds, g, S, E);
        if (BOTH(13)) GRID_BAR();
    }
    if (IN(15)) { PH_BEGIN();
        const bf16* qkv = QKV; bf16* o2 = O2;
        auto ref = [=](int cb, int qb) { const int hm = cb & 7, b = cb >> 3; const size_t rb = (size_t)b * SEQ, r0 = rb + (size_t)qb * 128;
            return att2::BlockRef{qkv + r0 * 3072 + hm * 128, qkv + rb * 3072 + 1024 + hm * 128, qkv + rb * 3072 + 2048 + (hm >> 1) * 256, o2 + r0 * 2048 + hm * 256, qb * 128}; };
        att2::phase((char*)lds, F.vcu, F.G, 8 * 8 * 16, ref, COS128, SIN128, args.in[32], args.in[34], WGU, WDN);
        if (BOTH(15)) GRID_BAR();
    }
    if (IN(16)) { PH_BEGIN(); comb_phase(F, O2, args.in[22], args.in[23], args.in[24], args.in[25], args.in[26], (unsigned char*)CAT);     if (BOTH(16)) GRID_BAR(); }
    if (IN(17)) { PH_BEGIN();
        pg8::Gemm g{CAT, WO1, T, D, D / 2}; pg8::StaticOrder S; S.init(T, D, F.G, (int)blockIdx.x); pg8::EpiResBf16 E{XB, VB, DN_ALPHA, 1.0f / (CAT_SC * WDN_SC)};
        pg8::gemm_phase<pg8::EpiResBf16, pg8::StaticOrder, true, true, true>(F.lds, g, S, E);
        if (BOTH(17)) GRID_BAR();
    }
    if (IN(20)) { PH_BEGIN(); topk_phase(F, XB, WR1, args.in[31], (unsigned*)(F.ctl + CW_CNT + 64), TKE, TKG, TKR, ROWTOK, VB, args.in[28], args.in[29], X8); if (BOTH(20)) GRID_BAR(); }
    if (IN(22)) { PH_BEGIN();
        moe_tables(F, (const unsigned*)(F.ctl + CW_CNT + 64));
        pg8::Gemm g{(const bf16*)X8, (const bf16*)WGU, MAXROWS, 2048, D / 2}; const pg8::GatherA GA{ROWTOK, (LAS int*)(F.lds + RING_BYTES), T - 1, tb, T}; pg8::MoeOrder S; S.init(tb[33], 8, F.G, (int)blockIdx.x, tb + 64); pg8::EpiSwiGLU E{ACT, args.in[33], 1.0f / (XSC * WGU_SC), ACT_SC, (LAS float*)(F.lds + RING_BYTES + 2048)};
        pg8::gemm_phase<pg8::EpiSwiGLU, pg8::MoeOrder, true, true, true, true>(F.lds, g, S, E, GA);
        if (BOTH(22)) GRID_BAR();
    }
    if (IN(23)) { PH_BEGIN();
        if (MK_PER_PHASE) moe_tables(F, (const unsigned*)(F.ctl + CW_CNT + 64));
        pg8::Gemm g{(const bf16*)ACT, (const bf16*)WDN, MAXROWS, D, D / 2}; pg8::MoeOrder S; S.init(tb[33], 4, F.G, (int)blockIdx.x, tb + 64); pg8::EpiDown E{YS, args.in[35], 1.0f / (ACT_SC * WDN_SC), YSC, (LAS float*)(F.lds + RING_BYTES + 2048)};
        pg8::gemm_phase<pg8::EpiDown, pg8::MoeOrder, true, true, true>(F.lds, g, S, E);
        if (BOTH(23)) GRID_BAR();
    }
    if (IN(24)) { PH_BEGIN(); if (MK_PER_PHASE) moe_tables(F, (const unsigned*)(F.ctl + CW_CNT + 64)); ln_phase<true, true>(F, XB, args.in[36], args.in[37], nullptr, nullptr, OUT, YS, TKE, TKG); }
#undef IN
#undef BOTH
#undef GRID_BAR
}

extern "C" void kernel_launch(void* const* d_in, const int* in_sizes, int n_in, void* d_out, int out_size, void* d_ws, size_t ws_size, hipStream_t stream) {
    static int grid = 0;
    if (grid == 0) {
        if (n_in != 38 || in_sizes[0] != T * D || out_size != T * D || ws_size < WS_END) { fprintf(stderr, "kernel_launch: unexpected shapes (n_in %d, in0 %d, out %d, ws %zu < %zu)\n", n_in, n_in > 0 ? in_sizes[0] : -1, out_size, ws_size, (size_t)WS_END); grid = -1; return; }
        int dev = 0, cus = 0, per_cu = 0;
        if (hipGetDevice(&dev) != hipSuccess || hipDeviceGetAttribute(&cus, hipDeviceAttributeMultiprocessorCount, dev) != hipSuccess) { grid = -1; return; }
        if (hipFuncSetAttribute((const void*)mega_fwd, hipFuncAttributeMaxDynamicSharedMemorySize, LDS_BYTES) != hipSuccess) { fprintf(stderr, "kernel_launch: hipFuncSetAttribute failed\n"); grid = -1; return; }
        if (hipOccupancyMaxActiveBlocksPerMultiprocessor(&per_cu, (const void*)mega_fwd, NWAVES * 64, LDS_BYTES) != hipSuccess || per_cu < 1) { fprintf(stderr, "kernel_launch: occupancy query says %d\n", per_cu); }
        (void)hipGetLastError();
        grid = cus;
    }
    if (grid < 0) return;
    if (hipMemsetAsync((char*)d_ws + WS_CTL, 0, CTL_ZERO_BYTES, stream) != hipSuccess) return;
    Args a{};
    for (int i = 0; i < 38; ++i) a.in[i] = (const float*)d_in[i];
    a.out = (float*)d_out; a.ws = (unsigned char*)d_ws; a.li = 0; a.pad = 0;
#if MK_PER_PHASE
    for (int p = 0; p < NPHASE; ++p) { a.ph_lo = p; a.ph_hi = p + 1; hipLaunchKernelGGL(mega_fwd, dim3(grid), dim3(NWAVES * 64), LDS_BYTES, stream, a); }
#else
    a.ph_lo = 0; a.ph_hi = NPHASE;
    hipLaunchKernelGGL(mega_fwd, dim3(grid), dim3(NWAVES * 64), LDS_BYTES, stream, a);
#endif
}
```

```cpp
#include <hip/hip_runtime.h>
#include <cstdio>
#include <cstdint>
__device__ __forceinline__ int tid_opaque() { int t = threadIdx.x; asm volatile("" : "+v"(t)); return t; }
namespace pg8 {
#define PG8_LAS __attribute__((address_space(3)))
typedef unsigned short bf16_t;
typedef short bf16x8 __attribute__((ext_vector_type(8)));
typedef short bf16x16 __attribute__((ext_vector_type(16)));
typedef int v8i __attribute__((ext_vector_type(8)));
typedef int v4i __attribute__((ext_vector_type(4)));
typedef float f32x4 __attribute__((ext_vector_type(4)));
typedef unsigned u32x4 __attribute__((ext_vector_type(4)));
constexpr int BM = 256, BK = 64, HALF = 128, HTB = HALF * BK * 2  , STAGE_BYTES = 8 * HTB, NXCD = 8, WGM = 8;

__host__ __device__ __forceinline__ int lds_byte(int r, int c) { const int st = (r >> 4) * 2 + (c >> 5), rr = r & 15, cc = c & 31, ob = rr * 64 + cc * 2; return st * 1024 + (ob ^ (((ob >> 9) & 1) << 5)); }
__host__ __device__ __forceinline__ void stage_rc(int b, int& R, int& C) { const int st = b / 1024, sb = b % 1024, swz = sb ^ (((sb >> 9) & 1) << 5); R = (st >> 1) * 16 + swz / 64; C = (st & 1) * 32 + (swz % 64) / 2; }
__host__ __device__ __forceinline__ int perm32(int rho) { const int n = rho >> 4, i = rho & 15; return 8 * (i >> 2) + 4 * n + (i & 3); }

struct Unit { int pm, pn; };
struct Gemm { const bf16_t* A; const bf16_t* Bt; int M, N, K; };

struct StaticOrder {
    int nM, nN, nwg, G, c;
    __host__ __device__ void init(int M, int N, int G_, int c_) { nM = M / BM; nN = N / BM; nwg = nM * nN; G = G_; c = c_; }
    __host__ __device__ bool next(int i, Unit& u) const {
        const long L = (long)i * G + c; if (L >= nwg) return false;
        int wgid = (int)L; { const int q = nwg / NXCD, r = nwg % NXCD, xcd = wgid % NXCD, off = wgid / NXCD; wgid = (xcd < r ? xcd * (q + 1) : r * (q + 1) + (xcd - r) * q) + off; }
        const int nig = WGM * nN, gid = wgid / nig, fm = gid * WGM, gsz = (nM - fm) < WGM ? (nM - fm) : WGM;
        u.pm = fm + ((wgid % nig) % gsz); u.pn = (wgid % nig) / gsz; return true;
    }
    __device__ __forceinline__ void a_ready(const Unit&) const {}
    __device__ __forceinline__ void done(const Unit&) const {}
};

__device__ __forceinline__ unsigned cvt_pk_bf16(float lo, float hi) { unsigned r; asm volatile("v_cvt_pk_bf16_f32 %0, %1, %2" : "=v"(r) : "v"(lo), "v"(hi)); return r; }
typedef float f32x2 __attribute__((ext_vector_type(2)));
__device__ __forceinline__ u32x4 pack8_bf16(const f32x4 v0, const f32x4 v1) { u32x4 w; w.x = cvt_pk_bf16(v0[0], v0[1]); w.y = cvt_pk_bf16(v0[2], v0[3]); w.z = cvt_pk_bf16(v1[0], v1[1]); w.w = cvt_pk_bf16(v1[2], v1[3]); return w; }
constexpr int TB_STRIDE = 528, TB_BYTES = 32 * TB_STRIDE;
#define PG8_LBAR() asm volatile("s_waitcnt lgkmcnt(0)\n\ts_barrier" ::: "memory")
template <class RowFn>
__device__ __forceinline__ void tile_rows_step_at(PG8_LAS unsigned char* tb, int wr, int fr, int piece0, int dist, int wid, int lane, const u32x4 w0, const u32x4 w1, const RowFn& rowfn) {
    PG8_LAS unsigned char* wp = tb + (wr * 16 + fr) * TB_STRIDE + piece0;
    *(PG8_LAS u32x4*)wp = w0; *(PG8_LAS u32x4*)(wp + dist) = w1;
    PG8_LBAR();
#pragma unroll
    for (int j = 0; j < 2; ++j) { const int rl = 4 * wid + 2 * j + (lane >> 5), ch = lane & 31;
        const u32x4 d = *(const PG8_LAS u32x4*)(tb + rl * TB_STRIDE + ch * 16);
        rowfn(j, rl, ch, d); }
    PG8_LBAR();
}
template <class RowFn>
__device__ __forceinline__ void tile_rows_step(PG8_LAS unsigned char* tb, int wr, int wc, int fr, int fq, const u32x4 w0, const u32x4 w1, const RowFn& rowfn) {
    tile_rows_step_at(tb, wr, fr, wc * 64 + fq * 16, 256, wr * 4 + wc, fq * 16 + fr, w0, w1, rowfn);
}
__device__ __forceinline__ int tile_row(int pm, int ai, int m, int rl) { return pm * BM + ai * HALF + (rl >> 4) * 64 + m * 16 + (rl & 15); }
struct EpiBf16 {
    static constexpr bool PERM = true, AFTER_DRAIN = false, LDS_BIAS = false;
    bf16_t* O; int ldc; float sc;
    __device__ __forceinline__ void operator()(const f32x4 (&acc)[2][2][4][2], const Unit& u, int wr, int wc, int fr, int fq) const {
        const int row0 = u.pm * BM + wr * 64 + fr, col0 = u.pn * BM + wc * 32 + 8 * fq;
#pragma unroll
        for (int ai = 0; ai < 2; ++ai)
#pragma unroll
            for (int m = 0; m < 4; ++m) { bf16_t* rowp = O + (size_t)(row0 + ai * HALF + m * 16) * ldc + col0;
#pragma unroll
                for (int bj = 0; bj < 2; ++bj) *(u32x4*)(rowp + bj * HALF) = pack8_bf16(acc[ai][bj][m][0] * sc, acc[ai][bj][m][1] * sc); }
    }
};
struct EpiInProj {
    static constexpr bool PERM = true, AFTER_DRAIN = false, LDS_BIAS = false;
    bf16_t* proj; bf16_t* ug; float sc;
    __device__ __forceinline__ void operator()(const f32x4 (&acc)[2][2][4][2], const Unit& u, int wr, int wc, int fr, int fq) const {
        const int row0 = u.pm * BM + wr * 64 + fr;
        if (u.pn < 3) {
            const int col0 = u.pn * BM + wc * 32 + 8 * fq;
#pragma unroll
            for (int ai = 0; ai < 2; ++ai)
#pragma unroll
                for (int m = 0; m < 4; ++m) { bf16_t* rowp = proj + (size_t)(row0 + ai * HALF + m * 16) * 768 + col0;
#pragma unroll
                    for (int bj = 0; bj < 2; ++bj) *(u32x4*)(rowp + bj * HALF) = pack8_bf16(acc[ai][bj][m][0] * sc, acc[ai][bj][m][1] * sc); }
        } else {
            const int col0 = (u.pn - 3) * HALF + wc * 32 + 8 * fq; const float ks = -1.4426950408889634f * sc;
#pragma unroll
            for (int ai = 0; ai < 2; ++ai)
#pragma unroll
                for (int m = 0; m < 4; ++m) { f32x4 o[2];
#pragma unroll
                    for (int n = 0; n < 2; ++n)
#pragma unroll
                        for (int q = 0; q < 4; ++q) o[n][q] = acc[ai][0][m][n][q] * sc * __builtin_amdgcn_rcpf(1.0f + __builtin_amdgcn_exp2f(acc[ai][1][m][n][q] * ks));
                    *(u32x4*)(ug + (size_t)(row0 + ai * HALF + m * 16) * 512 + col0) = pack8_bf16(o[0], o[1]); }
        }
    }
};
struct EpiQKV {
    static constexpr bool PERM = true, AFTER_DRAIN = false, LDS_BIAS = false;
    bf16_t* O; const float* cs; const float* sn; float sc; PG8_LAS unsigned char* tb;
    __device__ __forceinline__ void operator()(const f32x4 (&acc)[2][2][4][2], const Unit& u, int wr, int wc, int fr, int fq) const {
        const int row0 = u.pm * BM + wr * 64 + fr, pm = u.pm; const float s_ = sc; PG8_LAS unsigned char* const tb_ = tb; const float* const cs_ = cs; const float* const sn_ = sn;
        if (u.pn < 8) {
            const int dim = (wc & 1) * 32 + 8 * fq; bf16_t* const Ot = O + u.pn * BM;
            const int wcx = (wc >> 1) * 4 + (wc & 1);
            f32x4 cq[3][4];
#define PG8_ROPE_LD(st) do { const int pos_ = (row0 + ((st) >> 2) * HALF + ((st) & 3) * 16) & 4095; const float* cp_ = cs_ + pos_ * 64 + dim; const float* sp_ = sn_ + pos_ * 64 + dim; \
                cq[(st) % 3][0] = *(const f32x4*)cp_; cq[(st) % 3][1] = *(const f32x4*)(cp_ + 4); cq[(st) % 3][2] = *(const f32x4*)sp_; cq[(st) % 3][3] = *(const f32x4*)(sp_ + 4); } while (0)
            PG8_ROPE_LD(0); PG8_ROPE_LD(1);
#pragma unroll
            for (int st = 0; st < 8; ++st) { const int ai = st >> 2, m = st & 3;
                if (st + 2 < 8) PG8_ROPE_LD(st + 2);
                const f32x4 c0 = cq[st % 3][0], c1 = cq[st % 3][1], s0 = cq[st % 3][2], s1 = cq[st % 3][3];
                const f32x4 a0 = acc[ai][0][m][0] * s_, a1 = acc[ai][0][m][1] * s_, b0 = acc[ai][1][m][0] * s_, b1 = acc[ai][1][m][1] * s_;
                bf16_t* rowp = O + (size_t)(row0 + ai * HALF + m * 16) * 3072 + (2 * u.pn + (wc >> 1)) * 128 + dim;
                *(u32x4*)rowp = pack8_bf16(a0 * c0 - b0 * s0, a1 * c1 - b1 * s1);
                *(u32x4*)(rowp + 64) = pack8_bf16(b0 * c0 + a0 * s0, b1 * c1 + a1 * s1); }
#undef PG8_ROPE_LD
        } else {
            const int col0 = u.pn * BM + wc * 32 + 8 * fq;
#pragma unroll
            for (int ai = 0; ai < 2; ++ai)
#pragma unroll
                for (int m = 0; m < 4; ++m) { bf16_t* rowp = O + (size_t)(row0 + ai * HALF + m * 16) * 3072 + col0;
#pragma unroll
                    for (int bj = 0; bj < 2; ++bj) *(u32x4*)(rowp + bj * HALF) = pack8_bf16(acc[ai][bj][m][0] * s_, acc[ai][bj][m][1] * s_); }
        }
    }
};
struct EpiResBf16 {
    static constexpr bool PERM = true, AFTER_DRAIN = false, LDS_BIAS = false;
    const bf16_t* res; bf16_t* vb; float alpha, sc;
    __device__ __forceinline__ void operator()(const f32x4 (&acc)[2][2][4][2], const Unit& u, int wr, int wc, int fr, int fq) const {
        const int row0 = u.pm * BM + wr * 64 + fr, col0 = u.pn * BM + wc * 32 + 8 * fq;
#pragma unroll
        for (int ai = 0; ai < 2; ++ai)
#pragma unroll
            for (int m = 0; m < 4; ++m) { const size_t off = (size_t)(row0 + ai * HALF + m * 16) * 1024 + col0;
#pragma unroll
                for (int bj = 0; bj < 2; ++bj) { const u32x4 r = *(const u32x4*)(res + off + bj * HALF);
                    f32x4 v0, v1;
                    v0[0] = __uint_as_float(r.x << 16); v0[1] = __uint_as_float(r.x & 0xffff0000u); v0[2] = __uint_as_float(r.y << 16); v0[3] = __uint_as_float(r.y & 0xffff0000u);
                    v1[0] = __uint_as_float(r.z << 16); v1[1] = __uint_as_float(r.z & 0xffff0000u); v1[2] = __uint_as_float(r.w << 16); v1[3] = __uint_as_float(r.w & 0xffff0000u);
                    *(u32x4*)(vb + off + bj * HALF) = pack8_bf16(v0 * alpha + acc[ai][bj][m][0] * sc, v1 * alpha + acc[ai][bj][m][1] * sc); } }
    }
};
struct EpiRouter {
    static constexpr bool PERM = false, AFTER_DRAIN = false, LDS_BIAS = false;
    float* lg; const float* bias;
    __device__ __forceinline__ void operator()(const f32x4 (&acc)[2][2][4][2], const Unit& u, int wr, int wc, int fr, int fq) const {
        if (wc != 0) return;
        const int row0 = u.pm * BM + wr * 64 + fr;
        const f32x4 b0 = *(const f32x4*)(bias + 4 * fq), b1 = *(const f32x4*)(bias + 16 + 4 * fq);
#pragma unroll
        for (int ai = 0; ai < 2; ++ai)
#pragma unroll
            for (int m = 0; m < 4; ++m) { float* p = lg + (size_t)(row0 + ai * HALF + m * 16) * 32 + 4 * fq;
                *(f32x4*)p = acc[ai][0][m][0] + b0; *(f32x4*)(p + 16) = acc[ai][0][m][1] + b1; }
    }
};
typedef unsigned u32x2 __attribute__((ext_vector_type(2)));
__device__ __forceinline__ float clamp448(float v) { return fminf(fmaxf(v, -448.0f), 448.0f); }
__device__ __forceinline__ unsigned pk4_fp8(float a, float b, float c, float d) { int w = __builtin_amdgcn_cvt_pk_fp8_f32(clamp448(a), clamp448(b), 0, false); w = __builtin_amdgcn_cvt_pk_fp8_f32(clamp448(c), clamp448(d), w, true); return (unsigned)w; }
struct EpiSwiGLU {
    static constexpr bool PERM = true, AFTER_DRAIN = false, LDS_BIAS = true;
    unsigned char* act; const float* bgu; float in_scale, out_scale; PG8_LAS float* bl;
    __device__ __forceinline__ const float* bias_src(const Unit& u, int lane) const { return bgu + (size_t)(u.pn >> 3) * 2048 + (lane >> 5) * 1024 + (u.pn & 7) * HALF + (lane & 31) * 4; }
    __device__ __forceinline__ void operator()(const f32x4 (&acc)[2][2][4][2], const Unit& u, int wr, int wc, int fr, int fq, int par) const {
        constexpr float C = 1.702f * 1.4426950408889634f;
        const int j = u.pn & 7, row0 = u.pm * BM + wr * 64 + fr, cw = j * HALF + wc * 32 + 8 * fq;
        const PG8_LAS float* bg = bl + par * 256 + wc * 32 + 8 * fq;
        const f32x4 bg0 = *(const PG8_LAS f32x4*)bg, bg1 = *(const PG8_LAS f32x4*)(bg + 4), bu0 = *(const PG8_LAS f32x4*)(bg + 128), bu1 = *(const PG8_LAS f32x4*)(bg + 132);
        const float k1 = -C * in_scale, K2 = -out_scale / C;
        f32x2 bgs[2][2], bu[2][2];
#pragma unroll
        for (int p = 0; p < 2; ++p) { bgs[0][p] = (f32x2){bg0[2 * p], bg0[2 * p + 1]} * -C; bgs[1][p] = (f32x2){bg1[2 * p], bg1[2 * p + 1]} * -C; bu[0][p] = (f32x2){bu0[2 * p], bu0[2 * p + 1]}; bu[1][p] = (f32x2){bu1[2 * p], bu1[2 * p + 1]}; }
#pragma unroll
        for (int ai = 0; ai < 2; ++ai)
#pragma unroll
            for (int m = 0; m < 4; ++m) {
                f32x2 g2[4], u2[4], d2[4], s2[4], a2[4];
#pragma unroll
                for (int i = 0; i < 4; ++i) { const int n = i >> 1, p = i & 1;
                    g2[i] = (f32x2){acc[ai][0][m][n][2 * p], acc[ai][0][m][n][2 * p + 1]} * k1 + bgs[n][p];
                    u2[i] = (f32x2){acc[ai][1][m][n][2 * p], acc[ai][1][m][n][2 * p + 1]} * in_scale + bu[n][p]; }
#pragma unroll
                for (int i = 0; i < 4; ++i) { g2[i].x = __builtin_amdgcn_fmed3f(g2[i].x, -7.0f * C, 30.0f); g2[i].y = __builtin_amdgcn_fmed3f(g2[i].y, -7.0f * C, 30.0f); }
#pragma unroll
                for (int i = 0; i < 4; ++i) d2[i] = (f32x2){__builtin_amdgcn_exp2f(g2[i].x), __builtin_amdgcn_exp2f(g2[i].y)};
#pragma unroll
                for (int i = 0; i < 4; ++i) { u2[i].x = __builtin_amdgcn_fmed3f(u2[i].x, -7.0f, 7.0f); u2[i].y = __builtin_amdgcn_fmed3f(u2[i].y, -7.0f, 7.0f); }
#pragma unroll
                for (int i = 0; i < 4; ++i) d2[i] = d2[i] + 1.0f;
#pragma unroll
                for (int i = 0; i < 4; ++i) a2[i] = (u2[i] * K2 + K2) * g2[i];
                { const f32x2 p01 = d2[0] * d2[1], p23 = d2[2] * d2[3], pp = p01 * p23; const f32x2 r = (f32x2){__builtin_amdgcn_rcpf(pp.x), __builtin_amdgcn_rcpf(pp.y)};
                  const f32x2 r01 = r * p23, r23 = r * p01;
                  s2[0] = r01 * d2[1]; s2[1] = r01 * d2[0]; s2[2] = r23 * d2[3]; s2[3] = r23 * d2[2]; }
#pragma unroll
                for (int i = 0; i < 4; ++i) a2[i] = a2[i] * s2[i];
                int w0 = __builtin_amdgcn_cvt_pk_fp8_f32(a2[0].x, a2[0].y, 0, false); w0 = __builtin_amdgcn_cvt_pk_fp8_f32(a2[1].x, a2[1].y, w0, true);
                int w1 = __builtin_amdgcn_cvt_pk_fp8_f32(a2[2].x, a2[2].y, 0, false); w1 = __builtin_amdgcn_cvt_pk_fp8_f32(a2[3].x, a2[3].y, w1, true);
                *(u32x2*)(act + (size_t)(row0 + ai * HALF + m * 16) * 1024 + cw) = (u32x2){(unsigned)w0, (unsigned)w1}; }
    }
};
struct EpiDown {
    static constexpr bool PERM = true, AFTER_DRAIN = false, LDS_BIAS = true;
    unsigned char* ys; const float* bdn; float in_scale, out_scale; PG8_LAS float* bl;
    __device__ __forceinline__ const float* bias_src(const Unit& u, int lane) const { return bdn + (size_t)(u.pn >> 2) * 1024 + (u.pn & 3) * BM + lane * 4; }
    __device__ __forceinline__ void operator()(const f32x4 (&acc)[2][2][4][2], const Unit& u, int wr, int wc, int fr, int fq, int par) const {
        const int row0 = u.pm * BM + wr * 64 + fr, col0 = (u.pn & 3) * BM + wc * 32 + 8 * fq;
        f32x4 bv[2][2];
#pragma unroll
        for (int bj = 0; bj < 2; ++bj)
#pragma unroll
            for (int n = 0; n < 2; ++n) bv[bj][n] = *(const PG8_LAS f32x4*)(bl + par * 256 + bj * HALF + wc * 32 + 8 * fq + 4 * n) * out_scale;
        const float sc = in_scale * out_scale;
#pragma unroll
        for (int ai = 0; ai < 2; ++ai)
#pragma unroll
            for (int m = 0; m < 4; ++m) { const int row = row0 + ai * HALF + m * 16;
#pragma unroll
                for (int bj = 0; bj < 2; ++bj) { const f32x4 a = acc[ai][bj][m][0] * sc + bv[bj][0], b = acc[ai][bj][m][1] * sc + bv[bj][1];
                    *(u32x2*)(ys + (size_t)row * 1024 + col0 + bj * HALF) = (u32x2){pk4_fp8(a[0], a[1], a[2], a[3]), pk4_fp8(b[0], b[1], b[2], b[3])}; } }
    }
};
struct MoeOrder {
    int nM, nN, nwg, G, c; const PG8_LAS int* blk_e;
    __device__ void init(int nblk, int nN_, int G_, int c_, const PG8_LAS int* be) { nM = nblk; nN = nN_; nwg = nM * nN; G = G_; c = c_; blk_e = be; }
    __device__ bool next(int i, Unit& u) const {
        const long L = (long)i * G + c; if (L >= nwg) return false;
        int wgid = (int)L; { const int q = nwg / NXCD, r = nwg % NXCD, xcd = wgid % NXCD, off = wgid / NXCD; wgid = (xcd < r ? xcd * (q + 1) : r * (q + 1) + (xcd - r) * q) + off; }
        const int nig = WGM * nN, gid = wgid / nig, fm = gid * WGM, gsz = (nM - fm) < WGM ? (nM - fm) : WGM;
        u.pm = fm + ((wgid % nig) % gsz); const int pl = (wgid % nig) / gsz; u.pn = blk_e[u.pm] * nN + pl; return true;
    }
    __device__ __forceinline__ void a_ready(const Unit&) const {}
    __device__ __forceinline__ void done(const Unit&) const {}
};
struct GatherA { const int* rowtok; PG8_LAS int* idx; int maxrow; const PG8_LAS int* tb; int estride;
    __device__ __forceinline__ const int* src(int pm) const { if (tb == nullptr) return rowtok + (size_t)pm * BM; const int e = tb[64 + pm]; return rowtok + (size_t)e * estride + (pm * BM - tb[e]); } };
template <class Epi, class Sched, bool ALIGN_EPI = false, bool SP2 = false, bool FP8 = false, bool GATH = false>
__device__ __forceinline__ void gemm_phase(PG8_LAS unsigned char* lds, const Gemm g, const Sched& S, const Epi& E, const GatherA ga = GatherA{nullptr, nullptr, 0, nullptr, 0}) {
    static_assert(!GATH || SP2, "gathered A rows: SP2 loop only");
    const int tid = tid_opaque(), wid = __builtin_amdgcn_readfirstlane(tid >> 6), lane = tid & 63, wr = wid >> 2, wc = wid & 3, fr = lane & 15, fq = lane >> 4;
    const int K = g.K, nt = K / BK;
    unsigned voffA[2], voffB[2];
#pragma unroll
    for (int i = 0; i < 2; ++i) { int R, C; stage_rc(tid * 16 + i * 8192, R, C); const int Rb = Epi::PERM ? ((R & ~31) + perm32(R & 31)) : R;
        voffA[i] = GATH ? (unsigned)(R * 65536 + C * 2) : (unsigned)(R * K + C) * 2u; voffB[i] = (unsigned)(Rb * K + C) * 2u; }
    const size_t kstep = (size_t)(BK * 2);
    const size_t hstep = (size_t)HALF * K * 2;
    const size_t tstep = 2 * hstep;
    const unsigned ldsw = (unsigned)wid * 1024u;
    const int aoff = lds_byte(wr * 64 + fr, fq * 8), boff = lds_byte(wc * 32 + fr, fq * 8);
#define PG8_SA(b, h) (((b) * 2 + (h)) * HTB)
#define PG8_SB(b, h) ((4 + (b) * 2 + (h)) * HTB)
#define PG8_STAGE(bufoff, gbase, voff) do { _Pragma("unroll") for (int _i = 0; _i < 2; ++_i) \
        __builtin_amdgcn_global_load_lds((const unsigned*)((const char*)(gbase) + (voff)[_i]), (PG8_LAS unsigned*)(lds + (bufoff) + ldsw + _i * 8192), 16, 0, 0); } while (0)
#define PG8_STAGE2(bufoff, gbase, o0, o1) do { \
        __builtin_amdgcn_global_load_lds((const unsigned*)((const char*)(gbase) + (o0)), (PG8_LAS unsigned*)(lds + (bufoff) + ldsw), 16, 0, 0); \
        __builtin_amdgcn_global_load_lds((const unsigned*)((const char*)(gbase) + (o1)), (PG8_LAS unsigned*)(lds + (bufoff) + ldsw + 8192), 16, 0, 0); } while (0)
#define PG8_STA(bufoff, bcont, bgath, o0, o1) do { if constexpr (GATH) PG8_STAGE2(bufoff, bgath, o0, o1); else PG8_STAGE(bufoff, bcont, voffA); } while (0)
#define PG8_GOFF(ix, d00, d01, d10, d11) do { const int r0_ = (int)(voffA[0] >> 16), r1_ = (int)(voffA[1] >> 16); const unsigned c0_ = voffA[0] & 0xffffu, c1_ = voffA[1] & 0xffffu; \
        const unsigned rb_ = (unsigned)K * 2u; const unsigned mx_ = (unsigned)ga.maxrow; \
        const unsigned t00_ = (unsigned)(ix)[r0_], t01_ = (unsigned)(ix)[r1_], t10_ = (unsigned)(ix)[128 + r0_], t11_ = (unsigned)(ix)[128 + r1_]; \
        d00 = (t00_ < mx_ ? t00_ : mx_) * rb_ + c0_; d01 = (t01_ < mx_ ? t01_ : mx_) * rb_ + c1_; d10 = (t10_ < mx_ ? t10_ : mx_) * rb_ + c0_; d11 = (t11_ < mx_ ? t11_ : mx_) * rb_ + c1_; } while (0)
#define PG8_LD8(p) __builtin_shufflevector(*(const PG8_LAS v4i*)(p), *(const PG8_LAS v4i*)((p) + 1024), 0, 1, 2, 3, 4, 5, 6, 7)
#define PG8_LDA(dst, b, h) do { if constexpr (FP8) { _Pragma("unroll") for (int m = 0; m < 4; ++m) dst##8[m] = PG8_LD8(lds + PG8_SA(b, h) + aoff + m * 2048); } \
        else { _Pragma("unroll") for (int m = 0; m < 4; ++m) _Pragma("unroll") for (int k = 0; k < 2; ++k) dst[m][k] = *(const PG8_LAS bf16x8*)(lds + PG8_SA(b, h) + aoff + m * 2048 + k * 1024); } } while (0)
#define PG8_LDB(dst, b, h) do { if constexpr (FP8) { _Pragma("unroll") for (int n = 0; n < 2; ++n) dst##8[n] = PG8_LD8(lds + PG8_SB(b, h) + boff + n * 2048); } \
        else { _Pragma("unroll") for (int n = 0; n < 2; ++n) _Pragma("unroll") for (int k = 0; k < 2; ++k) dst[n][k] = *(const PG8_LAS bf16x8*)(lds + PG8_SB(b, h) + boff + n * 2048 + k * 1024); } } while (0)
#define PG8_MMA(ai, bj, At, Bt) do { __builtin_amdgcn_s_setprio(1); if constexpr (FP8) { _Pragma("unroll") for (int m = 0; m < 4; ++m) _Pragma("unroll") for (int n = 0; n < 2; ++n) \
        asm volatile("v_mfma_f32_16x16x128_f8f6f4 %0, %1, %2, %0" : "+v"(acc[ai][bj][m][n]) : "v"(Bt##8[n]), "v"(At##8[m])); } \
    else { _Pragma("unroll") for (int m = 0; m < 4; ++m) _Pragma("unroll") for (int n = 0; n < 2; ++n) _Pragma("unroll") for (int k = 0; k < 2; ++k) \
        acc[ai][bj][m][n] = __builtin_amdgcn_mfma_f32_16x16x32_bf16(Bt[n][k], At[m][k], acc[ai][bj][m][n], 0, 0, 0); } __builtin_amdgcn_s_setprio(0); } while (0)
#define PG8_WAIT_V(n) asm volatile("s_waitcnt vmcnt(" #n ")" ::: "memory")
#define PG8_WAIT_L(n) asm volatile("s_waitcnt lgkmcnt(" #n ")" ::: "memory")
#define PG8_BAR __builtin_amdgcn_s_barrier()
#define PG8_BAR_() __builtin_amdgcn_s_barrier()
#define PG8_SCHED __builtin_amdgcn_sched_barrier(0)
    Unit cur, nxt; int ui = 0;
    if (!S.next(0, cur)) return;
    f32x4 acc[2][2][4][2];
#pragma unroll
    for (int a = 0; a < 2; ++a)
#pragma unroll
        for (int b = 0; b < 2; ++b)
#pragma unroll
            for (int m = 0; m < 4; ++m)
#pragma unroll
                for (int n = 0; n < 2; ++n) acc[a][b][m][n] = (f32x4){0.f, 0.f, 0.f, 0.f};
    bf16x8 At[4][2], B0[2][2], B1[2][2]; v8i At8[4], B08[2], B18[2];
    const char* cA = (const char*)g.A + (GATH ? (size_t)0 : (size_t)cur.pm * tstep); const char* cB = (const char*)g.Bt + (size_t)cur.pn * tstep;
    S.a_ready(cur);
    unsigned cv00 = 0, cv01 = 0, cv10 = 0, cv11 = 0, nv00 = 0, nv01 = 0, nv10 = 0, nv11 = 0;
    if constexpr (GATH) {
        if (wid == 0) __builtin_amdgcn_global_load_lds((const unsigned*)(ga.src(cur.pm) + lane * 4), (PG8_LAS unsigned*)ga.idx, 16, 0, 0);
        asm volatile("s_waitcnt vmcnt(0)" ::: "memory"); PG8_BAR_();
        PG8_GOFF(ga.idx, cv00, cv01, cv10, cv11);
    }
    if constexpr (SP2) {
        PG8_STAGE(PG8_SB(0, 0), cB, voffB); PG8_STAGE(PG8_SB(0, 1), cB + hstep, voffB); PG8_STA(PG8_SA(0, 0), cA, cA, cv00, cv01); PG8_STA(PG8_SA(0, 1), cA + hstep, cA, cv10, cv11);
        if (wr == 1) PG8_BAR;
        PG8_WAIT_V(2); PG8_BAR;
        PG8_STAGE(PG8_SB(1, 0), cB + kstep, voffB); PG8_STA(PG8_SA(1, 0), cA + kstep, cA + kstep, cv00, cv01); PG8_STAGE(PG8_SB(1, 1), cB + hstep + kstep, voffB);
        PG8_WAIT_V(6); PG8_BAR;
    } else {
        PG8_STAGE(PG8_SB(0, 0), cB, voffB); PG8_STAGE(PG8_SA(0, 0), cA, voffA); PG8_STAGE(PG8_SB(0, 1), cB + hstep, voffB); PG8_STAGE(PG8_SA(0, 1), cA + hstep, voffA);
        if (wr == 1) PG8_BAR;
        PG8_WAIT_V(4); PG8_BAR;
        PG8_STAGE(PG8_SB(1, 0), cB + kstep, voffB); PG8_STAGE(PG8_SA(1, 0), cA + kstep, voffA); PG8_STAGE(PG8_SB(1, 1), cB + hstep + kstep, voffB);
        PG8_WAIT_V(6); PG8_BAR;
    }
    for (;;) {
        const bool has_next = S.next(ui + 1, nxt);
        if constexpr (Epi::LDS_BIAS) { if (wid == 1) __builtin_amdgcn_global_load_lds((const unsigned*)E.bias_src(cur, lane), (PG8_LAS unsigned*)(E.bl + (ui & 1) * 256), 16, 0, 0); }
        const char* nA = (has_next && !GATH) ? (const char*)g.A + (size_t)nxt.pm * tstep : cA; const char* nB = has_next ? (const char*)g.Bt + (size_t)nxt.pn * tstep : cB;
        if constexpr (GATH) { if (has_next && wid == 0) __builtin_amdgcn_global_load_lds((const unsigned*)(ga.src(nxt.pm) + lane * 4), (PG8_LAS unsigned*)(ga.idx + ((ui + 1) & 1) * BM), 16, 0, 0); }
#pragma nounroll
        for (int t = 0; t < nt; t += 2) {
            const bool last = (t == nt - 2);
            const char* a1 = cA + (size_t)(t + 1) * kstep;
            const char* a2 = last ? nA : cA + (size_t)(t + 2) * kstep; const char* b2 = last ? nB : cB + (size_t)(t + 2) * kstep;
            const char* a3 = a2 + kstep; const char* b3 = b2 + kstep;
            if (last && has_next) S.a_ready(nxt);
            unsigned x00 = cv00, x01 = cv01, x10 = cv10, x11 = cv11;
            if constexpr (GATH) { if (last) { if (has_next) { PG8_GOFF(ga.idx + ((ui + 1) & 1) * BM, nv00, nv01, nv10, nv11); } else { nv00 = cv00; nv01 = cv01; nv10 = cv10; nv11 = cv11; }
                x00 = nv00; x01 = nv01; x10 = nv10; x11 = nv11; } }
            if constexpr (SP2) {
            PG8_LDB(B0, 0, 0); PG8_LDB(B1, 0, 1); PG8_SCHED; PG8_LDA(At, 0, 0); PG8_STA(PG8_SA(1, 1), a1 + hstep, a1, cv10, cv11);
            PG8_WAIT_V(8); PG8_WAIT_L(0); PG8_BAR; PG8_MMA(0, 0, At, B0); PG8_MMA(0, 1, At, B1); PG8_BAR; PG8_SCHED;
            PG8_LDA(At, 0, 1); PG8_STAGE(PG8_SB(0, 0), b2, voffB); PG8_STAGE(PG8_SB(0, 1), b2 + hstep, voffB); PG8_STA(PG8_SA(0, 0), a2, a2, x00, x01);
            PG8_WAIT_V(8); PG8_WAIT_L(0); PG8_BAR; PG8_MMA(1, 0, At, B0); PG8_MMA(1, 1, At, B1); PG8_BAR; PG8_SCHED;
            PG8_LDB(B0, 1, 0); PG8_LDB(B1, 1, 1); PG8_SCHED; PG8_LDA(At, 1, 0); PG8_STA(PG8_SA(0, 1), a2 + hstep, a2, x10, x11);
            PG8_WAIT_V(8); PG8_WAIT_L(0); PG8_BAR; PG8_MMA(0, 0, At, B0); PG8_MMA(0, 1, At, B1); PG8_BAR; PG8_SCHED;
            PG8_LDA(At, 1, 1); PG8_STAGE(PG8_SB(1, 0), b3, voffB); PG8_STAGE(PG8_SB(1, 1), b3 + hstep, voffB); PG8_STA(PG8_SA(1, 0), a3, a3, x00, x01);
            PG8_WAIT_V(8); PG8_WAIT_L(0); PG8_BAR; PG8_MMA(1, 0, At, B0); PG8_MMA(1, 1, At, B1); PG8_BAR; PG8_SCHED;
            } else {
            PG8_LDB(B0, 0, 0); PG8_SCHED; PG8_LDA(At, 0, 0); PG8_STAGE(PG8_SA(1, 1), a1 + hstep, voffA);
            PG8_WAIT_L(8); PG8_BAR; PG8_WAIT_L(0); PG8_MMA(0, 0, At, B0); PG8_BAR; PG8_SCHED;
            PG8_LDB(B1, 0, 1); PG8_STAGE(PG8_SB(0, 0), b2, voffB);
            PG8_BAR; PG8_WAIT_L(0); PG8_MMA(0, 1, At, B1); PG8_BAR;
            PG8_LDA(At, 0, 1); PG8_STAGE(PG8_SA(0, 0), a2, voffA);
            PG8_BAR; PG8_WAIT_L(0); PG8_MMA(1, 0, At, B0); PG8_BAR; PG8_SCHED;
            PG8_STAGE(PG8_SB(0, 1), b2 + hstep, voffB);
            PG8_WAIT_V(6); PG8_BAR; PG8_MMA(1, 1, At, B1); PG8_BAR;
            PG8_LDB(B0, 1, 0); PG8_SCHED; PG8_LDA(At, 1, 0); PG8_STAGE(PG8_SA(0, 1), a2 + hstep, voffA);
            PG8_WAIT_L(8); PG8_BAR; PG8_WAIT_L(0); PG8_MMA(0, 0, At, B0); PG8_BAR; PG8_SCHED;
            PG8_LDB(B1, 1, 1); PG8_STAGE(PG8_SB(1, 0), b3, voffB);
            PG8_BAR; PG8_WAIT_L(0); PG8_MMA(0, 1, At, B1); PG8_BAR;
            PG8_LDA(At, 1, 1); PG8_STAGE(PG8_SA(1, 0), a3, voffA);
            PG8_BAR; PG8_WAIT_L(0); PG8_MMA(1, 0, At, B0); PG8_BAR; PG8_SCHED;
            PG8_STAGE(PG8_SB(1, 1), b3 + hstep, voffB);
            PG8_WAIT_V(6); PG8_BAR; PG8_MMA(1, 1, At, B1); PG8_BAR;
            }
        }
        if constexpr (ALIGN_EPI) { if (wr == 0) PG8_BAR; }
        if constexpr (FP8) asm volatile("s_nop 15\n\ts_nop 15" ::: "memory");
        if constexpr (!Epi::AFTER_DRAIN) { if constexpr (Epi::LDS_BIAS) E(acc, cur, wr, wc, fr, fq, ui & 1); else E(acc, cur, wr, wc, fr, fq); S.done(cur); }
        if (!has_next) break;
#pragma unroll
        for (int a = 0; a < 2; ++a)
#pragma unroll
            for (int b = 0; b < 2; ++b)
#pragma unroll
                for (int m = 0; m < 4; ++m)
#pragma unroll
                    for (int n = 0; n < 2; ++n) acc[a][b][m][n] = (f32x4){0.f, 0.f, 0.f, 0.f};
        cur = nxt; cA = nA; cB = nB; ++ui; cv00 = nv00; cv01 = nv01; cv10 = nv10; cv11 = nv11;
        if constexpr (ALIGN_EPI) { if (wr == 1) PG8_BAR; }
    }
    PG8_WAIT_V(0);
    if constexpr (!ALIGN_EPI) { if (wr == 0) PG8_BAR; }
    PG8_BAR;
    if constexpr (Epi::AFTER_DRAIN) { E.fused(acc, cur, wr, wc, fr, fq, lds, wid, lane); S.done(cur); }
#undef PG8_SA
#undef PG8_SB
#undef PG8_STAGE
#undef PG8_STAGE2
#undef PG8_STA
#undef PG8_GOFF
#undef PG8_BAR_
#undef PG8_LDA
#undef PG8_LDB
#undef PG8_MMA
#undef PG8_LD8
#undef PG8_WAIT_V
#undef PG8_WAIT_L
#undef PG8_BAR
#undef PG8_SCHED
}
}
namespace att {
constexpr float O8_SCALE = 64.0f;
typedef short bf16x8 __attribute__((ext_vector_type(8)));
typedef short s16x4 __attribute__((ext_vector_type(4)));
typedef float f32x16 __attribute__((ext_vector_type(16)));
typedef float f32x4 __attribute__((ext_vector_type(4)));
typedef unsigned u32x4 __attribute__((ext_vector_type(4)));
typedef unsigned short bf16;
constexpr int NW = 8, QBLK = 32, KVBLK = 64, QB = NW * QBLK, DV = 128;
constexpr int SHM_V = KVBLK * DV * 2;
constexpr float THR = 8.f;
#define ATT_SBAR() __builtin_amdgcn_sched_barrier(0)
#define ATT_LD16(base, uoff, voff) (*reinterpret_cast<const bf16x8*>((const char*)(base) + (size_t)(uoff) + (voff)))
__device__ __forceinline__ int v_st(int k, int c) { const int kk = (k & ~0xC) | ((k & 4) << 1) | ((k & 8) >> 1); return ((kk >> 3) * 4 + (c >> 5)) * 512 + ((kk & 7) * 32 + (c & 31)) * 2; }
__device__ __forceinline__ int v_rd_base(int lane) { return ((lane & 3) << 3) | (((lane >> 2) & 3) << 6) | (((lane >> 4) & 1) << 5) | (((lane >> 5) & 1) << 8); }
constexpr int v_rd_off(int d0, int ks, int half) { return d0 * 512 + ks * 4096 + half * 2048; }
__device__ __forceinline__ int crow(int r, int hi) { return (r & 3) + 8 * (r >> 2) + 4 * hi; }
__device__ __forceinline__ unsigned cvtpk(float lo, float hi) { unsigned r; asm volatile("v_cvt_pk_bf16_f32 %0, %1, %2" : "=v"(r) : "v"(lo), "v"(hi)); return r; }
__device__ __forceinline__ bf16x8 pack8(f32x4 a, f32x4 b) { u32x4 w = {cvtpk(a[0], a[1]), cvtpk(a[2], a[3]), cvtpk(b[0], b[1]), cvtpk(b[2], b[3])}; return *reinterpret_cast<bf16x8*>(&w); }
__device__ __forceinline__ bf16x8 load8(const bf16* p) { return *reinterpret_cast<const bf16x8*>(p); }
__device__ __forceinline__ void mask_tile(f32x16& p0, f32x16& p1, int dq, unsigned W) {
    const float NEG = -__builtin_inff();
#pragma unroll
    for (int r = 0; r < 16; ++r) {
        const int c = (r & 3) + 8 * (r >> 2);
        if ((unsigned)(dq - c) >= W) p0[r] = NEG;
        if ((unsigned)(dq - c - 32) >= W) p1[r] = NEG;
    }
}
template <int SCALE_E6>
__device__ __forceinline__ void partialSM(f32x16& p0, f32x16& p1, float& m_reg, float& mn, float& alpha) {
    constexpr float SCALE = SCALE_E6 * 1e-6f;
    float pmax = p0[0]; for (int r = 1; r < 16; ++r) pmax = fmaxf(pmax, p0[r]); for (int r = 0; r < 16; ++r) pmax = fmaxf(pmax, p1[r]);
    { auto rr = __builtin_amdgcn_permlane32_swap(__float_as_uint(pmax), __float_as_uint(pmax), false, false);
      pmax = fmaxf(__uint_as_float(rr[0]), __uint_as_float(rr[1])); }
    constexpr float C2 = 1.4426950408889634f * SCALE;
    if (__builtin_expect(__all((pmax - m_reg) * SCALE <= THR), 1)) { mn = m_reg; alpha = 1.f; }
    else { mn = fmaxf(m_reg, pmax); alpha = __builtin_amdgcn_exp2f((m_reg - mn) * C2); m_reg = mn; }
    const float mnL = -mn * C2;
    for (int r = 0; r < 16; ++r) p0[r] = fmaf(p0[r], C2, mnL); for (int r = 0; r < 16; ++r) p1[r] = fmaf(p1[r], C2, mnL);
    for (int r = 0; r < 16; ++r) p0[r] = __builtin_amdgcn_exp2f(p0[r]);
}
__device__ __forceinline__ void finishSM(f32x16& p0, f32x16& p1, float alpha, float& l_reg, bf16x8& pa0, bf16x8& pa1, bf16x8& pa2, bf16x8& pa3) {
    for (int r = 0; r < 16; ++r) p1[r] = __builtin_amdgcn_exp2f(p1[r]);
    float ps = 0; for (int r = 0; r < 16; ++r) ps += p0[r]; for (int r = 0; r < 16; ++r) ps += p1[r];
    { auto rr = __builtin_amdgcn_permlane32_swap(__float_as_uint(ps), __float_as_uint(ps), false, false);
      ps = __uint_as_float(rr[0]) + __uint_as_float(rr[1]); }
    l_reg = l_reg * alpha + ps;
#define ATT_PK4(P, B_, OUT) do { unsigned a0 = cvtpk(P[B_+0], P[B_+1]), a1 = cvtpk(P[B_+2], P[B_+3]);                          \
        unsigned b0 = cvtpk(P[B_+4], P[B_+5]), b1 = cvtpk(P[B_+6], P[B_+7]);                                             \
        auto r0 = __builtin_amdgcn_permlane32_swap(a0, b0, false, false); auto r1 = __builtin_amdgcn_permlane32_swap(a1, b1, false, false); \
        u32x4 w = {r0[0], r1[0], r0[1], r1[1]}; OUT = *reinterpret_cast<bf16x8*>(&w); } while (0)
    ATT_PK4(p0, 0, pa0); ATT_PK4(p0, 8, pa1); ATT_PK4(p1, 0, pa2); ATT_PK4(p1, 8, pa3);
#undef ATT_PK4
}
template <int DK> __device__ __forceinline__ int kswz(int row, int colB) { return row * (DK * 2 + 16) + colB; }
template <int DK, int KB, int NREG>
__device__ __forceinline__ void qkt(f32x16& p0, f32x16& p1, const char* K_lds, int r32, int hi, const bf16x8* qr, const char* qx) {
    constexpr int KSTR = DK * 2 + 16, SHM_K = KVBLK * KSTR, NCH = DK / 16;
    p0 = f32x16{}; p1 = f32x16{};
    const char* kb = K_lds + KB * SHM_K + kswz<DK>(r32, hi * 16);
#pragma unroll
    for (int d0 = 0; d0 < NCH; ++d0) { const char* a = kb + d0 * 32;
        bf16x8 b0 = *reinterpret_cast<const bf16x8*>(a);
        bf16x8 b1 = *reinterpret_cast<const bf16x8*>(a + 32 * KSTR);
        const bf16x8 qv = d0 < NREG ? qr[d0] : *reinterpret_cast<const bf16x8*>(qx + (d0 - NREG) * 1024);
        p0 = __builtin_amdgcn_mfma_f32_32x32x16_bf16(b0, qv, p0, 0, 0, 0);
        p1 = __builtin_amdgcn_mfma_f32_32x32x16_bf16(b1, qv, p1, 0, 0, 0); }
}
template <int VB>
__device__ __forceinline__ void pv_tile(f32x16* o, int vb0, bf16x8 pa0, bf16x8 pa1, bf16x8 pa2, bf16x8 pa3) {
#define ATT_TRRD(dst, off) asm volatile("ds_read_b64_tr_b16 %0, %1 offset:%2" : "=&v"(dst) : "v"(vb0), "i"(off) : "memory")
#define ATT_PV_D0(d0) do { s16x4 l0, l1, l2, l3, h0, h1, h2, h3; constexpr int b_ = VB * SHM_V + v_rd_off(d0, 0, 0); \
        ATT_TRRD(l0, b_); ATT_TRRD(h0, b_ + 2048); ATT_TRRD(l1, b_ + 4096); ATT_TRRD(h1, b_ + 6144); ATT_TRRD(l2, b_ + 8192); ATT_TRRD(h2, b_ + 10240); ATT_TRRD(l3, b_ + 12288); ATT_TRRD(h3, b_ + 14336); \
        asm volatile("s_waitcnt lgkmcnt(0)" ::: "memory"); ATT_SBAR();   \
        o[d0] = __builtin_amdgcn_mfma_f32_32x32x16_bf16(pa0, (bf16x8){l0[0], l0[1], l0[2], l0[3], h0[0], h0[1], h0[2], h0[3]}, o[d0], 0, 0, 0);   \
        o[d0] = __builtin_amdgcn_mfma_f32_32x32x16_bf16(pa1, (bf16x8){l1[0], l1[1], l1[2], l1[3], h1[0], h1[1], h1[2], h1[3]}, o[d0], 0, 0, 0);   \
        o[d0] = __builtin_amdgcn_mfma_f32_32x32x16_bf16(pa2, (bf16x8){l2[0], l2[1], l2[2], l2[3], h2[0], h2[1], h2[2], h2[3]}, o[d0], 0, 0, 0);   \
        o[d0] = __builtin_amdgcn_mfma_f32_32x32x16_bf16(pa3, (bf16x8){l3[0], l3[1], l3[2], l3[3], h3[0], h3[1], h3[2], h3[3]}, o[d0], 0, 0, 0); } while (0)
    ATT_PV_D0(0); ATT_PV_D0(1); ATT_PV_D0(2); ATT_PV_D0(3);
#undef ATT_PV_D0
#undef ATT_TRRD
}
template <int DK_, int QS_, int KS_, int VS_, int OS_, int ROFF_, int RH_, int SCALE_E6_> struct Cfg {
    static constexpr int DK = DK_, QS = QS_, KS = KS_, VS = VS_, OS = OS_, ROFF = ROFF_, RH = RH_, SCALE_E6 = SCALE_E6_;
    static constexpr int NCH = DK / 16, KSTR = DK * 2 + 16, SHM_K = KVBLK * KSTR, NREG = DK > 128 ? 7 : NCH  , QX_OFF = 2 * SHM_V + 2 * SHM_K + NW * 64 * 4, QX_WAVE = (NCH - NREG) * 1024, LDS_BYTES = QX_OFF + NW * QX_WAVE;
    static constexpr bool HAS_KR = DK > 128;
};
struct BlockRef { const bf16* Q; const bf16* K; const bf16* KR; const bf16* V; bf16* O; int P0; };
template <int NCH> struct Seam { bf16x8 qr[NCH]; bf16x8 st_v0, st_v1, st_k0, st_k1, st_k2; };

__device__ __forceinline__ float bf_lo(unsigned w) { return __uint_as_float(w << 16); }
__device__ __forceinline__ float bf_hi(unsigned w) { return __uint_as_float(w & 0xffff0000u); }
template <class C> __device__ __forceinline__ void rope_q(bf16x8* qr, const float* cs, const float* sn, int pos, int hi) {
#pragma unroll
    for (int i = 0; i < C::RH; ++i) {
        const unsigned toff = (unsigned)(pos * (C::RH * 16) + hi * 8) * 4u;
#define ATT_LDF4(base, uoff) (*reinterpret_cast<const f32x4*>((const char*)(base) + (size_t)(uoff) + toff))
        const f32x4 c0 = ATT_LDF4(cs, i * 64), c1 = ATT_LDF4(cs, i * 64 + 16), s0 = ATT_LDF4(sn, i * 64), s1 = ATT_LDF4(sn, i * 64 + 16);
#undef ATT_LDF4
        const u32x4 a = *reinterpret_cast<const u32x4*>(&qr[C::ROFF + i]), b = *reinterpret_cast<const u32x4*>(&qr[C::ROFF + C::RH + i]);
        u32x4 ya, yb;
#pragma unroll
        for (int w = 0; w < 4; ++w) {
            const float cl = w < 2 ? c0[2 * w] : c1[2 * w - 4], ch = w < 2 ? c0[2 * w + 1] : c1[2 * w - 3];
            const float sl = w < 2 ? s0[2 * w] : s1[2 * w - 4], sh = w < 2 ? s0[2 * w + 1] : s1[2 * w - 3];
            const float x1l = bf_lo(a[w]), x1h = bf_hi(a[w]), x2l = bf_lo(b[w]), x2h = bf_hi(b[w]);
            ya[w] = cvtpk(x1l * cl - x2l * sl, x1h * ch - x2h * sh);
            yb[w] = cvtpk(x2l * cl + x1l * sl, x2h * ch + x1h * sh);
        }
        qr[C::ROFF + i] = *reinterpret_cast<bf16x8*>(&ya); qr[C::ROFF + C::RH + i] = *reinterpret_cast<bf16x8*>(&yb);
    }
}
#define ATT_VMW() asm volatile("s_waitcnt vmcnt(0)" ::: "memory")
#define ATT_VMWN(n) asm volatile("s_waitcnt vmcnt(%0)" :: "i"(n) : "memory")
#define ATT_SLOAD(R, k0) do { S.st_v0 = ATT_LD16((R).V, (size_t)(k0) * (C::VS * 2), kvoff); S.st_v1 = ATT_LD16((R).V, (size_t)((k0) + 32) * (C::VS * 2), kvoff);              \
                         S.st_k0 = ATT_LD16((R).K, (size_t)(k0) * (C::KS * 2), kvoff); S.st_k1 = ATT_LD16((R).K, (size_t)((k0) + 32) * (C::KS * 2), kvoff);              \
                         if constexpr (C::HAS_KR) S.st_k2 = ATT_LD16((R).KR, (size_t)(k0) * 128, kroff); } while (0)
#define ATT_SWRITE_K(bf) do { *(bf16x8*)(K_lds + (bf) * C::SHM_K + kws) = S.st_k0; *(bf16x8*)(K_lds + (bf) * C::SHM_K + kws + 32 * C::KSTR) = S.st_k1; \
                         if constexpr (C::HAS_KR) *(bf16x8*)(K_lds + (bf) * C::SHM_K + kws2) = S.st_k2; } while (0)
#define ATT_SWRITE_V(bf) do { *(bf16x8*)(V_lds + (bf) * SHM_V + vst0) = S.st_v0; *(bf16x8*)(V_lds + (bf) * SHM_V + vst1) = S.st_v1; } while (0)
#define ATT_SWRITE(bf) do { ATT_SWRITE_V(bf); ATT_SWRITE_K(bf); } while (0)
template <class C>
__device__ __forceinline__ void prime(const BlockRef& cur, char* lds, Seam<C::NCH>& S) {
    const int tid = tid_opaque(), wid = __builtin_amdgcn_readfirstlane(tid >> 6), lane = tid & 63, r32 = lane & 31, hi = lane >> 5;
    const int sr = tid >> 4, sc = (tid & 15) * 8, kws = kswz<C::DK>(sr, sc * 2); char* K_lds = lds;
    const int kr = tid >> 3, kc = (tid & 7) * 8, kws2 = kswz<C::DK>(kr, (128 + kc) * 2);
    static_assert(C::KS == C::VS, "K and V share one per-lane offset");
    const unsigned kvoff = (unsigned)(sr * C::KS + sc) * 2u, kroff = (unsigned)(kr * 64 + kc) * 2u;
    const unsigned qoff = (unsigned)((wid * QBLK + r32) * C::QS + hi * 8) * 2u;
#pragma unroll
    for (int d0 = 0; d0 < C::NCH; ++d0) S.qr[d0] = ATT_LD16(cur.Q, d0 * 32, qoff);
    ATT_SLOAD(cur, 0); ATT_VMW(); ATT_SWRITE_K(0);
    __syncthreads();
}
template <class C>
__device__ __forceinline__ void block(const BlockRef& cur, const BlockRef& nxt, char* lds, Seam<C::NCH>& S, const float* rcos, const float* rsin) {
    const int tid = tid_opaque(), wid = __builtin_amdgcn_readfirstlane(tid >> 6), lane = tid & 63, r32 = lane & 31, hi = lane >> 5;
    const int NT = (cur.P0 + QB) / KVBLK;
    const unsigned W = 1u << 30;
    const int qlo = cur.P0 + wid * QBLK, qm = qlo + r32 - 4 * hi;
    char* V_lds = lds + 2 * C::SHM_K; char* K_lds = lds;
    float* ws = (float*)(lds + 2 * SHM_V + 2 * C::SHM_K) + wid * 64; float* li_l = ws, * al_l = ws + 32;
    float m_reg = -1e30f, l_reg = 0; f32x16 o[4] = {};
    const int sr = tid >> 4, sc = (tid & 15) * 8, vst0 = v_st(sr, sc), vst1 = v_st(32 + sr, sc), kws = kswz<C::DK>(sr, sc * 2);
    const int kr = tid >> 3, kc = (tid & 7) * 8, kws2 = kswz<C::DK>(kr, (128 + kc) * 2);
    const unsigned kvoff = (unsigned)(sr * C::KS + sc) * 2u, kroff = (unsigned)(kr * 64 + kc) * 2u;
    const int vb0 = (int)(uintptr_t)V_lds + v_rd_base(lane);
    rope_q<C>(S.qr, rcos, rsin, qlo + r32, hi);
    char* qx = lds + C::QX_OFF + wid * C::QX_WAVE + lane * 16;
    if constexpr (C::NREG < C::NCH) {
#pragma unroll
        for (int i = 0; i < C::NCH - C::NREG; ++i) *reinterpret_cast<bf16x8*>(qx + i * 1024) = S.qr[C::NREG + i];
    }
#define ATT_RESC(a) do { if (__any((a) < 1.f)) { if (hi == 0) al_l[r32] = (a); asm volatile("s_waitcnt lgkmcnt(0)" ::: "memory");              \
                     for (int d_ = 0; d_ < 4; ++d_) for (int r = 0; r < 16; ++r) o[d_][r] *= al_l[crow(r, hi)]; } } while (0)
#define ATT_KBASE(t) ((t) * KVBLK)
#define ATT_MASKT(P0_, P1_, t) do { const int kb_ = ATT_KBASE(t); if (kb_ + KVBLK - 1 > qlo) mask_tile(P0_, P1_, qm - kb_, W); } while (0)
#define ATT_SEAM_K0() do { ATT_VMWN(C::NCH == 8 ? 8 : C::NCH - 8); ATT_SWRITE_K(0); ATT_SBAR(); } while (0)
    f32x16 pA0, pA1, pB0, pB1; float mnA, mnB, alA, alB; bf16x8 pa0, pa1, pa2, pa3;
    ATT_SWRITE_V(0); ATT_SBAR();
    if (NT > 1) { ATT_SLOAD(cur, ATT_KBASE(1)); }
    ATT_SBAR(); qkt<C::DK, 0, C::NREG>(pA0, pA1, K_lds, r32, hi, S.qr, qx);
    ATT_MASKT(pA0, pA1, 0); partialSM<C::SCALE_E6>(pA0, pA1, m_reg, mnA, alA);
    if (NT > 1) { ATT_VMW(); ATT_SWRITE(1); }
    __syncthreads();
#define ATT_HALF_STEP(PX0, PX1, mnX, alX, PY0, PY1, alY, t, KB, VB, SB) do {                                                      \
        ATT_SBAR(); qkt<C::DK, KB, C::NREG>(PX0, PX1, K_lds, r32, hi, S.qr, qx);                                             \
        finishSM(PY0, PY1, alY, l_reg, pa0, pa1, pa2, pa3); ATT_SBAR();                                                           \
        if ((t) + 1 < NT) { ATT_SLOAD(cur, ATT_KBASE((t) + 1)); ATT_SBAR(); }                                               \
        pv_tile<VB>(o, vb0, pa0, pa1, pa2, pa3); ATT_MASKT(PX0, PX1, (t)); partialSM<C::SCALE_E6>(PX0, PX1, m_reg, mnX, alX);                                        \
        __syncthreads();                                                                                                      \
        if ((t) + 1 < NT) { ATT_VMW(); ATT_SWRITE(SB); }                                                                          \
        ATT_RESC(alX); __syncthreads(); } while (0)
    for (int t = 1; t + 1 < NT; t += 2) {
        ATT_HALF_STEP(pB0, pB1, mnB, alB, pA0, pA1, alA, t, 1, 0, 0);
        ATT_HALF_STEP(pA0, pA1, mnA, alA, pB0, pB1, alB, t + 1, 0, 1, 1);
    }
    ATT_SBAR(); qkt<C::DK, 1, C::NREG>(pB0, pB1, K_lds, r32, hi, S.qr, qx); ATT_SBAR();
    const unsigned qoff = (unsigned)((wid * QBLK + r32) * C::QS + hi * 8) * 2u;
    if constexpr (C::NCH == 8) { ATT_SLOAD(nxt, 0); ATT_SBAR(); }
#pragma unroll
    for (int d0 = 0; d0 < 8; ++d0) S.qr[d0] = ATT_LD16(nxt.Q, d0 * 32, qoff);
    ATT_SBAR();
    finishSM(pA0, pA1, alA, l_reg, pa0, pa1, pa2, pa3); ATT_SBAR();
    if constexpr (C::NCH > 8) {
        ATT_SLOAD(nxt, 0); ATT_SBAR();
#pragma unroll
        for (int d0 = 8; d0 < C::NCH; ++d0) S.qr[d0] = ATT_LD16(nxt.Q, d0 * 32, qoff);
        ATT_SBAR(); }
    pv_tile<0>(o, vb0, pa0, pa1, pa2, pa3);
    ATT_MASKT(pB0, pB1, NT - 1); partialSM<C::SCALE_E6>(pB0, pB1, m_reg, mnB, alB); __syncthreads(); ATT_RESC(alB);
    finishSM(pB0, pB1, alB, l_reg, pa0, pa1, pa2, pa3); ATT_SBAR(); pv_tile<1>(o, vb0, pa0, pa1, pa2, pa3);
    ATT_SBAR(); ATT_SEAM_K0();
    if (hi == 0) li_l[r32] = l_reg; asm volatile("s_waitcnt lgkmcnt(0)" ::: "memory");
    float rli[16];
#pragma unroll
    for (int r = 0; r < 16; ++r) rli[r] = __builtin_amdgcn_rcpf(li_l[crow(r, hi)]);
    const unsigned ooff = (unsigned)((wid * QBLK + 4 * hi) * C::OS + r32);
#pragma unroll
    for (int r = 0; r < 16; ++r) {
#pragma unroll
        for (int d0 = 0; d0 < 4; ++d0) { const float v = fminf(fmaxf(o[d0][r] * rli[r] * O8_SCALE, -448.f), 448.f);
            *reinterpret_cast<unsigned char*>((char*)cur.O + (size_t)(((r & 3) + 8 * (r >> 2)) * C::OS + d0 * 32) + ooff) = (unsigned char)(__builtin_amdgcn_cvt_pk_fp8_f32(v, v, 0, false) & 0xff); } }
    __syncthreads();
#undef ATT_RESC
#undef ATT_KBASE
#undef ATT_MASKT
#undef ATT_SEAM_K0
#undef ATT_HALF_STEP
}
struct Item { int bh, qb0, qb1; };
template <class C, class RefFn>
__device__ __forceinline__ void phase(char* lds, int vcu, int G, int total  , const RefFn& ref, const float* rcos, const float* rsin) {
    int L = vcu; if (L >= total) return;
    Item it{L >> 3, L & 7, 15 - (L & 7)}; int pass = 0;
    BlockRef cur = ref(it.bh, it.qb0);
    Seam<C::NCH> S;
    prime<C>(cur, lds, S);
    for (;;) {
        const bool more_pass = pass == 0, more_item = L + G < total, last = !more_pass && !more_item;
        Item itn = it; int passn = pass + 1, Ln = L;
        if (!more_pass) { passn = 0; Ln = more_item ? L + G : L; itn = Item{Ln >> 3, Ln & 7, 15 - (Ln & 7)}; }
        const BlockRef nxt = last ? cur : ref(itn.bh, passn ? itn.qb1 : itn.qb0);
        block<C>(cur, nxt, lds, S, rcos, rsin);
        if (last) break;
        cur = nxt; it = itn; pass = passn; L = Ln;
    }
}
}
namespace att2 {
using att::bf16x8; using att::s16x4; using att::f32x16; using att::f32x4; using att::u32x4; using att::bf16;
using att::v_st; using att::v_rd_base; using att::crow; using att::cvtpk; using att::mask_tile;
constexpr int KVBLK = 64, QB = 128, SHM_V = 64 * 128 * 2  , DK = 128, KSTR = DK * 2 + 16, SHM_K = KVBLK * KSTR;
constexpr int OFF_K = 0, OFF_V0 = 2 * SHM_K, OFF_V1 = OFF_V0 + 2 * SHM_V, OFF_WS = OFF_V1 + 2 * SHM_V, OFF_P = OFF_WS + 2048, LDS_BYTES = OFF_P + 4 * 4096;
constexpr int QS = 3072, KS = 3072, VS = 3072, OS = 2048, RH = 4, SCALE_E6 = 88388;
struct BlockRef { const bf16* Q; const bf16* K; const bf16* V; bf16* O; int P0; };
struct Seam { bf16x8 q0, q1, q2, q3, q4, q5, q6, q7; bf16x8 st0, st1, st2, st3; };
#define A2_SBAR() __builtin_amdgcn_sched_barrier(0)
#define A2_SG(mask, n) __builtin_amdgcn_sched_group_barrier(mask, n, 0)
#define A2_QK_G1() do { A2_SG(0x008, 2); A2_SG(0x100, 2); A2_SG(0x002, 24); } while (0)
#define A2_QK_G2() do { A2_SG(0x008, 2); A2_SG(0x002, 24); } while (0)
#define A2_QK_SCHED() do { A2_SG(0x100, 6); A2_QK_G1(); A2_QK_G1(); A2_QK_G1(); A2_QK_G1(); A2_QK_G1(); A2_QK_G2(); A2_QK_G2(); A2_QK_G2(); } while (0)
#define A2_LD16(base, uoff, voff) (*reinterpret_cast<const bf16x8*>((const char*)(base) + (size_t)(uoff) + (voff)))
#define A2_QLOAD(R) do { S.q0 = A2_LD16((R).Q, 0, qoff); S.q1 = A2_LD16((R).Q, 32, qoff); S.q2 = A2_LD16((R).Q, 64, qoff); S.q3 = A2_LD16((R).Q, 96, qoff); \
        S.q4 = A2_LD16((R).Q, 128, qoff); S.q5 = A2_LD16((R).Q, 160, qoff); S.q6 = A2_LD16((R).Q, 192, qoff); S.q7 = A2_LD16((R).Q, 224, qoff); } while (0)
#define A2_VMW() asm volatile("s_waitcnt vmcnt(0)" ::: "memory")
#define A2_VMWN(n) asm volatile("s_waitcnt vmcnt(%0)" :: "i"(n) : "memory")
#define A2_MIDBAR() asm volatile("s_waitcnt lgkmcnt(0)\n\ts_barrier" ::: "memory")
#define A2_SLOAD_K(R, k0) do { S.st0 = A2_LD16((R).K, (size_t)(k0) * (KS * 2), koff); S.st1 = A2_LD16((R).K, (size_t)((k0) + 16) * (KS * 2), koff); S.st2 = A2_LD16((R).K, (size_t)((k0) + 32) * (KS * 2), koff); S.st3 = A2_LD16((R).K, (size_t)((k0) + 48) * (KS * 2), koff); } while (0)
#define A2_SLOAD_V(R, k0) do { S.st0 = A2_LD16((R).V, (size_t)(k0) * (VS * 2), voff); S.q0 = A2_LD16((R).V, (size_t)(k0) * (VS * 2) + 256, voff); \
        S.st1 = A2_LD16((R).V, (size_t)((k0) + 16) * (VS * 2), voff); S.q1 = A2_LD16((R).V, (size_t)((k0) + 16) * (VS * 2) + 256, voff); \
        S.st2 = A2_LD16((R).V, (size_t)((k0) + 32) * (VS * 2), voff); S.q2 = A2_LD16((R).V, (size_t)((k0) + 32) * (VS * 2) + 256, voff); \
        S.st3 = A2_LD16((R).V, (size_t)((k0) + 48) * (VS * 2), voff); S.q3 = A2_LD16((R).V, (size_t)((k0) + 48) * (VS * 2) + 256, voff); } while (0)
#define A2_SLOAD_KQ(R, k0) do { S.q4 = A2_LD16((R).K, (size_t)(k0) * (KS * 2), koff); S.q5 = A2_LD16((R).K, (size_t)((k0) + 16) * (KS * 2), koff); S.q6 = A2_LD16((R).K, (size_t)((k0) + 32) * (KS * 2), koff); S.q7 = A2_LD16((R).K, (size_t)((k0) + 48) * (KS * 2), koff); } while (0)
#define A2_SWRITE_KQ(bf) do { char* kp_ = lds + OFF_K + (bf) * SHM_K + kws; *(bf16x8*)(kp_) = S.q4; *(bf16x8*)(kp_ + 16 * KSTR) = S.q5; *(bf16x8*)(kp_ + 32 * KSTR) = S.q6; *(bf16x8*)(kp_ + 48 * KSTR) = S.q7; } while (0)
#define A2_SWRITE_K(bf) do { char* kp_ = lds + OFF_K + (bf) * SHM_K + kws; *(bf16x8*)(kp_) = S.st0; *(bf16x8*)(kp_ + 16 * KSTR) = S.st1; *(bf16x8*)(kp_ + 32 * KSTR) = S.st2; *(bf16x8*)(kp_ + 48 * KSTR) = S.st3; } while (0)
#define A2_SWRITE_V(bf) do { char* v0_ = lds + OFF_V0 + (bf) * SHM_V; char* v1_ = lds + OFF_V1 + (bf) * SHM_V; \
        *(bf16x8*)(v0_ + vst0) = S.st0; *(bf16x8*)(v1_ + vst0) = S.q0; *(bf16x8*)(v0_ + vst1) = S.st1; *(bf16x8*)(v1_ + vst1) = S.q1; \
        *(bf16x8*)(v0_ + vst2) = S.st2; *(bf16x8*)(v1_ + vst2) = S.q2; *(bf16x8*)(v0_ + vst3) = S.st3; *(bf16x8*)(v1_ + vst3) = S.q3; } while (0)
template <int KB> __device__ __forceinline__ void qkt(f32x16& p0, f32x16& p1, const char* lds, int r32, int hi, const Seam& S) {
    const bf16x8 qr[8] = {S.q0, S.q1, S.q2, S.q3, S.q4, S.q5, S.q6, S.q7};
    p0 = f32x16{}; p1 = f32x16{};
    const char* kb = lds + OFF_K + KB * SHM_K + r32 * KSTR + hi * 16;
    bf16x8 ka[3], kc[3];
#pragma unroll
    for (int d0 = 0; d0 < 3; ++d0) { ka[d0] = *reinterpret_cast<const bf16x8*>(kb + d0 * 32); kc[d0] = *reinterpret_cast<const bf16x8*>(kb + d0 * 32 + 32 * KSTR); }
#pragma unroll
    for (int d0 = 0; d0 < 8; ++d0) {
        p0 = __builtin_amdgcn_mfma_f32_32x32x16_bf16(ka[d0 % 3], qr[d0], p0, 0, 0, 0);
        p1 = __builtin_amdgcn_mfma_f32_32x32x16_bf16(kc[d0 % 3], qr[d0], p1, 0, 0, 0);
        if (d0 + 3 < 8) { ka[d0 % 3] = *reinterpret_cast<const bf16x8*>(kb + (d0 + 3) * 32); kc[d0 % 3] = *reinterpret_cast<const bf16x8*>(kb + (d0 + 3) * 32 + 32 * KSTR); } }
}
typedef att::Cfg<128, QS, KS, VS, OS, 0, RH, SCALE_E6> RopeCfg;
constexpr int OFF_CV = LDS_BYTES, CV_WAVE = 64 * 33 * 4, LDS_BYTES_CV = OFF_CV + 4 * CV_WAVE;
constexpr int CV_ITEMS = 32768 + 16384;
struct Conv { const float* wgu; const float* wdn; unsigned char* dgu; unsigned char* ddn; int it, stride, tick, pend;
    float c0, c1, c2, c3, c4, c5, c6, c7, c8, c9, c10, c11, c12, c13, c14, c15, c16, c17, c18, c19, c20, c21, c22, c23, c24, c25, c26, c27, c28, c29, c30, c31; };
struct CvItem { const float* W; unsigned char* WT; int N, k0, n0, dst; float scale; };
__device__ __forceinline__ CvItem cv_decode(const Conv& C) {
    CvItem I; const int it = C.it;
    if (it < 32768) { const int e = it >> 10, r = it & 1023, kb = r >> 6, nb = r & 63, n0 = 32 * nb, up = n0 >= 1024, nn = n0 & 1023;
        I.W = C.wgu + (size_t)e * 1024 * 2048; I.WT = C.dgu + (size_t)e * 2048 * 1024; I.N = 2048; I.k0 = 64 * kb; I.n0 = n0; I.dst = 256 * (nn >> 7) + 128 * up + (nn & 127); I.scale = 256.0f; }
    else { const int j = it - 32768, e = j >> 9, r = j & 511, kb = r >> 5, nb = r & 31;
        I.W = C.wdn + (size_t)e * 1024 * 1024; I.WT = C.ddn + (size_t)e * 1024 * 1024; I.N = 1024; I.k0 = 64 * kb; I.n0 = 32 * nb; I.dst = 32 * nb; I.scale = 512.0f; }
    return I;
}
#define A2_CV_ALL(M) M(0) M(1) M(2) M(3) M(4) M(5) M(6) M(7) M(8) M(9) M(10) M(11) M(12) M(13) M(14) M(15) M(16) M(17) M(18) M(19) M(20) M(21) M(22) M(23) M(24) M(25) M(26) M(27) M(28) M(29) M(30) M(31)
__device__ __forceinline__ void cv_stage_a(Conv& C, int lane) {
    const CvItem I = cv_decode(C);
    const float* p = I.W + (size_t)(I.k0 + (lane >> 5)) * I.N + I.n0 + (lane & 31);
#define A2_CV_LD(i) C.c##i = p[(size_t)(2 * i) * I.N];
    A2_CV_ALL(A2_CV_LD)
#undef A2_CV_LD
}
__device__ __forceinline__ void cv_stage_b(Conv& C, char* lds, int vw, int lane) {
    const CvItem I = cv_decode(C);
    float* scr = (float*)(lds + OFF_CV + vw * CV_WAVE);
    float* w = scr + (lane >> 5) * 33 + (lane & 31);
#define A2_CV_ST(i) w[(2 * i) * 33] = C.c##i;
    A2_CV_ALL(A2_CV_ST)
#undef A2_CV_ST
    asm volatile("s_waitcnt lgkmcnt(0)" ::: "memory");
    const int c = lane & 3;
#pragma unroll
    for (int j = 0; j < 2; ++j) { const int n = (lane >> 2) + 16 * j; const float* sp = scr + (16 * c) * 33 + n; const float sc = I.scale;
        u32x4 o;
#pragma unroll
        for (int q = 0; q < 4; ++q) o[q] = pg8::pk4_fp8(sp[(4 * q) * 33] * sc, sp[(4 * q + 1) * 33] * sc, sp[(4 * q + 2) * 33] * sc, sp[(4 * q + 3) * 33] * sc);
        *reinterpret_cast<u32x4*>(I.WT + (size_t)(I.dst + n) * 1024 + I.k0 + 16 * c) = o; }
    asm volatile("s_waitcnt lgkmcnt(0)" ::: "memory");
}
__device__ __forceinline__ void cv_tick(Conv& C, char* lds, int vw, int lane) {
    const int ph = C.tick & 3; ++C.tick;
    if (ph == 0) { if (!C.pend && C.it < CV_ITEMS) { cv_stage_a(C, lane); C.pend = 1; } }
    else if (ph == 2) { if (C.pend) { cv_stage_b(C, lds, vw, lane); C.pend = 0; C.it += C.stride; } }
}
__device__ __forceinline__ void cv_finish(Conv& C, char* lds, int vw, int lane) {
    if (C.pend) { cv_stage_b(C, lds, vw, lane); C.pend = 0; C.it += C.stride; }
    while (C.it < CV_ITEMS) { cv_stage_a(C, lane); cv_stage_b(C, lds, vw, lane); C.it += C.stride; }
}
template <bool SW> __device__ __forceinline__ void prime(const BlockRef& cur, char* lds, Seam& S) {
    const int tid = tid_opaque(), wid = __builtin_amdgcn_readfirstlane(tid >> 6), lane = tid & 63, r32 = lane & 31, hi = lane >> 5;
    const int sw = wid & 3, t8 = tid & 255;
    const unsigned koff = (unsigned)((t8 >> 4) * KS + (t8 & 15) * 8) * 2u, voff = (unsigned)((t8 >> 4) * VS + (t8 & 15) * 8) * 2u;
    const int kws = (t8 >> 4) * KSTR + (t8 & 15) * 16;
    if constexpr (SW) {
        const unsigned qoff = (unsigned)((sw * 32 + r32) * QS + hi * 8) * 2u;
        A2_QLOAD(cur);
    } else { A2_SLOAD_KQ(cur, 0); A2_SLOAD_V(cur, 0); A2_VMWN(8); A2_SWRITE_KQ(0); }
    __syncthreads();
}
template <bool SW> __device__ __forceinline__ void block(const BlockRef& cur, const BlockRef& nxt, char* lds, Seam& S, const float* rcos, const float* rsin, Conv& C) {
    const int tid = tid_opaque(), wid = __builtin_amdgcn_readfirstlane(tid >> 6), lane = tid & 63, r32 = lane & 31, hi = lane >> 5;
    const int sw = wid & 3, t8 = tid & 255;
    const int NT = (cur.P0 + QB) / KVBLK;
    const unsigned W = 1u << 30;
    const int qlo = cur.P0 + sw * 32, qm = qlo + r32 - 4 * hi;
    float* ws = (float*)(lds + OFF_WS) + sw * 128; float* li_l = ws, * al_l = ws + 32; float* fl_l = ws + 64;
    char* pb = lds + OFF_P + sw * 4096 + lane * 16;
    float m_reg = -1e30f, l_reg = 0; f32x16 o[4] = {};
    const unsigned koff = (unsigned)((t8 >> 4) * KS + (t8 & 15) * 8) * 2u, voff = (unsigned)((t8 >> 4) * VS + (t8 & 15) * 8) * 2u;
    const int kws = (t8 >> 4) * KSTR + (t8 & 15) * 16;
    const int vst0 = v_st((t8 >> 4), (t8 & 15) * 8), vst1 = v_st((t8 >> 4) + 16, (t8 & 15) * 8), vst2 = v_st((t8 >> 4) + 32, (t8 & 15) * 8), vst3 = v_st((t8 >> 4) + 48, (t8 & 15) * 8);
    const int vb0 = (int)(uintptr_t)(lds + (SW ? OFF_V0 : OFF_V1)) + v_rd_base(lane);
#define A2_KBASE(t) ((t) * KVBLK)
#define A2_MASKT(P0_, P1_, t) do { const int kb_ = A2_KBASE(t); if (kb_ + KVBLK - 1 > qlo) mask_tile(P0_, P1_, qm - kb_, W); } while (0)
#define A2_PUTP() do { *(bf16x8*)(pb) = pa0; *(bf16x8*)(pb + 1024) = pa1; *(bf16x8*)(pb + 2048) = pa2; *(bf16x8*)(pb + 3072) = pa3; } while (0)
#define A2_GETP() do { pa0 = *(const bf16x8*)(pb); pa1 = *(const bf16x8*)(pb + 1024); pa2 = *(const bf16x8*)(pb + 2048); pa3 = *(const bf16x8*)(pb + 3072); } while (0)
#define A2_PUTAL(a) do { const bool any_ = __any((a) < 1.f); if (hi == 0) al_l[r32] = (a); if (lane == 0) fl_l[0] = any_ ? 1.f : 0.f; } while (0)
#define A2_RESC() do { if (fl_l[0] != 0.f) { for (int d_ = 0; d_ < 4; ++d_) for (int r = 0; r < 16; ++r) o[d_][r] *= al_l[crow(r, hi)]; } } while (0)
    f32x16 pA0, pA1, pB0, pB1; float mnA, mnB, alA = 1.f, alB = 1.f; bf16x8 pa0, pa1, pa2, pa3;
    if constexpr (!SW) { A2_SWRITE_V(0); }
    A2_SBAR();
    if (NT > 1) { if constexpr (!SW) { A2_SLOAD_KQ(cur, A2_KBASE(1)); A2_SLOAD_V(cur, A2_KBASE(1)); } }
    A2_SBAR();
    if constexpr (SW) { qkt<0>(pA0, pA1, lds, r32, hi, S); A2_MASKT(pA0, pA1, 0); att::partialSM<SCALE_E6>(pA0, pA1, m_reg, mnA, alA); }
    if (NT > 1) { if constexpr (!SW) { A2_VMW(); A2_SWRITE_KQ(1); A2_SWRITE_V(1); } }
    __syncthreads();
#define A2_STEP(PX0, PX1, mnX, alX, PY0, PY1, alY, t, KB, VB, SB) do {                                                      \
        A2_SBAR();                                                                                                            \
        if constexpr (SW) { qkt<KB>(PX0, PX1, lds, r32, hi, S); att::finishSM(PY0, PY1, alY, l_reg, pa0, pa1, pa2, pa3); A2_QK_SCHED(); A2_PUTP(); A2_SBAR();   \
                  }                                                                                                           \
        else { if ((t) + 1 < NT) { A2_SLOAD_KQ(cur, A2_KBASE((t) + 1)); A2_SLOAD_V(cur, A2_KBASE((t) + 1)); } A2_SBAR(); cv_tick(C, lds, sw, lane); }                \
        A2_SBAR(); A2_MIDBAR();                                                                                               \
        if constexpr (!SW) { A2_GETP(); }                                                                                               \
        att::pv_tile<VB>(o, vb0, pa0, pa1, pa2, pa3);                                                                         \
        if constexpr (SW) { A2_MASKT(PX0, PX1, (t)); att::partialSM<SCALE_E6>(PX0, PX1, m_reg, mnX, alX); A2_PUTAL(alX); }              \
        __syncthreads();                                                                                                      \
        if ((t) + 1 < NT) { if constexpr (!SW) { A2_SWRITE_KQ(SB); A2_SWRITE_V(SB); } }                                            \
        A2_RESC(); __syncthreads(); } while (0)
    for (int t = 1; t + 1 < NT; t += 2) {
        A2_STEP(pB0, pB1, mnB, alB, pA0, pA1, alA, t, 1, 0, 0);
        A2_STEP(pA0, pA1, mnA, alA, pB0, pB1, alB, t + 1, 0, 1, 1);
    }
    A2_SBAR();
    if constexpr (SW) { qkt<1>(pB0, pB1, lds, r32, hi, S); A2_SBAR();
        const unsigned qoff = (unsigned)((sw * 32 + r32) * QS + hi * 8) * 2u;
        A2_QLOAD(nxt);
        A2_SBAR();
        att::finishSM(pA0, pA1, alA, l_reg, pa0, pa1, pa2, pa3); A2_PUTP(); }
    else { A2_SLOAD_KQ(nxt, 0); A2_SLOAD_V(nxt, 0); }
    A2_SBAR(); A2_MIDBAR();
    if constexpr (!SW) { A2_GETP(); }
    att::pv_tile<0>(o, vb0, pa0, pa1, pa2, pa3);
    if constexpr (SW) { A2_MASKT(pB0, pB1, NT - 1); att::partialSM<SCALE_E6>(pB0, pB1, m_reg, mnB, alB); A2_PUTAL(alB); }
    A2_SBAR(); A2_MIDBAR();
    A2_RESC();
    if constexpr (SW) { att::finishSM(pB0, pB1, alB, l_reg, pa0, pa1, pa2, pa3); A2_PUTP(); if (hi == 0) li_l[r32] = l_reg; }
    A2_SBAR(); A2_MIDBAR();
    if constexpr (!SW) { A2_GETP(); }
    att::pv_tile<1>(o, vb0, pa0, pa1, pa2, pa3);
    A2_SBAR();
    if constexpr (!SW) { A2_VMWN(8); A2_SWRITE_KQ(0); A2_SBAR(); }
    float rli[16];
#pragma unroll
    for (int r = 0; r < 16; ++r) rli[r] = __builtin_amdgcn_rcpf(li_l[crow(r, hi)]);
    const unsigned ooff = (unsigned)((sw * 32 + 4 * hi) * OS + (SW ? 0 : 128) + r32) * 2u;
#pragma unroll
    for (int r = 0; r < 16; ++r) {
#pragma unroll
        for (int d0 = 0; d0 < 4; ++d0) { const float v = o[d0][r] * rli[r];
            const float vn = __shfl_xor(v, 1);
            if ((r32 & 1) == 0) *reinterpret_cast<unsigned*>((char*)cur.O + (size_t)((((r & 3) + 8 * (r >> 2)) * OS + d0 * 32) * 2) + ooff) = cvtpk(v, vn); } }
    __syncthreads();
#undef A2_KBASE
#undef A2_MASKT
#undef A2_PUTP
#undef A2_GETP
#undef A2_PUTAL
#undef A2_RESC
#undef A2_STEP
}
template <bool SW, class RefFn>
__device__ __forceinline__ void run(char* lds, int vcu, int G, int total, const RefFn& ref, const float* rcos, const float* rsin, const Conv& C0) {
    int L = vcu;
    int cb = L >> 4, q0 = L & 15, q1 = 31 - (L & 15), pass = 0;
    BlockRef cur = ref(cb, q0);
    Seam S; Conv C = C0;
    prime<SW>(cur, lds, S);
    for (;;) {
        const bool more_pass = pass == 0, more_item = L + G < total, last = !more_pass && !more_item;
        int cbn = cb, q0n = q0, q1n = q1, passn = pass + 1, Ln = L;
        if (!more_pass) { passn = 0; Ln = more_item ? L + G : L; cbn = Ln >> 4; q0n = Ln & 15; q1n = 31 - (Ln & 15); }
        const BlockRef nxt = last ? cur : ref(cbn, passn ? q1n : q0n);
        block<SW>(cur, nxt, lds, S, rcos, rsin, C);
        if (last) break;
        cur = nxt; cb = cbn; q0 = q0n; q1 = q1n; pass = passn; L = Ln;
    }
    if constexpr (!SW) { const int lane = (int)threadIdx.x & 63, vw = __builtin_amdgcn_readfirstlane((int)threadIdx.x >> 6) & 3; cv_finish(C, lds, vw, lane); }
}
template <class RefFn>
__device__ __forceinline__ void phase(char* lds, int vcu, int G, int total, const RefFn& ref, const float* rcos, const float* rsin, const float* wgu, const float* wdn, unsigned char* dgu, unsigned char* ddn) {
    const int wid = __builtin_amdgcn_readfirstlane((int)threadIdx.x >> 6);
    Conv C0{}; C0.wgu = wgu; C0.wdn = wdn; C0.dgu = dgu; C0.ddn = ddn; C0.it = vcu * 4 + (wid & 3); C0.stride = G * 4; C0.tick = 0; C0.pend = 0;
    if (wid < 4) run<true>(lds, vcu, G, total, ref, rcos, rsin, C0); else run<false>(lds, vcu, G, total, ref, rcos, rsin, C0);
}
}
constexpr int NWAVES = 8;
#ifndef MK_PER_PHASE
#define MK_PER_PHASE 0
#endif
constexpr int NPHASE = 25;
constexpr int T = 32768, D = 1024, SEQ = 4096, NPROJ = 1792  , PROJ_LD = 768  , NEXP = 32, TOPK = 4;
constexpr int NASSIGN = T * TOPK, MAXBLK = 544, MAXROWS = MAXBLK * 256;
constexpr float LN_EPS = 1e-5f, RMS_EPS = 1e-6f, DN_ALPHA = 1.4142135623730951f;
constexpr float LAMBDA_INIT1 = 0.35550906759096927f;
constexpr size_t MiB = 1u << 20;
constexpr size_t WS_CTL = 0, CTL_ZERO_BYTES = 64 * 1024;
constexpr size_t WS_COS64 = 1 * MiB, WS_SIN64 = WS_COS64 + 512 * 1024, WS_COS128 = 2 * MiB, WS_SIN128 = 3 * MiB;
constexpr size_t WS_WIN = 4 * MiB, WS_WQU = 8 * MiB, WS_WKVU = 9 * MiB, WS_WO0 = 10 * MiB, WS_WR0 = 12 * MiB, WS_WQKV = 13 * MiB, WS_WO1 = 19 * MiB, WS_WR1 = 21 * MiB;
constexpr int TKR_OFF = 262144;
constexpr size_t WS_LOGIT = 22 * MiB, WS_TKE = 26 * MiB, WS_TKG = WS_TKE + 512 * 1024, WS_TKR = 27 * MiB, WS_TDEST = WS_TKR + 512 * 1024, WS_RGATE = 28 * MiB, WS_ROWTOK = WS_LOGIT  ;
constexpr size_t WS_VB = 224 * MiB;
constexpr size_t WS_XB = 32 * MiB, WS_WGU = 96 * MiB  , WS_WDN = 160 * MiB  , WS_X8 = 192 * MiB  , WS_OV = 288 * MiB;
constexpr size_t WS_XG = WS_OV, WS_ACT = WS_OV + 272 * MiB;
constexpr size_t WS_UG = WS_OV + 48 * MiB  , WS_PROJ = WS_OV, WS_QLN = WS_OV + 112 * MiB, WS_KVLN = WS_OV + 136 * MiB, WS_KROPE = WS_OV + 152 * MiB, WS_Q0 = WS_OV + 156 * MiB, WS_KV0 = WS_OV + 204 * MiB;
constexpr size_t WS_QKV = WS_OV, WS_O2 = WS_OV + 192 * MiB, WS_CAT = WS_OV + 332 * MiB;
constexpr size_t WS_END = WS_OV + 544 * MiB;
static_assert(WS_KV0 + 64 * MiB <= WS_CAT && WS_O2 + 128 * MiB <= WS_CAT && WS_CAT + 64 * MiB <= WS_END && WS_ACT + 272 * MiB <= WS_END, "d_ws map");
constexpr int CW_TMO = 0, CW_BAR = 4096, CW_CNT = 8192;
constexpr int RING_BYTES = 131072  , LDSCTL_OFF = 152576  , MISC_OFF = LDSCTL_OFF, MOE_OFF = LDSCTL_OFF + 256;
constexpr int LDS_BYTES = 155648;

#define GAS __attribute__((address_space(1)))
#define LAS __attribute__((address_space(3)))
typedef unsigned short bf16;
typedef unsigned v4u __attribute__((ext_vector_type(4)));
typedef unsigned v2u __attribute__((ext_vector_type(2)));
typedef float f32x4 __attribute__((ext_vector_type(4)));
typedef float f32x2 __attribute__((ext_vector_type(2)));
typedef GAS unsigned gu32;
#define RLX_AGENT __ATOMIC_RELAXED, __HIP_MEMORY_SCOPE_AGENT
#define LDS_WAIT() asm volatile("s_waitcnt lgkmcnt(0)" ::: "memory")
#define VM_WAIT() asm volatile("s_waitcnt vmcnt(0)" ::: "memory")
__device__ __forceinline__ unsigned pk2(float lo, float hi) { unsigned r; asm volatile("v_cvt_pk_bf16_f32 %0, %1, %2" : "=v"(r) : "v"(lo), "v"(hi)); return r; }
__device__ __forceinline__ float bflo(unsigned w) { return __uint_as_float(w << 16); }
__device__ __forceinline__ float bfhi(unsigned w) { return __uint_as_float(w & 0xffff0000u); }
__device__ __forceinline__ float sigmoidf_(float z) { return __builtin_amdgcn_rcpf(1.0f + __builtin_amdgcn_exp2f(-1.4426950408889634f * z)); }

#define XB_TMO      128
#define XB_XCNT(j)  (256  + 64 * (j))
#define XB_XSUB(j)  (1280 + 64 * (j))
#define XB_XGEN(j)  (2304 + 64 * (j))
#define XB_TOP      3328
#define XB_TOPGEN   3392
#define XCD_BAR_WORDS 3456
#define XB_SPIN_CAP (1u << 18)
__device__ __forceinline__ unsigned xb_ld(unsigned* p)              { return __hip_atomic_load(p, __ATOMIC_RELAXED, __HIP_MEMORY_SCOPE_AGENT); }
__device__ __forceinline__ unsigned xb_add(unsigned* p, unsigned v) { return __hip_atomic_fetch_add(p, v, __ATOMIC_RELAXED, __HIP_MEMORY_SCOPE_AGENT); }
__device__ __forceinline__ unsigned xb_xcc_id() { return (unsigned)__builtin_amdgcn_s_getreg((3 << 11) | 20) & 0xFu; }
#define XB_SPIN(cond, bar) do { unsigned _sp = 0; while (cond) { __builtin_amdgcn_s_sleep(1); \
    if ((++_sp & 255u) == 0u) { if (xb_ld(&(bar)[XB_TMO])) break; if (_sp > XB_SPIN_CAP) { atomicAdd(&(bar)[XB_TMO], 1u); break; } } } } while (0)
struct XcdBarrier { unsigned* bar; unsigned x; volatile LAS unsigned* st; };
__device__ __forceinline__ XcdBarrier xcd_barrier_post(unsigned* bar, volatile LAS unsigned* st) {
    XcdBarrier b; b.bar = bar; b.x = xb_xcc_id(); b.st = st;
    if (threadIdx.x == 0) (void)xb_add(&bar[XB_XCNT(b.x)], 1u);
    return b;
}
__device__ __forceinline__ void xcd_barrier_complete(unsigned* bar, unsigned x, unsigned& nloc, unsigned& nx) {
    const unsigned G = gridDim.x * gridDim.y * gridDim.z;
    unsigned sum, cnt, mine, sp = 0u;
    for (;;) {
        sum = 0u; cnt = 0u; mine = 0u;
#pragma unroll
        for (unsigned j = 0; j < 16; ++j) { const unsigned c = xb_ld(&bar[XB_XCNT(j)]); sum += c; cnt += (c > 0u) ? 1u : 0u; mine = (j == x) ? c : mine; }
        if (sum == G) break;
        __builtin_amdgcn_s_sleep(1);
        if ((++sp & 255u) == 0u) { if (xb_ld(&bar[XB_TMO])) break; if (sp > XB_SPIN_CAP) { atomicAdd(&bar[XB_TMO], 1u); break; } }
    }
    nloc = mine > 0u ? mine : 1u; nx = cnt > 0u ? cnt : 1u;
}
__device__ __forceinline__ void xcd_barrier(const XcdBarrier& b) {
    asm volatile("s_waitcnt vmcnt(0)" ::: "memory");
    __syncthreads();
    if (threadIdx.x == 0) {
        unsigned* bar = b.bar;
        __builtin_amdgcn_s_waitcnt(0);
        unsigned nloc = b.st[0], nx = b.st[1];
        if (nloc == 0u) { xcd_barrier_complete(bar, b.x, nloc, nx); b.st[0] = nloc; b.st[1] = nx; }
        const unsigned old = xb_add(&bar[XB_XSUB(b.x)], 1u);
        const unsigned gen = old / nloc;
        if (old + 1u == (gen + 1u) * nloc) {
            __builtin_amdgcn_fence(__ATOMIC_RELEASE, "agent");
            asm volatile("s_waitcnt vmcnt(0)" ::: "memory");
            const unsigned og = xb_add(&bar[XB_TOP], 1u);
            const unsigned tg = og / nx;
            if (og + 1u == (tg + 1u) * nx) xb_add(&bar[XB_TOPGEN], 1u);
            else XB_SPIN(xb_ld(&bar[XB_TOPGEN]) == tg, bar);
            __builtin_amdgcn_fence(__ATOMIC_ACQUIRE, "agent");
            xb_add(&bar[XB_XGEN(b.x)], 1u);
            asm volatile("s_waitcnt vmcnt(0)" ::: "memory");
        } else {
            XB_SPIN(xb_ld(&bar[XB_XGEN(b.x)]) == gen, bar);
            __builtin_amdgcn_fence(__ATOMIC_ACQUIRE, "agent");
            asm volatile("s_waitcnt vmcnt(0)" ::: "memory");
        }
    }
    __syncthreads();
}

struct Frame {
    LAS unsigned char* lds; gu32* ctl;
    int tid, lane, wave, vcu, G, gw, NGW;
};
__device__ __forceinline__ float wave_sum(float v) {
#define WS_DPP(x, ctrl, rmask) __int_as_float(__builtin_amdgcn_update_dpp(0, __float_as_int(x), ctrl, rmask, 0xF, false))
    v += WS_DPP(v, 0xB1, 0xF);
    v += WS_DPP(v, 0x4E, 0xF);
    v += WS_DPP(v, 0x124, 0xF);
    v += WS_DPP(v, 0x128, 0xF);
    v += WS_DPP(v, 0x142, 0xA);
    v += WS_DPP(v, 0x143, 0xC);
#undef WS_DPP
    return __int_as_float(__builtin_amdgcn_readlane(__float_as_int(v), 63));
}
__device__ __forceinline__ unsigned pk4_fp8(float a, float b, float c, float d) { return pg8::pk4_fp8(a, b, c, d); }
constexpr float XSC = 16.0f, WGU_SC = 256.0f, ACT_SC = 8.0f, WDN_SC = 512.0f, YSC = 64.0f, CAT_SC = 64.0f;
__device__ __forceinline__ void transpose_item(const float* W, int K, int N, bf16* WT, int k0, int n0, int dst_row, LAS float* scr, int lane) {
#pragma unroll 8
    for (int i = 0; i < 32; ++i) { const int kk = 2 * i + (lane >> 5); scr[kk * 33 + (lane & 31)] = W[(size_t)(k0 + kk) * N + n0 + (lane & 31)]; }
    LDS_WAIT(); asm volatile("" ::: "memory");
    const int c = lane & 7;
#pragma unroll
    for (int j = 0; j < 4; ++j) { const int n = (lane >> 3) + 8 * j; const LAS float* s = scr + (8 * c) * 33 + n;
        v4u o; o.x = pk2(s[0 * 33], s[1 * 33]); o.y = pk2(s[2 * 33], s[3 * 33]); o.z = pk2(s[4 * 33], s[5 * 33]); o.w = pk2(s[6 * 33], s[7 * 33]);
        *(GAS v4u*)(WT + (size_t)(dst_row + n) * K + k0 + 8 * c) = o; }
    LDS_WAIT(); asm volatile("" ::: "memory");
}
template <int MODE> __device__ __forceinline__ void convert_matrix(const Frame& F, const float* W, int K, int N, bf16* WT, int nexp) {
    LAS float* scr = (LAS float*)(F.lds + F.wave * 16384);
    const int nblk = N / 32, per = (K / 64) * nblk, total = per * nexp;
    for (int it = F.gw; it < total; it += F.NGW) {
        const int e = it / per, r = it - e * per, kb = r / nblk, nb = r - kb * nblk, n0 = 32 * nb;
        int dst = n0;
        if (MODE == 1) { const int up = n0 >= 1024, nn = n0 & 1023; dst = 256 * (nn >> 7) + 128 * up + (nn & 127); }
        if (MODE == 3 && n0 >= 704) { const int g = n0 >= 1216, cc = n0 - (g ? 1216 : 704); dst = 768 + 256 * (cc >> 7) + 128 * g + (cc & 127); }
        if (MODE == 2 && n0 < 2048) { const int qk = n0 & ~1023, cc = n0 & 1023, h8 = cc >> 7, d0 = cc & 127; dst = qk + (h8 >> 1) * 256 + (d0 >> 6) * 128 + (h8 & 1) * 64 + (d0 & 63); }
        transpose_item(W + (size_t)e * K * N, K, N, WT + (size_t)e * N * K, 64 * kb, n0, dst, scr, F.lane);
    }
}
__device__ __forceinline__ void transpose_item8(const float* W, int K, int N, unsigned char* WT, int k0, int n0, int dst_row, LAS float* scr, int lane, float scale) {
#pragma unroll 8
    for (int i = 0; i < 32; ++i) { const int kk = 2 * i + (lane >> 5); scr[kk * 33 + (lane & 31)] = W[(size_t)(k0 + kk) * N + n0 + (lane & 31)]; }
    LDS_WAIT(); asm volatile("" ::: "memory");
    const int c = lane & 3;
#pragma unroll
    for (int j = 0; j < 2; ++j) { const int n = (lane >> 2) + 16 * j; const LAS float* s = scr + (16 * c) * 33 + n;
        v4u o;
#pragma unroll
        for (int q = 0; q < 4; ++q) o[q] = pk4_fp8(s[(4 * q) * 33] * scale, s[(4 * q + 1) * 33] * scale, s[(4 * q + 2) * 33] * scale, s[(4 * q + 3) * 33] * scale);
        *(GAS v4u*)(WT + (size_t)(dst_row + n) * K + k0 + 16 * c) = o; }
    LDS_WAIT(); asm volatile("" ::: "memory");
}
template <int MODE> __device__ __forceinline__ void convert_matrix8(const Frame& F, const float* W, int K, int N, unsigned char* WT, int nexp, float scale) {
    LAS float* scr = (LAS float*)(F.lds + F.wave * 16384);
    const int nblk = N / 32, per = (K / 64) * nblk, total = per * nexp;
    for (int it = F.gw; it < total; it += F.NGW) {
        const int e = it / per, r = it - e * per, kb = r / nblk, nb = r - kb * nblk, n0 = 32 * nb;
        int dst = n0;
        if (MODE == 1) { const int up = n0 >= 1024, nn = n0 & 1023; dst = 256 * (nn >> 7) + 128 * up + (nn & 127); }
        if (MODE == 3 && n0 >= 704) { const int g = n0 >= 1216, cc = n0 - (g ? 1216 : 704); dst = 768 + 256 * (cc >> 7) + 128 * g + (cc & 127); }
        if (MODE == 2 && n0 < 2048) { const int qk = n0 & ~1023, cc = n0 & 1023, h8 = cc >> 7, d0 = cc & 127; dst = qk + (h8 >> 1) * 256 + (d0 >> 6) * 128 + (h8 & 1) * 64 + (d0 & 63); }
        transpose_item8(W + (size_t)e * K * N, K, N, WT + (size_t)e * N * K, 64 * kb, n0, dst, scr, F.lane, scale);
    }
}
__device__ __forceinline__ void zero_bytes16(const Frame& F, void* p, size_t bytes) {
    GAS v4u* q = (GAS v4u*)p; const size_t n = bytes / 16;
    for (size_t i = (size_t)F.vcu * 512 + F.tid; i < n; i += (size_t)F.G * 512) q[i] = (v4u){0u, 0u, 0u, 0u};
}
__device__ __forceinline__ void rope_tables(const Frame& F, float* cs, float* sn, int half  ) {
    const int n = SEQ * half;
    for (int i = F.vcu * 512 + F.tid; i < n; i += F.G * 512) {
        const int pos = i / half, f = i - pos * half;
        const float inv = __builtin_amdgcn_exp2f(-(float)f / (float)half * 13.287712379549449f);
        const float ang = (float)pos * inv;
        double rev = (double)ang * 0.15915494309189535; rev -= __builtin_floor(rev);
        const float rf = (float)rev;
        cs[i] = __builtin_amdgcn_cosf(rf); sn[i] = __builtin_amdgcn_sinf(rf);
    }
}
__device__ __forceinline__ void rows_to_bf16(const Frame& F, const float* x, bf16* xb, unsigned char* x8) {
    for (int m0 = F.gw * 4; m0 < T; m0 += F.NGW * 4) {
        f32x4 v[4][4];
#pragma unroll
        for (int r = 0; r < 4; ++r)
#pragma unroll
            for (int j = 0; j < 4; ++j) v[r][j] = *((const GAS f32x4*)(x + (size_t)(m0 + r) * D) + F.lane + 64 * j);
#pragma unroll
        for (int r = 0; r < 4; ++r)
#pragma unroll
            for (int j = 0; j < 4; ++j) { *((GAS v2u*)(xb + (size_t)(m0 + r) * D) + F.lane + 64 * j) = (v2u){pk2(v[r][j].x, v[r][j].y), pk2(v[r][j].z, v[r][j].w)};
                *((GAS unsigned*)(x8 + (size_t)(m0 + r) * D) + F.lane + 64 * j) = pk4_fp8(v[r][j].x * XSC, v[r][j].y * XSC, v[r][j].z * XSC, v[r][j].w * XSC); }
    }
}
constexpr int NRM = 8;
__device__ __forceinline__ void mid0_rows(const Frame& F, const bf16* proj, const float* qg, const float* kvg, const float* cs64, const float* sn64, bf16* qln, bf16* kvln, bf16* krope) {
    float gq[3][2], gk[2][2];
#pragma unroll
    for (int j = 0; j < 3; ++j) { const f32x2 g = *(const f32x2*)(qg + 2 * (F.lane + 64 * j)); gq[j][0] = g.x; gq[j][1] = g.y; }
#pragma unroll
    for (int j = 0; j < 2; ++j) { const f32x2 g = *(const f32x2*)(kvg + 2 * (F.lane + 64 * j)); gk[j][0] = g.x; gk[j][1] = g.y; }
    for (int t0 = F.gw * NRM; t0 < T; t0 += F.NGW * NRM) {
        unsigned w[NRM][3], v[NRM][2]; unsigned short kx[NRM]; float cc[NRM], sc[NRM];
#pragma unroll
        for (int r = 0; r < NRM; ++r) { const GAS unsigned* prow = (const GAS unsigned*)(proj + (size_t)(t0 + r) * PROJ_LD);
#pragma unroll
            for (int j = 0; j < 3; ++j) w[r][j] = prow[F.lane + 64 * j];
#pragma unroll
            for (int j = 0; j < 2; ++j) v[r][j] = prow[192 + F.lane + 64 * j];
            kx[r] = ((const GAS bf16*)prow)[640 + F.lane];
            const int pos = (t0 + r) & (SEQ - 1); cc[r] = cs64[pos * 32 + (F.lane & 31)]; sc[r] = sn64[pos * 32 + (F.lane & 31)]; }
#pragma unroll
        for (int r = 0; r < NRM; ++r) { const int t = t0 + r;
            float ss = 0.f;
#pragma unroll
            for (int j = 0; j < 3; ++j) { const float a = bflo(w[r][j]), b = bfhi(w[r][j]); ss += a * a + b * b; }
            float rstd = 1.0f / sqrtf(wave_sum(ss) * (1.0f / 384.0f) + RMS_EPS);
            GAS unsigned* qo = (GAS unsigned*)(qln + (size_t)t * 384);
#pragma unroll
            for (int j = 0; j < 3; ++j) qo[F.lane + 64 * j] = pk2(bflo(w[r][j]) * rstd * gq[j][0], bfhi(w[r][j]) * rstd * gq[j][1]);
            ss = 0.f;
#pragma unroll
            for (int j = 0; j < 2; ++j) { const float a = bflo(v[r][j]), b = bfhi(v[r][j]); ss += a * a + b * b; }
            rstd = 1.0f / sqrtf(wave_sum(ss) * (1.0f / 256.0f) + RMS_EPS);
            GAS unsigned* ko = (GAS unsigned*)(kvln + (size_t)t * 256);
#pragma unroll
            for (int j = 0; j < 2; ++j) ko[F.lane + 64 * j] = pk2(bflo(v[r][j]) * rstd * gk[j][0], bfhi(v[r][j]) * rstd * gk[j][1]);
            const float xk = __uint_as_float((unsigned)kx[r] << 16), xp = __shfl_xor(xk, 32);
            const float y = F.lane < 32 ? xk * cc[r] - xp * sc[r] : xk * cc[r] + xp * sc[r];
            ((GAS bf16*)krope)[(size_t)t * 64 + F.lane] = (bf16)(pk2(y, 0.f) & 0xffffu); }
    }
}
#ifndef NHB
#define NHB 1
#endif
__device__ __forceinline__ void conv_stage(const Frame& F, const bf16* ug, int tile, LAS unsigned char* B) {
    const int t0 = tile * 32, pos0 = t0 & (SEQ - 1);
    for (int rr = __builtin_amdgcn_readfirstlane(F.wave); rr < 62; rr += NWAVES) {
        if (pos0 - 30 + rr >= 0) __builtin_amdgcn_global_load_lds((const unsigned*)((const GAS unsigned char*)ug + (size_t)(t0 - 30 + rr) * 1024 + F.lane * 16), (LAS unsigned*)(B + rr * 1024), 16, 0, 0);
        else *(LAS v4u*)(B + rr * 1024 + F.lane * 16) = (v4u){0u, 0u, 0u, 0u};
    }
}
constexpr int CONV_U1 = 66560;
__device__ __forceinline__ void conv_prefetch(const Frame& F, const bf16* ug) { if (F.vcu < T / 32) conv_stage(F, ug, F.vcu, F.lds); }
__device__ __forceinline__ void conv_phase(const Frame& F, const bf16* proj, const float* cw, const float* cb, const float* lg, const float* lb, bf16* cat) {
    LAS float* part = (LAS float*)(F.lds + 65536);
    const int cp = F.tid & 255, th = F.tid >> 8;
    f32x2 wv2[31];
#pragma unroll
    for (int j = 0; j < 31; ++j) wv2[j] = *(const f32x2*)(cw + j * 512 + 2 * cp);
    const f32x2 bia = *(const f32x2*)(cb + 2 * cp), g2 = *(const f32x2*)(lg + 2 * cp), b2 = *(const f32x2*)(lb + 2 * cp);
    int it = 0;
    for (int tile = F.vcu; tile < T / 32; tile += F.G, ++it) {
        const int t0 = tile * 32;
        LAS unsigned char* U = F.lds + (it & 1) * CONV_U1;
        asm volatile("s_waitcnt vmcnt(0)" ::: "memory");
        __syncthreads();
        if (tile + F.G < T / 32) conv_stage(F, proj, tile + F.G, F.lds + ((it + 1) & 1) * CONV_U1);
        f32x2 acc[16];
#pragma unroll
        for (int i = 0; i < 16; ++i) acc[i] = bia;
#pragma unroll
        for (int r = 0; r < 46; ++r) {
            const unsigned uu = *(const LAS unsigned*)(U + (th * 16 + r) * 1024 + cp * 4); const f32x2 u2 = (f32x2){bflo(uu), bfhi(uu)};
#pragma unroll
            for (int i = 0; i < 16; ++i) { const int j = r - i; if (j >= 0 && j <= 30) acc[i] = __builtin_elementwise_fma(wv2[j], u2, acc[i]); }
        }
        {
            float rs[32];
#pragma unroll
            for (int i = 0; i < 16; ++i) { rs[2 * i] = acc[i].x + acc[i].y; rs[2 * i + 1] = acc[i].x * acc[i].x + acc[i].y * acc[i].y; }
#define WS_DPP(x, ctrl, rmask) __int_as_float(__builtin_amdgcn_update_dpp(0, __float_as_int(x), ctrl, rmask, 0xF, false))
#pragma unroll
            for (int k = 0; k < 32; ++k) rs[k] += __int_as_float(__builtin_amdgcn_mov_dpp(__float_as_int(rs[k]), 0xB1, 0xF, 0xF, true));
#pragma unroll
            for (int k = 0; k < 32; ++k) rs[k] += __int_as_float(__builtin_amdgcn_mov_dpp(__float_as_int(rs[k]), 0x4E, 0xF, 0xF, true));
#pragma unroll
            for (int k = 0; k < 32; ++k) rs[k] += __int_as_float(__builtin_amdgcn_mov_dpp(__float_as_int(rs[k]), 0x124, 0xF, 0xF, true));
#pragma unroll
            for (int k = 0; k < 32; ++k) rs[k] += __int_as_float(__builtin_amdgcn_mov_dpp(__float_as_int(rs[k]), 0x128, 0xF, 0xF, true));
#pragma unroll
            for (int k = 0; k < 32; ++k) rs[k] += WS_DPP(rs[k], 0x142, 0xA);
#pragma unroll
            for (int k = 0; k < 32; ++k) rs[k] += WS_DPP(rs[k], 0x143, 0xC);
#undef WS_DPP
            if (F.lane == 63) {
#pragma unroll
                for (int i = 0; i < 16; ++i) *(LAS f32x2*)(part + ((th * 16 + i) * 4 + (F.wave & 3)) * 2) = (f32x2){rs[2 * i], rs[2 * i + 1]}; }
        }
        __syncthreads();
        int cpo_ = cp; asm volatile("" : "+v"(cpo_));
        GAS unsigned char* const cbase_ = (GAS unsigned char*)cat + (size_t)(t0 + th * 16) * D + 512 + 2 * cpo_;
#pragma unroll
        for (int i = 0; i < 16; ++i) {
            const LAS f32x2* pp = (const LAS f32x2*)(part + (th * 16 + i) * 8);
            const f32x2 p0 = pp[0], p1 = pp[1], p2 = pp[2], p3 = pp[3];
            const float mean = ((p0.x + p1.x) + (p2.x + p3.x)) * (1.0f / 512.0f), ex2 = ((p0.y + p1.y) + (p2.y + p3.y)) * (1.0f / 512.0f);
            const float rstd = 1.0f / sqrtf(fmaxf(ex2 - mean * mean, 0.f) + LN_EPS);
            const float v0 = (acc[i].x - mean) * rstd * g2.x + b2.x, v1 = (acc[i].y - mean) * rstd * g2.y + b2.y;
            *(GAS unsigned short*)(cbase_ + (unsigned)(i * D)) = (unsigned short)__builtin_amdgcn_cvt_pk_fp8_f32(fminf(v0 * sigmoidf_(v0) * CAT_SC, 448.f), fminf(v1 * sigmoidf_(v1) * CAT_SC, 448.f), 0, false);
        }
    }
    __syncthreads();
}
__device__ __forceinline__ f32x4 bf4(v2u w) { f32x4 r; r.x = bflo(w.x); r.y = bfhi(w.x); r.z = bflo(w.y); r.w = bfhi(w.y); return r; }
__device__ __forceinline__ f32x4 fp8x4(unsigned w) { const f32x2 a = __builtin_amdgcn_cvt_pk_f32_fp8((int)w, false), b = __builtin_amdgcn_cvt_pk_f32_fp8((int)w, true); f32x4 r; r.x = a.x; r.y = a.y; r.z = b.x; r.w = b.y; return r; }
template <bool MOE_SUM, bool FINAL, int NRX = 0> __device__ __forceinline__ void ln_phase(const Frame& F, const bf16* vin, const float* g, const float* b, bf16* xb, unsigned char* x8, float* outf, const unsigned char* ys, const int* tok_dest, const float* tok_gate, int row_first = -1, int row_step = 0, int row_end = 0) {
    constexpr int NR = NRX ? NRX : (MOE_SUM ? 2 : 4);
    if (row_first < 0) { row_first = F.gw * NR; row_step = F.NGW * NR; row_end = T; }
    for (int t0 = row_first; t0 < row_end; t0 += row_step) {
        v2u vi[NR][4]; unsigned y4[MOE_SUM ? NR : 1][4][4]; float gt[MOE_SUM ? NR : 1][4];
#pragma unroll
        for (int r = 0; r < NR; ++r) {
#pragma unroll
            for (int j = 0; j < 4; ++j) vi[r][j] = *((const GAS v2u*)(vin + (size_t)(t0 + r) * D) + F.lane + 64 * j);
            if (MOE_SUM) {
#pragma unroll
                for (int k = 0; k < 4; ++k) { const int a_ = 4 * (t0 + r) + k; const int d = ((const LAS int*)(F.lds + MOE_OFF))[tok_dest[a_]] + tok_dest[a_ + TKR_OFF];     gt[r][k] = tok_gate[4 * (t0 + r) + k] * (1.0f / YSC);
#pragma unroll
                    for (int j = 0; j < 4; ++j) y4[r][k][j] = *((const GAS unsigned*)(ys + (size_t)d * D) + F.lane + 64 * j); }
            }
        }
#pragma unroll
        for (int r = 0; r < NR; ++r) { const int t = t0 + r;
            f32x4 v[4];
#pragma unroll
            for (int j = 0; j < 4; ++j) v[j] = bf4(vi[r][j]);
            if (MOE_SUM) {
#pragma unroll
                for (int j = 0; j < 4; ++j) { v[j] = v[j] * DN_ALPHA;
#pragma unroll
                    for (int k = 0; k < 4; ++k) v[j] += fp8x4(y4[r][k][j]) * gt[r][k]; }
            }
            float s = 0.f;
#pragma unroll
            for (int j = 0; j < 4; ++j) s += (v[j].x + v[j].y) + (v[j].z + v[j].w);
            const float mean = wave_sum(s) * (1.f / D); float s2 = 0.f;
#pragma unroll
            for (int j = 0; j < 4; ++j) { v[j] = v[j] - mean; s2 += (v[j].x * v[j].x + v[j].y * v[j].y) + (v[j].z * v[j].z + v[j].w * v[j].w); }
            const float rstd = 1.f / sqrtf(wave_sum(s2) * (1.f / D) + LN_EPS);
#pragma unroll
            for (int j = 0; j < 4; ++j) { const f32x4 gg = *((const GAS f32x4*)g + F.lane + 64 * j), bb = *((const GAS f32x4*)b + F.lane + 64 * j);
                const f32x4 y = v[j] * rstd * gg + bb;
                if (FINAL) *((GAS f32x4*)(outf + (size_t)t * D) + F.lane + 64 * j) = y;
                else *((GAS v2u*)(xb + (size_t)t * D) + F.lane + 64 * j) = (v2u){pk2(y.x, y.y), pk2(y.z, y.w)};
                if (!FINAL) *((GAS unsigned*)(x8 + (size_t)t * D) + F.lane + 64 * j) = pk4_fp8(y.x * XSC, y.y * XSC, y.z * XSC, y.w * XSC); }
        }
    }
}
__device__ __forceinline__ void topk_phase(const Frame& F, const bf16* xb, const bf16* wrt, const float* rb, unsigned* cnt, int* tk_e, float* tk_g, int* tk_rank, int* row_tok, const bf16* vb = nullptr, const float* lng = nullptr, const float* lnb = nullptr, unsigned char* x8 = nullptr) {
    typedef short bf16x8 __attribute__((ext_vector_type(8)));
    LAS unsigned char* WL = F.lds;
    LAS float* lgt = (LAS float*)(F.lds + 67584);
    LAS int* se = (LAS int*)(F.lds + 86016); LAS float* sg = (LAS float*)(F.lds + 88064); LAS unsigned* hist = (LAS unsigned*)(F.lds + 90112); LAS unsigned* base = (LAS unsigned*)(F.lds + 90240);
    v4u wreg[8];
#pragma unroll
    for (int j = 0; j < 8; ++j) { const int i = F.tid + 512 * j, row = i >> 7, ch = i & 127; wreg[j] = *(const GAS v4u*)(wrt + (size_t)row * 1024 + ch * 8); }
    bool filled = false;
    const int fr = F.lane & 15, fq = F.lane >> 4;
    for (int ch = F.vcu; ch < T / 128; ch += F.G) {
        if (F.tid < 32) hist[F.tid] = 0u;
        if (vb != nullptr) { const int r0_ = ch * 128 + 16 * F.wave; ln_phase<false, false, 8>(F, vb, lng, lnb, const_cast<bf16*>(xb), x8, nullptr, nullptr, nullptr, nullptr, r0_, 8, r0_ + 16);
            asm volatile("s_waitcnt vmcnt(0)" ::: "memory"); __builtin_amdgcn_fence(__ATOMIC_ACQ_REL, "workgroup"); }
        if (!filled) { filled = true;
#pragma unroll
            for (int j = 0; j < 8; ++j) { const int i = F.tid + 512 * j, row = i >> 7, c16 = i & 127; *(LAS v4u*)(WL + row * 2064 + c16 * 16) = wreg[j]; }
            __syncthreads(); }
        {
            f32x4 acc0 = {0.f, 0.f, 0.f, 0.f}, acc1 = {0.f, 0.f, 0.f, 0.f};
            const bf16* arow = xb + (size_t)(ch * 128 + 16 * F.wave + fr) * D + fq * 8;
            const LAS unsigned char* b0p = WL + fr * 2064 + fq * 16; const LAS unsigned char* b1p = b0p + 16 * 2064;
#pragma unroll
            for (int k0 = 0; k0 < D; k0 += 32) {
                const bf16x8 a = *(const GAS bf16x8*)(arow + k0);
                const bf16x8 b0 = *(const LAS bf16x8*)(b0p + k0 * 2), b1 = *(const LAS bf16x8*)(b1p + k0 * 2);
                acc0 = __builtin_amdgcn_mfma_f32_16x16x32_bf16(b0, a, acc0, 0, 0, 0);
                acc1 = __builtin_amdgcn_mfma_f32_16x16x32_bf16(b1, a, acc1, 0, 0, 0);
            }
            const f32x4 bb0 = *(const GAS f32x4*)(rb + 4 * fq), bb1 = *(const GAS f32x4*)(rb + 16 + 4 * fq);
            LAS float* lp = lgt + (16 * F.wave + fr) * 33 + 4 * fq;
#pragma unroll
            for (int q = 0; q < 4; ++q) { lp[q] = acc0[q] + bb0[q]; lp[16 + q] = acc1[q] + bb1[q]; }
        }
        __syncthreads();
        if (F.tid < 128) {
            float v[32];
#pragma unroll
            for (int e = 0; e < 32; ++e) v[e] = lgt[F.tid * 33 + e];
            float tv[4]; int ti[4];
#pragma unroll
            for (int k = 0; k < 4; ++k) {
                float best = v[0]; int bi = 0;
#pragma unroll
                for (int e = 1; e < 32; ++e) if (v[e] > best) { best = v[e]; bi = e; }
                tv[k] = best; ti[k] = bi;
#pragma unroll
                for (int e = 0; e < 32; ++e) v[e] = (e == bi) ? -__builtin_inff() : v[e];
            }
            const float e1 = __expf(tv[1] - tv[0]), e2 = __expf(tv[2] - tv[0]), e3 = __expf(tv[3] - tv[0]), inv = 1.0f / (1.0f + e1 + e2 + e3);
            se[F.tid * 4 + 0] = ti[0]; se[F.tid * 4 + 1] = ti[1]; se[F.tid * 4 + 2] = ti[2]; se[F.tid * 4 + 3] = ti[3];
            sg[F.tid * 4 + 0] = inv; sg[F.tid * 4 + 1] = e1 * inv; sg[F.tid * 4 + 2] = e2 * inv; sg[F.tid * 4 + 3] = e3 * inv;
        }
        __syncthreads();
        const int e = se[F.tid]; const float gt = sg[F.tid];
        const unsigned lr = __hip_atomic_fetch_add(hist + e, 1u, __ATOMIC_RELAXED, __HIP_MEMORY_SCOPE_WORKGROUP);
        __syncthreads();
        if (F.tid < 32) base[F.tid] = __hip_atomic_fetch_add(cnt + F.tid, hist[F.tid], __ATOMIC_RELAXED, __HIP_MEMORY_SCOPE_AGENT);
        __syncthreads();
        const int a = ch * 512 + F.tid;
        tk_e[a] = e; tk_g[a] = gt; tk_rank[a] = (int)(base[e] + lr); row_tok[e * T + (int)(base[e] + lr)] = a >> 2;
        __syncthreads();
    }
}
__device__ __forceinline__ void moe_tables(const Frame& F, const unsigned* cnt) {
    LAS int* tb = (LAS int*)(F.lds + MOE_OFF);
    if (F.tid < 32) {
        const int pc = (((int)__hip_atomic_load(cnt + F.tid, RLX_AGENT) + 255) >> 8) << 8; int s = pc;
#pragma unroll
        for (int d = 1; d < 32; d <<= 1) { const int t = __shfl_up(s, d, 32); if (F.tid >= d) s += t; }
        tb[F.tid] = s - pc; if (F.tid == 31) { tb[32] = s; tb[33] = s >> 8; } }
    __syncthreads();
    for (int bk = F.tid; bk < MAXBLK; bk += 512) { const int r0 = bk << 8; int e = 0;
        for (int q = 1; q < NEXP; ++q) e += (tb[q] <= r0) ? 1 : 0;
        tb[64 + bk] = e; }
    __syncthreads();
}
__device__ __forceinline__ void gather_phase(const Frame& F, const unsigned char* x8, const int* tk_e, const int* tk_rank, unsigned char* xg, int* tok_dest) {
    const LAS int* tb = (const LAS int*)(F.lds + MOE_OFF);
    for (int a0 = F.gw * 64; a0 < NASSIGN; a0 += F.NGW * 64) {
        const int a = a0 + F.lane, dest = tb[tk_e[a]] + tk_rank[a];
        tok_dest[a] = dest;
        for (int i0 = 0; i0 < 64; i0 += 8) {
            v4u r[8];
#pragma unroll
            for (int i = 0; i < 8; ++i) r[i] = *((const GAS v4u*)(x8 + (size_t)((a0 + i0 + i) >> 2) * D) + F.lane);
#pragma unroll
            for (int i = 0; i < 8; ++i) { const int d = __builtin_amdgcn_readlane(dest, i0 + i); *((GAS v4u*)(xg + (size_t)d * D) + F.lane) = r[i]; }
        }
    }
}
__device__ __forceinline__ void index_phase(const Frame& F, const int* tk_e, const int* tk_rank, int* tok_dest, int* row_tok) {
    const LAS int* tb = (const LAS int*)(F.lds + MOE_OFF);
    for (int a = F.vcu * 512 + F.tid; a < NASSIGN; a += F.G * 512) { const int dest = tb[tk_e[a]] + tk_rank[a]; tok_dest[a] = dest; row_tok[dest] = a >> 2; }
}
__device__ __forceinline__ void ropek_phase(const Frame& F, bf16* qkv, const float* cs, const float* sn) {
    for (int t0 = F.gw * 2; t0 < T; t0 += F.NGW * 2) {
        unsigned short x1[2][8], x2[2][8]; float c[2], s[2];
#pragma unroll
        for (int r = 0; r < 2; ++r) { const int pos = (t0 + r) & (SEQ - 1); c[r] = cs[pos * 64 + F.lane]; s[r] = sn[pos * 64 + F.lane];
            const GAS bf16* kr = (const GAS bf16*)(qkv + (size_t)(t0 + r) * 3072 + 1024);
#pragma unroll
            for (int hh = 0; hh < 8; ++hh) { x1[r][hh] = kr[hh * 128 + F.lane]; x2[r][hh] = kr[hh * 128 + 64 + F.lane]; } }
#pragma unroll
        for (int r = 0; r < 2; ++r) { GAS bf16* kr = (GAS bf16*)(qkv + (size_t)(t0 + r) * 3072 + 1024);
#pragma unroll
            for (int hh = 0; hh < 8; ++hh) { const float a = __uint_as_float((unsigned)x1[r][hh] << 16), b = __uint_as_float((unsigned)x2[r][hh] << 16);
                kr[hh * 128 + F.lane] = (bf16)(pk2(a * c[r] - b * s[r], 0.f) & 0xffffu); kr[hh * 128 + 64 + F.lane] = (bf16)(pk2(b * c[r] + a * s[r], 0.f) & 0xffffu); } }
    }
}
__device__ __forceinline__ void comb_phase(const Frame& F, const bf16* o2, const float* lq1, const float* lk1, const float* lq2, const float* lk2, const float* sg, unsigned char* cat8) {
    const float d1 = wave_sum(lq1[F.lane] * lk1[F.lane] + lq1[64 + F.lane] * lk1[64 + F.lane]), d2 = wave_sum(lq2[F.lane] * lk2[F.lane] + lq2[64 + F.lane] * lk2[64 + F.lane]);
    const float lam = __expf(d1) - __expf(d2) + LAMBDA_INIT1;
    const f32x4 g4 = *((const GAS f32x4*)sg + F.lane);
    for (int t0 = F.gw * 2; t0 < T; t0 += F.NGW * 2) {
        v2u a[2][4], b[2][4];
#pragma unroll
        for (int r = 0; r < 2; ++r)
#pragma unroll
            for (int h = 0; h < 4; ++h) { a[r][h] = *((const GAS v2u*)(o2 + (size_t)(t0 + r) * 2048 + h * 512) + F.lane); b[r][h] = *((const GAS v2u*)(o2 + (size_t)(t0 + r) * 2048 + h * 512 + 256) + F.lane); }
#pragma unroll
        for (int r = 0; r < 2; ++r)
#pragma unroll
            for (int h = 0; h < 4; ++h) {
                f32x4 v; v.x = bflo(a[r][h].x) - lam * bflo(b[r][h].x); v.y = bfhi(a[r][h].x) - lam * bfhi(b[r][h].x); v.z = bflo(a[r][h].y) - lam * bflo(b[r][h].y); v.w = bfhi(a[r][h].y) - lam * bfhi(b[r][h].y);
                const float rstd = 1.0f / sqrtf(wave_sum((v.x * v.x + v.y * v.y) + (v.z * v.z + v.w * v.w)) * (1.0f / 256.0f) + RMS_EPS) * (1.0f - LAMBDA_INIT1);
                *((GAS unsigned*)(cat8 + (size_t)(t0 + r) * D + h * 256) + F.lane) = pk4_fp8(v.x * rstd * g4.x * CAT_SC, v.y * rstd * g4.y * CAT_SC, v.z * rstd * g4.z * CAT_SC, v.w * rstd * g4.w * CAT_SC);
            }
    }
}
typedef att::Cfg<192, 768, 1024, 1024, 1024, 8, 2, 72169> AttL0;
typedef att::Cfg<128, 3072, 3072, 3072, 2048, 0, 4, 88388> AttL1;
static_assert(AttL0::LDS_BYTES <= LDSCTL_OFF && att2::LDS_BYTES_CV <= LDSCTL_OFF && MOE_OFF + (64 + MAXBLK) * 4 <= LDS_BYTES, "LDS map");
struct Args { const float* in[38]; float* out; unsigned char* ws; int ph_lo, ph_hi, li, pad; };
__global__ void __launch_bounds__(NWAVES * 64, 2) mega_fwd(Args args) {
    extern __shared__ __attribute__((aligned(16))) unsigned char lds[];
    Frame F;
    F.lds = (LAS unsigned char*)lds;
    F.tid = threadIdx.x; F.lane = F.tid & 63; F.wave = __builtin_amdgcn_readfirstlane(F.tid >> 6);
    F.G = gridDim.x; { const int bx = blockIdx.x; F.vcu = (F.G % 8 == 0) ? (bx % 8) * (F.G / 8) + bx / 8 : bx; }
    F.gw = F.vcu * NWAVES + F.wave; F.NGW = F.G * NWAVES;
    unsigned char* ws = args.ws;
    F.ctl = (gu32*)(ws + WS_CTL);
    for (int u = F.tid; u < (LDS_BYTES - LDSCTL_OFF) / 4; u += NWAVES * 64) ((LAS unsigned*)(F.lds + LDSCTL_OFF))[u] = 0u;
    __syncthreads();
    XcdBarrier bar; bar.bar = (unsigned*)(F.ctl + CW_BAR); bar.x = 0; bar.st = nullptr;
    if (!MK_PER_PHASE) bar = xcd_barrier_post((unsigned*)(F.ctl + CW_BAR), (volatile LAS unsigned*)(F.lds + MISC_OFF) + 8);
#define GRID_BAR() do { if (!MK_PER_PHASE) xcd_barrier(bar); } while (0)
#define PH_BEGIN() do { F.tid = tid_opaque(); F.lane = F.tid & 63; } while (0)
    const int lo = args.ph_lo, hi = args.ph_hi;
#define IN(k) (lo <= (k) && (k) < hi)
#define BOTH(k) (IN(k) && IN((k) + 1))
    const float* x = args.in[0]; float* OUT = args.out; bf16* VB = (bf16*)(ws + WS_VB);
    bf16* WIN = (bf16*)(ws + WS_WIN); bf16* WQU = (bf16*)(ws + WS_WQU); bf16* WKVU = (bf16*)(ws + WS_WKVU); bf16* WO0 = (bf16*)(ws + WS_WO0); bf16* WR0 = (bf16*)(ws + WS_WR0);
    bf16* WQKV = (bf16*)(ws + WS_WQKV); bf16* WO1 = (bf16*)(ws + WS_WO1); bf16* WR1 = (bf16*)(ws + WS_WR1); unsigned char* WGU = ws + WS_WGU; unsigned char* WDN = ws + WS_WDN; unsigned char* X8 = ws + WS_X8;
    float* COS64 = (float*)(ws + WS_COS64); float* SIN64 = (float*)(ws + WS_SIN64); float* COS128 = (float*)(ws + WS_COS128); float* SIN128 = (float*)(ws + WS_SIN128);
    bf16* XB = (bf16*)(ws + WS_XB); bf16* PROJ = (bf16*)(ws + WS_PROJ); bf16* UG = (bf16*)(ws + WS_UG); bf16* QLN = (bf16*)(ws + WS_QLN); bf16* KVLN = (bf16*)(ws + WS_KVLN); bf16* KROPE = (bf16*)(ws + WS_KROPE);
    bf16* Q0 = (bf16*)(ws + WS_Q0); bf16* KV0 = (bf16*)(ws + WS_KV0); bf16* CAT = (bf16*)(ws + WS_CAT); bf16* QKV = (bf16*)(ws + WS_QKV); bf16* O2 = (bf16*)(ws + WS_O2);
    unsigned char* YS = ws + WS_XG + 136 * MiB; unsigned char* ACT = ws + WS_ACT;
    int* TKE = (int*)(ws + WS_TKE); float* TKG = (float*)(ws + WS_TKG); int* TKR = (int*)(ws + WS_TKR); int* TDEST = (int*)(ws + WS_TDEST); int* ROWTOK = (int*)(ws + WS_ROWTOK);
    const LAS int* tb = (const LAS int*)(F.lds + MOE_OFF);

    if (IN(0)) { PH_BEGIN();
        convert_matrix8<3>(F, args.in[1], 1024, 1728, (unsigned char*)WIN, 1, WGU_SC);  zero_bytes16(F, (unsigned char*)WIN + (size_t)704 * 1024, (size_t)64 * 1024);
        convert_matrix<0>(F, args.in[3], 384, 768, WQU, 1);
        convert_matrix<0>(F, args.in[5], 256, 1024, WKVU, 1);
        convert_matrix8<0>(F, args.in[10], 1024, 1024, (unsigned char*)WO0, 1, WDN_SC);
        convert_matrix<0>(F, args.in[13], 1024, 32, WR0, 1);
        convert_matrix8<2>(F, args.in[21], 1024, 3072, (unsigned char*)WQKV, 1, WGU_SC);
        convert_matrix8<0>(F, args.in[27], 1024, 1024, (unsigned char*)WO1, 1, WDN_SC);
        convert_matrix<0>(F, args.in[30], 1024, 32, WR1, 1);
        convert_matrix8<1>(F, args.in[15], 1024, 2048, WGU, NEXP, WGU_SC);
        convert_matrix8<0>(F, args.in[17], 1024, 1024, WDN, NEXP, WDN_SC);
        rows_to_bf16(F, x, XB, X8);
        rope_tables(F, COS64, SIN64, 32); rope_tables(F, COS128, SIN128, 64);
        if (BOTH(0)) GRID_BAR();
    }
    if (IN(1)) { PH_BEGIN();
        pg8::Gemm g{(const bf16*)X8, WIN, T, NPROJ, 512}; pg8::StaticOrder S; S.init(T, NPROJ, F.G, (int)blockIdx.x);
        pg8::EpiInProj E{PROJ, UG, 1.0f / (XSC * WGU_SC)};
        pg8::gemm_phase<pg8::EpiInProj, pg8::StaticOrder, true, true, true>(F.lds, g, S, E);
        if (BOTH(1)) GRID_BAR();
    }
    if (IN(2)) { PH_BEGIN();
        conv_prefetch(F, UG);
        mid0_rows(F, PROJ, args.in[2], args.in[4], COS64, SIN64, QLN, KVLN, KROPE);
        conv_phase(F, UG, args.in[6], args.in[7], args.in[8], args.in[9], CAT);
        if (BOTH(2)) GRID_BAR();
    }
    if (IN(3)) { PH_BEGIN();
        { pg8::Gemm g{QLN, WQU, T, 768, 384}; pg8::StaticOrder S; S.init(T, 768, F.G, (int)blockIdx.x); pg8::EpiBf16 E{Q0, 768, 1.0f};
          pg8::gemm_phase<pg8::EpiBf16, pg8::StaticOrder, true, true>(F.lds, g, S, E); }
        { pg8::Gemm g{KVLN, WKVU, T, 1024, 256}; pg8::StaticOrder S; S.init(T, 1024, F.G, (int)blockIdx.x); pg8::EpiBf16 E{KV0, 1024, 1.0f};
          pg8::gemm_phase<pg8::EpiBf16, pg8::StaticOrder, true, true>(F.lds, g, S, E); }
        if (BOTH(3)) GRID_BAR();
    }
    if (IN(4)) { PH_BEGIN();
        const bf16* q = Q0; const bf16* kv = KV0; const bf16* krp = KROPE; bf16* cat = CAT;
        auto ref = [=](int bh, int qb) { const int b = bh >> 2, h = bh & 3; const size_t rb = (size_t)b * SEQ, r0 = rb + (size_t)qb * 256;
            return att::BlockRef{q + r0 * 768 + h * 192, kv + rb * 1024 + h * 256, krp + rb * 64, kv + rb * 1024 + h * 256 + 128, (bf16*)((unsigned char*)cat + r0 * 1024 + h * 128)  , qb * 256}; };
        att::phase<AttL0>((char*)lds, F.vcu, F.G, 8 * 4 * 8, ref, COS64, SIN64);
        if (BOTH(4)) GRID_BAR();
    }
    if (IN(5)) { PH_BEGIN();
        pg8::Gemm g{CAT, WO0, T, D, D / 2}; pg8::StaticOrder S; S.init(T, D, F.G, (int)blockIdx.x); pg8::EpiResBf16 E{XB, VB, DN_ALPHA, 1.0f / (CAT_SC * WDN_SC)};
        pg8::gemm_phase<pg8::EpiResBf16, pg8::StaticOrder, true, true, true>(F.lds, g, S, E);
        if (BOTH(5)) GRID_BAR();
    }
    if (IN(8)) { PH_BEGIN(); topk_phase(F, XB, WR0, args.in[14], (unsigned*)(F.ctl + CW_CNT), TKE, TKG, TKR, ROWTOK, VB, args.in[11], args.in[12], X8); if (BOTH(8)) GRID_BAR(); }
    if (IN(10)) { PH_BEGIN();
        moe_tables(F, (const unsigned*)(F.ctl + CW_CNT));
        pg8::Gemm g{(const bf16*)X8, (const bf16*)WGU, MAXROWS, 2048, D / 2}; const pg8::GatherA GA{ROWTOK, (LAS int*)(F.lds + RING_BYTES), T - 1, tb, T}; pg8::MoeOrder S; S.init(tb[33], 8, F.G, (int)blockIdx.x, tb + 64); pg8::EpiSwiGLU E{ACT, args.in[16], 1.0f / (XSC * WGU_SC), ACT_SC, (LAS float*)(F.lds + RING_BYTES + 2048)};
        pg8::gemm_phase<pg8::EpiSwiGLU, pg8::MoeOrder, true, true, true, true>(F.lds, g, S, E, GA);
        if (BOTH(10)) GRID_BAR();
    }
    if (IN(11)) { PH_BEGIN();
        if (MK_PER_PHASE) moe_tables(F, (const unsigned*)(F.ctl + CW_CNT));
        pg8::Gemm g{(const bf16*)ACT, (const bf16*)WDN, MAXROWS, D, D / 2}; pg8::MoeOrder S; S.init(tb[33], 4, F.G, (int)blockIdx.x, tb + 64); pg8::EpiDown E{YS, args.in[18], 1.0f / (ACT_SC * WDN_SC), YSC, (LAS float*)(F.lds + RING_BYTES + 2048)};
        pg8::gemm_phase<pg8::EpiDown, pg8::MoeOrder, true, true, true>(F.lds, g, S, E);
        if (BOTH(11)) GRID_BAR();
    }
    if (IN(12)) { PH_BEGIN();
        if (MK_PER_PHASE) moe_tables(F, (const unsigned*)(F.ctl + CW_CNT));
        ln_phase<true, false>(F, XB, args.in[19], args.in[20], XB, X8, nullptr, YS, TKE, TKG);
        if (BOTH(12)) GRID_BAR();
    }
    if (IN(13)) { PH_BEGIN();
        pg8::Gemm g{(const bf16*)X8, WQKV, T, 3072, D / 2}; pg8::StaticOrder S; S.init(T, 3072, F.G, (int)blockIdx.x); pg8::EpiQKV E{QKV, COS128, SIN128, 1.0f / (XSC * WGU_SC), F.lds + RING_BYTES + 4096};
        pg8::gemm_phase<pg8::EpiQKV, pg8::StaticOrder, true, true, true>(F.lds, g, S, E);
        if (BOTH(13)) GRID_BAR();
    }
    if (IN(15)) { PH_BEGIN();
        const bf16* qkv = QKV; bf16* o2 = O2;
        auto ref = [=](int cb, int qb) { const int hm = cb & 7, b = cb >> 3; const size_t rb = (size_t)b * SEQ, r0 = rb + (size_t)qb * 128;
            return att2::BlockRef{qkv + r0 * 3072 + hm * 128, qkv + rb * 3072 + 1024 + hm * 128, qkv + rb * 3072 + 2048 + (hm >> 1) * 256, o2 + r0 * 2048 + hm * 256, qb * 128}; };
        att2::phase((char*)lds, F.vcu, F.G, 8 * 8 * 16, ref, COS128, SIN128, args.in[32], args.in[34], WGU, WDN);
        if (BOTH(15)) GRID_BAR();
    }
    if (IN(16)) { PH_BEGIN(); comb_phase(F, O2, args.in[22], args.in[23], args.in[24], args.in[25], args.in[26], (unsigned char*)CAT);     if (BOTH(16)) GRID_BAR(); }
    if (IN(17)) { PH_BEGIN();
        pg8::Gemm g{CAT, WO1, T, D, D / 2}; pg8::StaticOrder S; S.init(T, D, F.G, (int)blockIdx.x); pg8::EpiResBf16 E{XB, VB, DN_ALPHA, 1.0f / (CAT_SC * WDN_SC)};
        pg8::gemm_phase<pg8::EpiResBf16, pg8::StaticOrder, true, true, true>(F.lds, g, S, E);
        if (BOTH(17)) GRID_BAR();
    }
    if (IN(20)) { PH_BEGIN(); topk_phase(F, XB, WR1, args.in[31], (unsigned*)(F.ctl + CW_CNT + 64), TKE, TKG, TKR, ROWTOK, VB, args.in[28], args.in[29], X8); if (BOTH(20)) GRID_BAR(); }
    if (IN(22)) { PH_BEGIN();
        moe_tables(F, (const unsigned*)(F.ctl + CW_CNT + 64));
        pg8::Gemm g{(const bf16*)X8, (const bf16*)WGU, MAXROWS, 2048, D / 2}; const pg8::GatherA GA{ROWTOK, (LAS int*)(F.lds + RING_BYTES), T - 1, tb, T}; pg8::MoeOrder S; S.init(tb[33], 8, F.G, (int)blockIdx.x, tb + 64); pg8::EpiSwiGLU E{ACT, args.in[33], 1.0f / (XSC * WGU_SC), ACT_SC, (LAS float*)(F.lds + RING_BYTES + 2048)};
        pg8::gemm_phase<pg8::EpiSwiGLU, pg8::MoeOrder, true, true, true, true>(F.lds, g, S, E, GA);
        if (BOTH(22)) GRID_BAR();
    }
    if (IN(23)) { PH_BEGIN();
        if (MK_PER_PHASE) moe_tables(F, (const unsigned*)(F.ctl + CW_CNT + 64));
        pg8::Gemm g{(const bf16*)ACT, (const bf16*)WDN, MAXROWS, D, D / 2}; pg8::MoeOrder S; S.init(tb[33], 4, F.G, (int)blockIdx.x, tb + 64); pg8::EpiDown E{YS, args.in[35], 1.0f / (ACT_SC * WDN_SC), YSC, (LAS float*)(F.lds + RING_BYTES + 2048)};
        pg8::gemm_phase<pg8::EpiDown, pg8::MoeOrder, true, true, true>(F.lds, g, S, E);
        if (BOTH(23)) GRID_BAR();
    }
    if (IN(24)) { PH_BEGIN(); if (MK_PER_PHASE) moe_tables(F, (const unsigned*)(F.ctl + CW_CNT + 64)); ln_phase<true, true>(F, XB, args.in[36], args.in[37], nullptr, nullptr, OUT, YS, TKE, TKG); }
#undef IN
#undef BOTH
#undef GRID_BAR
}

extern "C" void kernel_launch(void* const* d_in, const int* in_sizes, int n_in, void* d_out, int out_size, void* d_ws, size_t ws_size, hipStream_t stream) {
    static int grid = 0;
    if (grid == 0) {
        if (n_in != 38 || in_sizes[0] != T * D || out_size != T * D || ws_size < WS_END) { fprintf(stderr, "kernel_launch: unexpected shapes (n_in %d, in0 %d, out %d, ws %zu < %zu)\n", n_in, n_in > 0 ? in_sizes[0] : -1, out_size, ws_size, (size_t)WS_END); grid = -1; return; }
        int dev = 0, cus = 0, per_cu = 0;
        if (hipGetDevice(&dev) != hipSuccess || hipDeviceGetAttribute(&cus, hipDeviceAttributeMultiprocessorCount, dev) != hipSuccess) { grid = -1; return; }
        if (hipFuncSetAttribute((const void*)mega_fwd, hipFuncAttributeMaxDynamicSharedMemorySize, LDS_BYTES) != hipSuccess) { fprintf(stderr, "kernel_launch: hipFuncSetAttribute failed\n"); grid = -1; return; }
        if (hipOccupancyMaxActiveBlocksPerMultiprocessor(&per_cu, (const void*)mega_fwd, NWAVES * 64, LDS_BYTES) != hipSuccess || per_cu < 1) { fprintf(stderr, "kernel_launch: occupancy query says %d\n", per_cu); }
        (void)hipGetLastError();
        grid = cus;
    }
    if (grid < 0) return;
    if (hipMemsetAsync((char*)d_ws + WS_CTL, 0, CTL_ZERO_BYTES, stream) != hipSuccess) return;
    Args a{};
    for (int i = 0; i < 38; ++i) a.in[i] = (const float*)d_in[i];
    a.out = (float*)d_out; a.ws = (unsigned char*)d_ws; a.li = 0; a.pad = 0;
#if MK_PER_PHASE
    for (int p = 0; p < NPHASE; ++p) { a.ph_lo = p; a.ph_hi = p + 1; hipLaunchKernelGGL(mega_fwd, dim3(grid), dim3(NWAVES * 64), LDS_BYTES, stream, a); }
#else
    a.ph_lo = 0; a.ph_hi = NPHASE;
    hipLaunchKernelGGL(mega_fwd, dim3(grid), dim3(NWAVES * 64), LDS_BYTES, stream, a);
#endif
}
```

```cpp
#include <hip/hip_runtime.h>
#include <cstdio>
#include <cstdint>
__device__ __forceinline__ int tid_opaque() { int t = threadIdx.x; asm volatile("" : "+v"(t)); return t; }
namespace pg8 {
#define PG8_LAS __attribute__((address_space(3)))
typedef unsigned short bf16_t;
typedef short bf16x8 __attribute__((ext_vector_type(8)));
typedef short bf16x16 __attribute__((ext_vector_type(16)));
typedef int v8i __attribute__((ext_vector_type(8)));
typedef int v4i __attribute__((ext_vector_type(4)));
typedef float f32x4 __attribute__((ext_vector_type(4)));
typedef unsigned u32x4 __attribute__((ext_vector_type(4)));
constexpr int BM = 256, BK = 64, HALF = 128, HTB = HALF * BK * 2  , STAGE_BYTES = 8 * HTB, NXCD = 8, WGM = 8;

__host__ __device__ __forceinline__ int lds_byte(int r, int c) { const int st = (r >> 4) * 2 + (c >> 5), rr = r & 15, cc = c & 31, ob = rr * 64 + cc * 2; return st * 1024 + (ob ^ (((ob >> 9) & 1) << 5)); }
__host__ __device__ __forceinline__ void stage_rc(int b, int& R, int& C) { const int st = b / 1024, sb = b % 1024, swz = sb ^ (((sb >> 9) & 1) << 5); R = (st >> 1) * 16 + swz / 64; C = (st & 1) * 32 + (swz % 64) / 2; }
__host__ __device__ __forceinline__ int perm32(int rho) { const int n = rho >> 4, i = rho & 15; return 8 * (i >> 2) + 4 * n + (i & 3); }

struct Unit { int pm, pn; };
struct Gemm { const bf16_t* A; const bf16_t* Bt; int M, N, K; };

struct StaticOrder {
    int nM, nN, nwg, G, c;
    __host__ __device__ void init(int M, int N, int G_, int c_) { nM = M / BM; nN = N / BM; nwg = nM * nN; G = G_; c = c_; }
    __host__ __device__ bool next(int i, Unit& u) const {
        const long L = (long)i * G + c; if (L >= nwg) return false;
        int wgid = (int)L; { const int q = nwg / NXCD, r = nwg % NXCD, xcd = wgid % NXCD, off = wgid / NXCD; wgid = (xcd < r ? xcd * (q + 1) : r * (q + 1) + (xcd - r) * q) + off; }
        const int nig = WGM * nN, gid = wgid / nig, fm = gid * WGM, gsz = (nM - fm) < WGM ? (nM - fm) : WGM;
        u.pm = fm + ((wgid % nig) % gsz); u.pn = (wgid % nig) / gsz; return true;
    }
    __device__ __forceinline__ void a_ready(const Unit&) const {}
    __device__ __forceinline__ void done(const Unit&) const {}
};

__device__ __forceinline__ unsigned cvt_pk_bf16(float lo, float hi) { unsigned r; asm volatile("v_cvt_pk_bf16_f32 %0, %1, %2" : "=v"(r) : "v"(lo), "v"(hi)); return r; }
typedef float f32x2 __attribute__((ext_vector_type(2)));
__device__ __forceinline__ u32x4 pack8_bf16(const f32x4 v0, const f32x4 v1) { u32x4 w; w.x = cvt_pk_bf16(v0[0], v0[1]); w.y = cvt_pk_bf16(v0[2], v0[3]); w.z = cvt_pk_bf16(v1[0], v1[1]); w.w = cvt_pk_bf16(v1[2], v1[3]); return w; }
constexpr int TB_STRIDE = 528, TB_BYTES = 32 * TB_STRIDE;
#define PG8_LBAR() asm volatile("s_waitcnt lgkmcnt(0)\n\ts_barrier" ::: "memory")
template <class RowFn>
__device__ __forceinline__ void tile_rows_step_at(PG8_LAS unsigned char* tb, int wr, int fr, int piece0, int dist, int wid, int lane, const u32x4 w0, const u32x4 w1, const RowFn& rowfn) {
    PG8_LAS unsigned char* wp = tb + (wr * 16 + fr) * TB_STRIDE + piece0;
    *(PG8_LAS u32x4*)wp = w0; *(PG8_LAS u32x4*)(wp + dist) = w1;
    PG8_LBAR();
#pragma unroll
    for (int j = 0; j < 2; ++j) { const int rl = 4 * wid + 2 * j + (lane >> 5), ch = lane & 31;
        const u32x4 d = *(const PG8_LAS u32x4*)(tb + rl * TB_STRIDE + ch * 16);
        rowfn(j, rl, ch, d); }
    PG8_LBAR();
}
template <class RowFn>
__device__ __forceinline__ void tile_rows_step(PG8_LAS unsigned char* tb, int wr, int wc, int fr, int fq, const u32x4 w0, const u32x4 w1, const RowFn& rowfn) {
    tile_rows_step_at(tb, wr, fr, wc * 64 + fq * 16, 256, wr * 4 + wc, fq * 16 + fr, w0, w1, rowfn);
}
__device__ __forceinline__ int tile_row(int pm, int ai, int m, int rl) { return pm * BM + ai * HALF + (rl >> 4) * 64 + m * 16 + (rl & 15); }
struct EpiBf16 {
    static constexpr bool PERM = true, AFTER_DRAIN = false, LDS_BIAS = false;
    bf16_t* O; int ldc; float sc;
    __device__ __forceinline__ void operator()(const f32x4 (&acc)[2][2][4][2], const Unit& u, int wr, int wc, int fr, int fq) const {
        const int row0 = u.pm * BM + wr * 64 + fr, col0 = u.pn * BM + wc * 32 + 8 * fq;
#pragma unroll
        for (int ai = 0; ai < 2; ++ai)
#pragma unroll
            for (int m = 0; m < 4; ++m) { bf16_t* rowp = O + (size_t)(row0 + ai * HALF + m * 16) * ldc + col0;
#pragma unroll
                for (int bj = 0; bj < 2; ++bj) *(u32x4*)(rowp + bj * HALF) = pack8_bf16(acc[ai][bj][m][0] * sc, acc[ai][bj][m][1] * sc); }
    }
};
struct EpiInProj {
    static constexpr bool PERM = true, AFTER_DRAIN = false, LDS_BIAS = false;
    bf16_t* proj; bf16_t* ug; float sc;
    __device__ __forceinline__ void operator()(const f32x4 (&acc)[2][2][4][2], const Unit& u, int wr, int wc, int fr, int fq) const {
        const int row0 = u.pm * BM + wr * 64 + fr;
        if (u.pn < 3) {
            const int col0 = u.pn * BM + wc * 32 + 8 * fq;
#pragma unroll
            for (int ai = 0; ai < 2; ++ai)
#pragma unroll
                for (int m = 0; m < 4; ++m) { bf16_t* rowp = proj + (size_t)(row0 + ai * HALF + m * 16) * 768 + col0;
#pragma unroll
                    for (int bj = 0; bj < 2; ++bj) *(u32x4*)(rowp + bj * HALF) = pack8_bf16(acc[ai][bj][m][0] * sc, acc[ai][bj][m][1] * sc); }
        } else {
            const int col0 = (u.pn - 3) * HALF + wc * 32 + 8 * fq; const float ks = -1.4426950408889634f * sc;
#pragma unroll
            for (int ai = 0; ai < 2; ++ai)
#pragma unroll
                for (int m = 0; m < 4; ++m) { f32x4 o[2];
#pragma unroll
                    for (int n = 0; n < 2; ++n)
#pragma unroll
                        for (int q = 0; q < 4; ++q) o[n][q] = acc[ai][0][m][n][q] * sc * __builtin_amdgcn_rcpf(1.0f + __builtin_amdgcn_exp2f(acc[ai][1][m][n][q] * ks));
                    *(u32x4*)(ug + (size_t)(row0 + ai * HALF + m * 16) * 512 + col0) = pack8_bf16(o[0], o[1]); }
        }
    }
};
struct EpiQKV {
    static constexpr bool PERM = true, AFTER_DRAIN = false, LDS_BIAS = false;
    bf16_t* O; const float* cs; const float* sn; float sc; PG8_LAS unsigned char* tb;
    __device__ __forceinline__ void operator()(const f32x4 (&acc)[2][2][4][2], const Unit& u, int wr, int wc, int fr, int fq) const {
        const int row0 = u.pm * BM + wr * 64 + fr, pm = u.pm; const float s_ = sc; PG8_LAS unsigned char* const tb_ = tb; const float* const cs_ = cs; const float* const sn_ = sn;
        if (u.pn < 8) {
            const int dim = (wc & 1) * 32 + 8 * fq; bf16_t* const Ot = O + u.pn * BM;
            const int wcx = (wc >> 1) * 4 + (wc & 1);
            f32x4 cq[3][4];
#define PG8_ROPE_LD(st) do { const int pos_ = (row0 + ((st) >> 2) * HALF + ((st) & 3) * 16) & 4095; const float* cp_ = cs_ + pos_ * 64 + dim; const float* sp_ = sn_ + pos_ * 64 + dim; \
                cq[(st) % 3][0] = *(const f32x4*)cp_; cq[(st) % 3][1] = *(const f32x4*)(cp_ + 4); cq[(st) % 3][2] = *(const f32x4*)sp_; cq[(st) % 3][3] = *(const f32x4*)(sp_ + 4); } while (0)
            PG8_ROPE_LD(0); PG8_ROPE_LD(1);
#pragma unroll
            for (int st = 0; st < 8; ++st) { const int ai = st >> 2, m = st & 3;
                if (st + 2 < 8) PG8_ROPE_LD(st + 2);
                const f32x4 c0 = cq[st % 3][0], c1 = cq[st % 3][1], s0 = cq[st % 3][2], s1 = cq[st % 3][3];
                const f32x4 a0 = acc[ai][0][m][0] * s_, a1 = acc[ai][0][m][1] * s_, b0 = acc[ai][1][m][0] * s_, b1 = acc[ai][1][m][1] * s_;
                bf16_t* rowp = O + (size_t)(row0 + ai * HALF + m * 16) * 3072 + (2 * u.pn + (wc >> 1)) * 128 + dim;
                *(u32x4*)rowp = pack8_bf16(a0 * c0 - b0 * s0, a1 * c1 - b1 * s1);
                *(u32x4*)(rowp + 64) = pack8_bf16(b0 * c0 + a0 * s0, b1 * c1 + a1 * s1); }
#undef PG8_ROPE_LD
        } else {
            const int col0 = u.pn * BM + wc * 32 + 8 * fq;
#pragma unroll
            for (int ai = 0; ai < 2; ++ai)
#pragma unroll
                for (int m = 0; m < 4; ++m) { bf16_t* rowp = O + (size_t)(row0 + ai * HALF + m * 16) * 3072 + col0;
#pragma unroll
                    for (int bj = 0; bj < 2; ++bj) *(u32x4*)(rowp + bj * HALF) = pack8_bf16(acc[ai][bj][m][0] * s_, acc[ai][bj][m][1] * s_); }
        }
    }
};
struct EpiResBf16 {
    static constexpr bool PERM = true, AFTER_DRAIN = false, LDS_BIAS = false;
    const bf16_t* res; bf16_t* vb; float alpha, sc;
    __device__ __forceinline__ void operator()(const f32x4 (&acc)[2][2][4][2], const Unit& u, int wr, int wc, int fr, int fq) const {
        const int row0 = u.pm * BM + wr * 64 + fr, col0 = u.pn * BM + wc * 32 + 8 * fq;
#pragma unroll
        for (int ai = 0; ai < 2; ++ai)
#pragma unroll
            for (int m = 0; m < 4; ++m) { const size_t off = (size_t)(row0 + ai * HALF + m * 16) * 1024 + col0;
#pragma unroll
                for (int bj = 0; bj < 2; ++bj) { const u32x4 r = *(const u32x4*)(res + off + bj * HALF);
                    f32x4 v0, v1;
                    v0[0] = __uint_as_float(r.x << 16); v0[1] = __uint_as_float(r.x & 0xffff0000u); v0[2] = __uint_as_float(r.y << 16); v0[3] = __uint_as_float(r.y & 0xffff0000u);
                    v1[0] = __uint_as_float(r.z << 16); v1[1] = __uint_as_float(r.z & 0xffff0000u); v1[2] = __uint_as_float(r.w << 16); v1[3] = __uint_as_float(r.w & 0xffff0000u);
                    *(u32x4*)(vb + off + bj * HALF) = pack8_bf16(v0 * alpha + acc[ai][bj][m][0] * sc, v1 * alpha + acc[ai][bj][m][1] * sc); } }
    }
};
struct EpiRouter {
    static constexpr bool PERM = false, AFTER_DRAIN = false, LDS_BIAS = false;
    float* lg; const float* bias;
    __device__ __forceinline__ void operator()(const f32x4 (&acc)[2][2][4][2], const Unit& u, int wr, int wc, int fr, int fq) const {
        if (wc != 0) return;
        const int row0 = u.pm * BM + wr * 64 + fr;
        const f32x4 b0 = *(const f32x4*)(bias + 4 * fq), b1 = *(const f32x4*)(bias + 16 + 4 * fq);
#pragma unroll
        for (int ai = 0; ai < 2; ++ai)
#pragma unroll
            for (int m = 0; m < 4; ++m) { float* p = lg + (size_t)(row0 + ai * HALF + m * 16) * 32 + 4 * fq;
                *(f32x4*)p = acc[ai][0][m][0] + b0; *(f32x4*)(p + 16) = acc[ai][0][m][1] + b1; }
    }
};
typedef unsigned u32x2 __attribute__((ext_vector_type(2)));
__device__ __forceinline__ float clamp448(float v) { return fminf(fmaxf(v, -448.0f), 448.0f); }
__device__ __forceinline__ unsigned pk4_fp8(float a, float b, float c, float d) { int w = __builtin_amdgcn_cvt_pk_fp8_f32(clamp448(a), clamp448(b), 0, false); w = __builtin_amdgcn_cvt_pk_fp8_f32(clamp448(c), clamp448(d), w, true); return (unsigned)w; }
struct EpiSwiGLU {
    static constexpr bool PERM = true, AFTER_DRAIN = false, LDS_BIAS = true;
    unsigned char* act; const float* bgu; float in_scale, out_scale; PG8_LAS float* bl;
    __device__ __forceinline__ const float* bias_src(const Unit& u, int lane) const { return bgu + (size_t)(u.pn >> 3) * 2048 + (lane >> 5) * 1024 + (u.pn & 7) * HALF + (lane & 31) * 4; }
    __device__ __forceinline__ void operator()(const f32x4 (&acc)[2][2][4][2], const Unit& u, int wr, int wc, int fr, int fq, int par) const {
        constexpr float C = 1.702f * 1.4426950408889634f;
        const int j = u.pn & 7, row0 = u.pm * BM + wr * 64 + fr, cw = j * HALF + wc * 32 + 8 * fq;
        const PG8_LAS float* bg = bl + par * 256 + wc * 32 + 8 * fq;
        const f32x4 bg0 = *(const PG8_LAS f32x4*)bg, bg1 = *(const PG8_LAS f32x4*)(bg + 4), bu0 = *(const PG8_LAS f32x4*)(bg + 128), bu1 = *(const PG8_LAS f32x4*)(bg + 132);
        const float k1 = -C * in_scale, K2 = -out_scale / C;
        f32x2 bgs[2][2], bu[2][2];
#pragma unroll
        for (int p = 0; p < 2; ++p) { bgs[0][p] = (f32x2){bg0[2 * p], bg0[2 * p + 1]} * -C; bgs[1][p] = (f32x2){bg1[2 * p], bg1[2 * p + 1]} * -C; bu[0][p] = (f32x2){bu0[2 * p], bu0[2 * p + 1]}; bu[1][p] = (f32x2){bu1[2 * p], bu1[2 * p + 1]}; }
#pragma unroll
        for (int ai = 0; ai < 2; ++ai)
#pragma unroll
            for (int m = 0; m < 4; ++m) {
                f32x2 g2[4], u2[4], d2[4], s2[4], a2[4];
#pragma unroll
                for (int i = 0; i < 4; ++i) { const int n = i >> 1, p = i & 1;
                    g2[i] = (f32x2){acc[ai][0][m][n][2 * p], acc[ai][0][m][n][2 * p + 1]} * k1 + bgs[n][p];
                    u2[i] = (f32x2){acc[ai][1][m][n][2 * p], acc[ai][1][m][n][2 * p + 1]} * in_scale + bu[n][p]; }
#pragma unroll
                for (int i = 0; i < 4; ++i) { g2[i].x = __builtin_amdgcn_fmed3f(g2[i].x, -7.0f * C, 30.0f); g2[i].y = __builtin_amdgcn_fmed3f(g2[i].y, -7.0f * C, 30.0f); }
#pragma unroll
                for (int i = 0; i < 4; ++i) d2[i] = (f32x2){__builtin_amdgcn_exp2f(g2[i].x), __builtin_amdgcn_exp2f(g2[i].y)};
#pragma unroll
                for (int i = 0; i < 4; ++i) { u2[i].x = __builtin_amdgcn_fmed3f(u2[i].x, -7.0f, 7.0f); u2[i].y = __builtin_amdgcn_fmed3f(u2[i].y, -7.0f, 7.0f); }
#pragma unroll
                for (int i = 0; i < 4; ++i) d2[i] = d2[i] + 1.0f;
#pragma unroll
                for (int i = 0; i < 4; ++i) a2[i] = (u2[i] * K2 + K2) * g2[i];
                { const f32x2 p01 = d2[0] * d2[1], p23 = d2[2] * d2[3], pp = p01 * p23; const f32x2 r = (f32x2){__builtin_amdgcn_rcpf(pp.x), __builtin_amdgcn_rcpf(pp.y)};
                  const f32x2 r01 = r * p23, r23 = r * p01;
                  s2[0] = r01 * d2[1]; s2[1] = r01 * d2[0]; s2[2] = r23 * d2[3]; s2[3] = r23 * d2[2]; }
#pragma unroll
                for (int i = 0; i < 4; ++i) a2[i] = a2[i] * s2[i];
                int w0 = __builtin_amdgcn_cvt_pk_fp8_f32(a2[0].x, a2[0].y, 0, false); w0 = __builtin_amdgcn_cvt_pk_fp8_f32(a2[1].x, a2[1].y, w0, true);
                int w1 = __builtin_amdgcn_cvt_pk_fp8_f32(a2[2].x, a2[2].y, 0, false); w1 = __builtin_amdgcn_cvt_pk_fp8_f32(a2[3].x, a2[3].y, w1, true);
                *(u32x2*)(act + (size_t)(row0 + ai * HALF + m * 16) * 1024 + cw) = (u32x2){(unsigned)w0, (unsigned)w1}; }
    }
};
struct EpiDown {
    static constexpr bool PERM = true, AFTER_DRAIN = false, LDS_BIAS = true;
    unsigned char* ys; const float* bdn; float in_scale, out_scale; PG8_LAS float* bl;
    __device__ __forceinline__ const float* bias_src(const Unit& u, int lane) const { return bdn + (size_t)(u.pn >> 2) * 1024 + (u.pn & 3) * BM + lane * 4; }
    __device__ __forceinline__ void operator()(const f32x4 (&acc)[2][2][4][2], const Unit& u, int wr, int wc, int fr, int fq, int par) const {
        const int row0 = u.pm * BM + wr * 64 + fr, col0 = (u.pn & 3) * BM + wc * 32 + 8 * fq;
        f32x4 bv[2][2];
#pragma unroll
        for (int bj = 0; bj < 2; ++bj)
#pragma unroll
            for (int n = 0; n < 2; ++n) bv[bj][n] = *(const PG8_LAS f32x4*)(bl + par * 256 + bj * HALF + wc * 32 + 8 * fq + 4 * n) * out_scale;
        const float sc = in_scale * out_scale;
#pragma unroll
        for (int ai = 0; ai < 2; ++ai)
#pragma unroll
            for (int m = 0; m < 4; ++m) { const int row = row0 + ai * HALF + m * 16;
#pragma unroll
                for (int bj = 0; bj < 2; ++bj) { const f32x4 a = acc[ai][bj][m][0] * sc + bv[bj][0], b = acc[ai][bj][m][1] * sc + bv[bj][1];
                    *(u32x2*)(ys + (size_t)row * 1024 + col0 + bj * HALF) = (u32x2){pk4_fp8(a[0], a[1], a[2], a[3]), pk4_fp8(b[0], b[1], b[2], b[3])}; } }
    }
};
struct MoeOrder {
    int nM, nN, nwg, G, c; const PG8_LAS int* blk_e;
    __device__ void init(int nblk, int nN_, int G_, int c_, const PG8_LAS int* be) { nM = nblk; nN = nN_; nwg = nM * nN; G = G_; c = c_; blk_e = be; }
    __device__ bool next(int i, Unit& u) const {
        const long L = (long)i * G + c; if (L >= nwg) return false;
        int wgid = (int)L; { const int q = nwg / NXCD, r = nwg % NXCD, xcd = wgid % NXCD, off = wgid / NXCD; wgid = (xcd < r ? xcd * (q + 1) : r * (q + 1) + (xcd - r) * q) + off; }
        const int nig = WGM * nN, gid = wgid / nig, fm = gid * WGM, gsz = (nM - fm) < WGM ? (nM - fm) : WGM;
        u.pm = fm + ((wgid % nig) % gsz); const int pl = (wgid % nig) / gsz; u.pn = blk_e[u.pm] * nN + pl; return true;
    }
    __device__ __forceinline__ void a_ready(const Unit&) const {}
    __device__ __forceinline__ void done(const Unit&) const {}
};
struct GatherA { const int* rowtok; PG8_LAS int* idx; int maxrow; const PG8_LAS int* tb; int estride;
    __device__ __forceinline__ const int* src(int pm) const { if (tb == nullptr) return rowtok + (size_t)pm * BM; const int e = tb[64 + pm]; return rowtok + (size_t)e * estride + (pm * BM - tb[e]); } };
template <class Epi, class Sched, bool ALIGN_EPI = false, bool SP2 = false, bool FP8 = false, bool GATH = false>
__device__ __forceinline__ void gemm_phase(PG8_LAS unsigned char* lds, const Gemm g, const Sched& S, const Epi& E, const GatherA ga = GatherA{nullptr, nullptr, 0, nullptr, 0}) {
    static_assert(!GATH || SP2, "gathered A rows: SP2 loop only");
    const int tid = tid_opaque(), wid = __builtin_amdgcn_readfirstlane(tid >> 6), lane = tid & 63, wr = wid >> 2, wc = wid & 3, fr = lane & 15, fq = lane >> 4;
    const int K = g.K, nt = K / BK;
    unsigned voffA[2], voffB[2];
#pragma unroll
    for (int i = 0; i < 2; ++i) { int R, C; stage_rc(tid * 16 + i * 8192, R, C); const int Rb = Epi::PERM ? ((R & ~31) + perm32(R & 31)) : R;
        voffA[i] = GATH ? (unsigned)(R * 65536 + C * 2) : (unsigned)(R * K + C) * 2u; voffB[i] = (unsigned)(Rb * K + C) * 2u; }
    const size_t kstep = (size_t)(BK * 2);
    const size_t hstep = (size_t)HALF * K * 2;
    const size_t tstep = 2 * hstep;
    const unsigned ldsw = (unsigned)wid * 1024u;
    const int aoff = lds_byte(wr * 64 + fr, fq * 8), boff = lds_byte(wc * 32 + fr, fq * 8);
#define PG8_SA(b, h) (((b) * 2 + (h)) * HTB)
#define PG8_SB(b, h) ((4 + (b) * 2 + (h)) * HTB)
#define PG8_STAGE(bufoff, gbase, voff) do { _Pragma("unroll") for (int _i = 0; _i < 2; ++_i) \
        __builtin_amdgcn_global_load_lds((const unsigned*)((const char*)(gbase) + (voff)[_i]), (PG8_LAS unsigned*)(lds + (bufoff) + ldsw + _i * 8192), 16, 0, 0); } while (0)
#define PG8_STAGE2(bufoff, gbase, o0, o1) do { \
        __builtin_amdgcn_global_load_lds((const unsigned*)((const char*)(gbase) + (o0)), (PG8_LAS unsigned*)(lds + (bufoff) + ldsw), 16, 0, 0); \
        __builtin_amdgcn_global_load_lds((const unsigned*)((const char*)(gbase) + (o1)), (PG8_LAS unsigned*)(lds + (bufoff) + ldsw + 8192), 16, 0, 0); } while (0)
#define PG8_STA(bufoff, bcont, bgath, o0, o1) do { if constexpr (GATH) PG8_STAGE2(bufoff, bgath, o0, o1); else PG8_STAGE(bufoff, bcont, voffA); } while (0)
#define PG8_GOFF(ix, d00, d01, d10, d11) do { const int r0_ = (int)(voffA[0] >> 16), r1_ = (int)(voffA[1] >> 16); const unsigned c0_ = voffA[0] & 0xffffu, c1_ = voffA[1] & 0xffffu; \
        const unsigned rb_ = (unsigned)K * 2u; const unsigned mx_ = (unsigned)ga.maxrow; \
        const unsigned t00_ = (unsigned)(ix)[r0_], t01_ = (unsigned)(ix)[r1_], t10_ = (unsigned)(ix)[128 + r0_], t11_ = (unsigned)(ix)[128 + r1_]; \
        d00 = (t00_ < mx_ ? t00_ : mx_) * rb_ + c0_; d01 = (t01_ < mx_ ? t01_ : mx_) * rb_ + c1_; d10 = (t10_ < mx_ ? t10_ : mx_) * rb_ + c0_; d11 = (t11_ < mx_ ? t11_ : mx_) * rb_ + c1_; } while (0)
#define PG8_LD8(p) __builtin_shufflevector(*(const PG8_LAS v4i*)(p), *(const PG8_LAS v4i*)((p) + 1024), 0, 1, 2, 3, 4, 5, 6, 7)
#define PG8_LDA(dst, b, h) do { if constexpr (FP8) { _Pragma("unroll") for (int m = 0; m < 4; ++m) dst##8[m] = PG8_LD8(lds + PG8_SA(b, h) + aoff + m * 2048); } \
        else { _Pragma("unroll") for (int m = 0; m < 4; ++m) _Pragma("unroll") for (int k = 0; k < 2; ++k) dst[m][k] = *(const PG8_LAS bf16x8*)(lds + PG8_SA(b, h) + aoff + m * 2048 + k * 1024); } } while (0)
#define PG8_LDB(dst, b, h) do { if constexpr (FP8) { _Pragma("unroll") for (int n = 0; n < 2; ++n) dst##8[n] = PG8_LD8(lds + PG8_SB(b, h) + boff + n * 2048); } \
        else { _Pragma("unroll") for (int n = 0; n < 2; ++n) _Pragma("unroll") for (int k = 0; k < 2; ++k) dst[n][k] = *(const PG8_LAS bf16x8*)(lds + PG8_SB(b, h) + boff + n * 2048 + k * 1024); } } while (0)
#define PG8_MMA(ai, bj, At, Bt) do { __builtin_amdgcn_s_setprio(1); if constexpr (FP8) { _Pragma("unroll") for (int m = 0; m < 4; ++m) _Pragma("unroll") for (int n = 0; n < 2; ++n) \
        asm volatile("v_mfma_f32_16x16x128_f8f6f4 %0, %1, %2, %0" : "+v"(acc[ai][bj][m][n]) : "v"(Bt##8[n]), "v"(At##8[m])); } \
    else { _Pragma("unroll") for (int m = 0; m < 4; ++m) _Pragma("unroll") for (int n = 0; n < 2; ++n) _Pragma("unroll") for (int k = 0; k < 2; ++k) \
        acc[ai][bj][m][n] = __builtin_amdgcn_mfma_f32_16x16x32_bf16(Bt[n][k], At[m][k], acc[ai][bj][m][n], 0, 0, 0); } __builtin_amdgcn_s_setprio(0); } while (0)
#define PG8_WAIT_V(n) asm volatile("s_waitcnt vmcnt(" #n ")" ::: "memory")
#define PG8_WAIT_L(n) asm volatile("s_waitcnt lgkmcnt(" #n ")" ::: "memory")
#define PG8_BAR __builtin_amdgcn_s_barrier()
#define PG8_BAR_() __builtin_amdgcn_s_barrier()
#define PG8_SCHED __builtin_amdgcn_sched_barrier(0)
    Unit cur, nxt; int ui = 0;
    if (!S.next(0, cur)) return;
    f32x4 acc[2][2][4][2];
#pragma unroll
    for (int a = 0; a < 2; ++a)
#pragma unroll
        for (int b = 0; b < 2; ++b)
#pragma unroll
            for (int m = 0; m < 4; ++m)
#pragma unroll
                for (int n = 0; n < 2; ++n) acc[a][b][m][n] = (f32x4){0.f, 0.f, 0.f, 0.f};
    bf16x8 At[4][2], B0[2][2], B1[2][2]; v8i At8[4], B08[2], B18[2];
    const char* cA = (const char*)g.A + (GATH ? (size_t)0 : (size_t)cur.pm * tstep); const char* cB = (const char*)g.Bt + (size_t)cur.pn * tstep;
    S.a_ready(cur);
    unsigned cv00 = 0, cv01 = 0, cv10 = 0, cv11 = 0, nv00 = 0, nv01 = 0, nv10 = 0, nv11 = 0;
    if constexpr (GATH) {
        if (wid == 0) __builtin_amdgcn_global_load_lds((const unsigned*)(ga.src(cur.pm) + lane * 4), (PG8_LAS unsigned*)ga.idx, 16, 0, 0);
        asm volatile("s_waitcnt vmcnt(0)" ::: "memory"); PG8_BAR_();
        PG8_GOFF(ga.idx, cv00, cv01, cv10, cv11);
    }
    if constexpr (SP2) {
        PG8_STAGE(PG8_SB(0, 0), cB, voffB); PG8_STAGE(PG8_SB(0, 1), cB + hstep, voffB); PG8_STA(PG8_SA(0, 0), cA, cA, cv00, cv01); PG8_STA(PG8_SA(0, 1), cA + hstep, cA, cv10, cv11);
        if (wr == 1) PG8_BAR;
        PG8_WAIT_V(2); PG8_BAR;
        PG8_STAGE(PG8_SB(1, 0), cB + kstep, voffB); PG8_STA(PG8_SA(1, 0), cA + kstep, cA + kstep, cv00, cv01); PG8_STAGE(PG8_SB(1, 1), cB + hstep + kstep, voffB);
        PG8_WAIT_V(6); PG8_BAR;
    } else {
        PG8_STAGE(PG8_SB(0, 0), cB, voffB); PG8_STAGE(PG8_SA(0, 0), cA, voffA); PG8_STAGE(PG8_SB(0, 1), cB + hstep, voffB); PG8_STAGE(PG8_SA(0, 1), cA + hstep, voffA);
        if (wr == 1) PG8_BAR;
        PG8_WAIT_V(4); PG8_BAR;
        PG8_STAGE(PG8_SB(1, 0), cB + kstep, voffB); PG8_STAGE(PG8_SA(1, 0), cA + kstep, voffA); PG8_STAGE(PG8_SB(1, 1), cB + hstep + kstep, voffB);
        PG8_WAIT_V(6); PG8_BAR;
    }
    for (;;) {
        const bool has_next = S.next(ui + 1, nxt);
        if constexpr (Epi::LDS_BIAS) { if (wid == 1) __builtin_amdgcn_global_load_lds((const unsigned*)E.bias_src(cur, lane), (PG8_LAS unsigned*)(E.bl + (ui & 1) * 256), 16, 0, 0); }
        const char* nA = (has_next && !GATH) ? (const char*)g.A + (size_t)nxt.pm * tstep : cA; const char* nB = has_next ? (const char*)g.Bt + (size_t)nxt.pn * tstep : cB;
        if constexpr (GATH) { if (has_next && wid == 0) __builtin_amdgcn_global_load_lds((const unsigned*)(ga.src(nxt.pm) + lane * 4), (PG8_LAS unsigned*)(ga.idx + ((ui + 1) & 1) * BM), 16, 0, 0); }
#pragma nounroll
        for (int t = 0; t < nt; t += 2) {
            const bool last = (t == nt - 2);
            const char* a1 = cA + (size_t)(t + 1) * kstep;
            const char* a2 = last ? nA : cA + (size_t)(t + 2) * kstep; const char* b2 = last ? nB : cB + (size_t)(t + 2) * kstep;
            const char* a3 = a2 + kstep; const char* b3 = b2 + kstep;
            if (last && has_next) S.a_ready(nxt);
            unsigned x00 = cv00, x01 = cv01, x10 = cv10, x11 = cv11;
            if constexpr (GATH) { if (last) { if (has_next) { PG8_GOFF(ga.idx + ((ui + 1) & 1) * BM, nv00, nv01, nv10, nv11); } else { nv00 = cv00; nv01 = cv01; nv10 = cv10; nv11 = cv11; }
                x00 = nv00; x01 = nv01; x10 = nv10; x11 = nv11; } }
            if constexpr (SP2) {
            PG8_LDB(B0, 0, 0); PG8_LDB(B1, 0, 1); PG8_SCHED; PG8_LDA(At, 0, 0); PG8_STA(PG8_SA(1, 1), a1 + hstep, a1, cv10, cv11);
            PG8_WAIT_V(8); PG8_WAIT_L(0); PG8_BAR; PG8_MMA(0, 0, At, B0); PG8_MMA(0, 1, At, B1); PG8_BAR; PG8_SCHED;
            PG8_LDA(At, 0, 1); PG8_STAGE(PG8_SB(0, 0), b2, voffB); PG8_STAGE(PG8_SB(0, 1), b2 + hstep, voffB); PG8_STA(PG8_SA(0, 0), a2, a2, x00, x01);
            PG8_WAIT_V(8); PG8_WAIT_L(0); PG8_BAR; PG8_MMA(1, 0, At, B0); PG8_MMA(1, 1, At, B1); PG8_BAR; PG8_SCHED;
            PG8_LDB(B0, 1, 0); PG8_LDB(B1, 1, 1); PG8_SCHED; PG8_LDA(At, 1, 0); PG8_STA(PG8_SA(0, 1), a2 + hstep, a2, x10, x11);
            PG8_WAIT_V(8); PG8_WAIT_L(0); PG8_BAR; PG8_MMA(0, 0, At, B0); PG8_MMA(0, 1, At, B1); PG8_BAR; PG8_SCHED;
            PG8_LDA(At, 1, 1); PG8_STAGE(PG8_SB(1, 0), b3, voffB); PG8_STAGE(PG8_SB(1, 1), b3 + hstep, voffB); PG8_STA(PG8_SA(1, 0), a3, a3, x00, x01);
            PG8_WAIT_V(8); PG8_WAIT_L(0); PG8_BAR; PG8_MMA(1, 0, At, B0); PG8_MMA(1, 1, At, B1); PG8_BAR; PG8_SCHED;
            } else {
            PG8_LDB(B0, 0, 0); PG8_SCHED; PG8_LDA(At, 0, 0); PG8_STAGE(PG8_SA(1, 1), a1 + hstep, voffA);
            PG8_WAIT_L(8); PG8_BAR; PG8_WAIT_L(0); PG8_MMA(0, 0, At, B0); PG8_BAR; PG8_SCHED;
            PG8_LDB(B1, 0, 1); PG8_STAGE(PG8_SB(0, 0), b2, voffB);
            PG8_BAR; PG8_WAIT_L(0); PG8_MMA(0, 1, At, B1); PG8_BAR;
            PG8_LDA(At, 0, 1); PG8_STAGE(PG8_SA(0, 0), a2, voffA);
            PG8_BAR; PG8_WAIT_L(0); PG8_MMA(1, 0, At, B0); PG8_BAR; PG8_SCHED;
            PG8_STAGE(PG8_SB(0, 1), b2 + hstep, voffB);
            PG8_WAIT_V(6); PG8_BAR; PG8_MMA(1, 1, At, B1); PG8_BAR;
            PG8_LDB(B0, 1, 0); PG8_SCHED; PG8_LDA(At, 1, 0); PG8_STAGE(PG8_SA(0, 1), a2 + hstep, voffA);
            PG8_WAIT_L(8); PG8_BAR; PG8_WAIT_L(0); PG8_MMA(0, 0, At, B0); PG8_BAR; PG8_SCHED;
            PG8_LDB(B1, 1, 1); PG8_STAGE(PG8_SB(1, 0), b3, voffB);
            PG8_BAR; PG8_WAIT_L(0); PG8_MMA(0, 1, At, B1); PG8_BAR;
            PG8_LDA(At, 1, 1); PG8_STAGE(PG8_SA(1, 0), a3, voffA);
            PG8_BAR; PG8_WAIT_L(0); PG8_MMA(1, 0, At, B0); PG8_BAR; PG8_SCHED;
            PG8_STAGE(PG8_SB(1, 1), b3 + hstep, voffB);
            PG8_WAIT_V(6); PG8_BAR; PG8_MMA(1, 1, At, B1); PG8_BAR;
            }
        }
        if constexpr (ALIGN_EPI) { if (wr == 0) PG8_BAR; }
        if constexpr (FP8) asm volatile("s_nop 15\n\ts_nop 15" ::: "memory");
        if constexpr (!Epi::AFTER_DRAIN) { if constexpr (Epi::LDS_BIAS) E(acc, cur, wr, wc, fr, fq, ui & 1); else E(acc, cur, wr, wc, fr, fq); S.done(cur); }
        if (!has_next) break;
#pragma unroll
        for (int a = 0; a < 2; ++a)
#pragma unroll
            for (int b = 0; b < 2; ++b)
#pragma unroll
                for (int m = 0; m < 4; ++m)
#pragma unroll
                    for (int n = 0; n < 2; ++n) acc[a][b][m][n] = (f32x4){0.f, 0.f, 0.f, 0.f};
        cur = nxt; cA = nA; cB = nB; ++ui; cv00 = nv00; cv01 = nv01; cv10 = nv10; cv11 = nv11;
        if constexpr (ALIGN_EPI) { if (wr == 1) PG8_BAR; }
    }
    PG8_WAIT_V(0);
    if constexpr (!ALIGN_EPI) { if (wr == 0) PG8_BAR; }
    PG8_BAR;
    if constexpr (Epi::AFTER_DRAIN) { E.fused(acc, cur, wr, wc, fr, fq, lds, wid, lane); S.done(cur); }
#undef PG8_SA
#undef PG8_SB
#undef PG8_STAGE
#undef PG8_STAGE2
#undef PG8_STA
#undef PG8_GOFF
#undef PG8_BAR_
#undef PG8_LDA
#undef PG8_LDB
#undef PG8_MMA
#undef PG8_LD8
#undef PG8_WAIT_V
#undef PG8_WAIT_L
#undef PG8_BAR
#undef PG8_SCHED
}
}
namespace att {
constexpr float O8_SCALE = 64.0f;
typedef short bf16x8 __attribute__((ext_vector_type(8)));
typedef short s16x4 __attribute__((ext_vector_type(4)));
typedef float f32x16 __attribute__((ext_vector_type(16)));
typedef float f32x4 __attribute__((ext_vector_type(4)));
typedef unsigned u32x4 __attribute__((ext_vector_type(4)));
typedef unsigned short bf16;
constexpr int NW = 8, QBLK = 32, KVBLK = 64, QB = NW * QBLK, DV = 128;
constexpr int SHM_V = KVBLK * DV * 2;
constexpr float THR = 8.f;
#define ATT_SBAR() __builtin_amdgcn_sched_barrier(0)
#define ATT_LD16(base, uoff, voff) (*reinterpret_cast<const bf16x8*>((const char*)(base) + (size_t)(uoff) + (voff)))
__device__ __forceinline__ int v_st(int k, int c) { const int kk = (k & ~0xC) | ((k & 4) << 1) | ((k & 8) >> 1); return ((kk >> 3) * 4 + (c >> 5)) * 512 + ((kk & 7) * 32 + (c & 31)) * 2; }
__device__ __forceinline__ int v_rd_base(int lane) { return ((lane & 3) << 3) | (((lane >> 2) & 3) << 6) | (((lane >> 4) & 1) << 5) | (((lane >> 5) & 1) << 8); }
constexpr int v_rd_off(int d0, int ks, int half) { return d0 * 512 + ks * 4096 + half * 2048; }
__device__ __forceinline__ int crow(int r, int hi) { return (r & 3) + 8 * (r >> 2) + 4 * hi; }
__device__ __forceinline__ unsigned cvtpk(float lo, float hi) { unsigned r; asm volatile("v_cvt_pk_bf16_f32 %0, %1, %2" : "=v"(r) : "v"(lo), "v"(hi)); return r; }
__device__ __forceinline__ bf16x8 pack8(f32x4 a, f32x4 b) { u32x4 w = {cvtpk(a[0], a[1]), cvtpk(a[2], a[3]), cvtpk(b[0], b[1]), cvtpk(b[2], b[3])}; return *reinterpret_cast<bf16x8*>(&w); }
__device__ __forceinline__ bf16x8 load8(const bf16* p) { return *reinterpret_cast<const bf16x8*>(p); }
__device__ __forceinline__ void mask_tile(f32x16& p0, f32x16& p1, int dq, unsigned W) {
    const float NEG = -__builtin_inff();
#pragma unroll
    for (int r = 0; r < 16; ++r) {
        const int c = (r & 3) + 8 * (r >> 2);
        if ((unsigned)(dq - c) >= W) p0[r] = NEG;
        if ((unsigned)(dq - c - 32) >= W) p1[r] = NEG;
    }
}
template <int SCALE_E6>
__device__ __forceinline__ void partialSM(f32x16& p0, f32x16& p1, float& m_reg, float& mn, float& alpha) {
    constexpr float SCALE = SCALE_E6 * 1e-6f;
    float pmax = p0[0]; for (int r = 1; r < 16; ++r) pmax = fmaxf(pmax, p0[r]); for (int r = 0; r < 16; ++r) pmax = fmaxf(pmax, p1[r]);
    { auto rr = __builtin_amdgcn_permlane32_swap(__float_as_uint(pmax), __float_as_uint(pmax), false, false);
      pmax = fmaxf(__uint_as_float(rr[0]), __uint_as_float(rr[1])); }
    constexpr float C2 = 1.4426950408889634f * SCALE;
    if (__builtin_expect(__all((pmax - m_reg) * SCALE <= THR), 1)) { mn = m_reg; alpha = 1.f; }
    else { mn = fmaxf(m_reg, pmax); alpha = __builtin_amdgcn_exp2f((m_reg - mn) * C2); m_reg = mn; }
    const float mnL = -mn * C2;
    for (int r = 0; r < 16; ++r) p0[r] = fmaf(p0[r], C2, mnL); for (int r = 0; r < 16; ++r) p1[r] = fmaf(p1[r], C2, mnL);
    for (int r = 0; r < 16; ++r) p0[r] = __builtin_amdgcn_exp2f(p0[r]);
}
__device__ __forceinline__ void finishSM(f32x16& p0, f32x16& p1, float alpha, float& l_reg, bf16x8& pa0, bf16x8& pa1, bf16x8& pa2, bf16x8& pa3) {
    for (int r = 0; r < 16; ++r) p1[r] = __builtin_amdgcn_exp2f(p1[r]);
    float ps = 0; for (int r = 0; r < 16; ++r) ps += p0[r]; for (int r = 0; r < 16; ++r) ps += p1[r];
    { auto rr = __builtin_amdgcn_permlane32_swap(__float_as_uint(ps), __float_as_uint(ps), false, false);
      ps = __uint_as_float(rr[0]) + __uint_as_float(rr[1]); }
    l_reg = l_reg * alpha + ps;
#define ATT_PK4(P, B_, OUT) do { unsigned a0 = cvtpk(P[B_+0], P[B_+1]), a1 = cvtpk(P[B_+2], P[B_+3]);                          \
        unsigned b0 = cvtpk(P[B_+4], P[B_+5]), b1 = cvtpk(P[B_+6], P[B_+7]);                                             \
        auto r0 = __builtin_amdgcn_permlane32_swap(a0, b0, false, false); auto r1 = __builtin_amdgcn_permlane32_swap(a1, b1, false, false); \
        u32x4 w = {r0[0], r1[0], r0[1], r1[1]}; OUT = *reinterpret_cast<bf16x8*>(&w); } while (0)
    ATT_PK4(p0, 0, pa0); ATT_PK4(p0, 8, pa1); ATT_PK4(p1, 0, pa2); ATT_PK4(p1, 8, pa3);
#undef ATT_PK4
}
template <int DK> __device__ __forceinline__ int kswz(int row, int colB) { return row * (DK * 2 + 16) + colB; }
template <int DK, int KB, int NREG>
__device__ __forceinline__ void qkt(f32x16& p0, f32x16& p1, const char* K_lds, int r32, int hi, const bf16x8* qr, const char* qx) {
    constexpr int KSTR = DK * 2 + 16, SHM_K = KVBLK * KSTR, NCH = DK / 16;
    p0 = f32x16{}; p1 = f32x16{};
    const char* kb = K_lds + KB * SHM_K + kswz<DK>(r32, hi * 16);
#pragma unroll
    for (int d0 = 0; d0 < NCH; ++d0) { const char* a = kb + d0 * 32;
        bf16x8 b0 = *reinterpret_cast<const bf16x8*>(a);
        bf16x8 b1 = *reinterpret_cast<const bf16x8*>(a + 32 * KSTR);
        const bf16x8 qv = d0 < NREG ? qr[d0] : *reinterpret_cast<const bf16x8*>(qx + (d0 - NREG) * 1024);
        p0 = __builtin_amdgcn_mfma_f32_32x32x16_bf16(b0, qv, p0, 0, 0, 0);
        p1 = __builtin_amdgcn_mfma_f32_32x32x16_bf16(b1, qv, p1, 0, 0, 0); }
}
template <int VB>
__device__ __forceinline__ void pv_tile(f32x16* o, int vb0, bf16x8 pa0, bf16x8 pa1, bf16x8 pa2, bf16x8 pa3) {
#define ATT_TRRD(dst, off) asm volatile("ds_read_b64_tr_b16 %0, %1 offset:%2" : "=&v"(dst) : "v"(vb0), "i"(off) : "memory")
#define ATT_PV_D0(d0) do { s16x4 l0, l1, l2, l3, h0, h1, h2, h3; constexpr int b_ = VB * SHM_V + v_rd_off(d0, 0, 0); \
        ATT_TRRD(l0, b_); ATT_TRRD(h0, b_ + 2048); ATT_TRRD(l1, b_ + 4096); ATT_TRRD(h1, b_ + 6144); ATT_TRRD(l2, b_ + 8192); ATT_TRRD(h2, b_ + 10240); ATT_TRRD(l3, b_ + 12288); ATT_TRRD(h3, b_ + 14336); \
        asm volatile("s_waitcnt lgkmcnt(0)" ::: "memory"); ATT_SBAR();   \
        o[d0] = __builtin_amdgcn_mfma_f32_32x32x16_bf16(pa0, (bf16x8){l0[0], l0[1], l0[2], l0[3], h0[0], h0[1], h0[2], h0[3]}, o[d0], 0, 0, 0);   \
        o[d0] = __builtin_amdgcn_mfma_f32_32x32x16_bf16(pa1, (bf16x8){l1[0], l1[1], l1[2], l1[3], h1[0], h1[1], h1[2], h1[3]}, o[d0], 0, 0, 0);   \
        o[d0] = __builtin_amdgcn_mfma_f32_32x32x16_bf16(pa2, (bf16x8){l2[0], l2[1], l2[2], l2[3], h2[0], h2[1], h2[2], h2[3]}, o[d0], 0, 0, 0);   \
        o[d0] = __builtin_amdgcn_mfma_f32_32x32x16_bf16(pa3, (bf16x8){l3[0], l3[1], l3[2], l3[3], h3[0], h3[1], h3[2], h3[3]}, o[d0], 0, 0, 0); } while (0)
    ATT_PV_D0(0); ATT_PV_D0(1); ATT_PV_D0(2); ATT_PV_D0(3);
#undef ATT_PV_D0
#undef ATT_TRRD
}
template <int DK_, int QS_, int KS_, int VS_, int OS_, int ROFF_, int RH_, int SCALE_E6_> struct Cfg {
    static constexpr int DK = DK_, QS = QS_, KS = KS_, VS = VS_, OS = OS_, ROFF = ROFF_, RH = RH_, SCALE_E6 = SCALE_E6_;
    static constexpr int NCH = DK / 16, KSTR = DK * 2 + 16, SHM_K = KVBLK * KSTR, NREG = DK > 128 ? 7 : NCH  , QX_OFF = 2 * SHM_V + 2 * SHM_K + NW * 64 * 4, QX_WAVE = (NCH - NREG) * 1024, LDS_BYTES = QX_OFF + NW * QX_WAVE;
    static constexpr bool HAS_KR = DK > 128;
};
struct BlockRef { const bf16* Q; const bf16* K; const bf16* KR; const bf16* V; bf16* O; int P0; };
template <int NCH> struct Seam { bf16x8 qr[NCH]; bf16x8 st_v0, st_v1, st_k0, st_k1, st_k2; };

__device__ __forceinline__ float bf_lo(unsigned w) { return __uint_as_float(w << 16); }
__device__ __forceinline__ float bf_hi(unsigned w) { return __uint_as_float(w & 0xffff0000u); }
template <class C> __device__ __forceinline__ void rope_q(bf16x8* qr, const float* cs, const float* sn, int pos, int hi) {
#pragma unroll
    for (int i = 0; i < C::RH; ++i) {
        const unsigned toff = (unsigned)(pos * (C::RH * 16) + hi * 8) * 4u;
#define ATT_LDF4(base, uoff) (*reinterpret_cast<const f32x4*>((const char*)(base) + (size_t)(uoff) + toff))
        const f32x4 c0 = ATT_LDF4(cs, i * 64), c1 = ATT_LDF4(cs, i * 64 + 16), s0 = ATT_LDF4(sn, i * 64), s1 = ATT_LDF4(sn, i * 64 + 16);
#undef ATT_LDF4
        const u32x4 a = *reinterpret_cast<const u32x4*>(&qr[C::ROFF + i]), b = *reinterpret_cast<const u32x4*>(&qr[C::ROFF + C::RH + i]);
        u32x4 ya, yb;
#pragma unroll
        for (int w = 0; w < 4; ++w) {
            const float cl = w < 2 ? c0[2 * w] : c1[2 * w - 4], ch = w < 2 ? c0[2 * w + 1] : c1[2 * w - 3];
            const float sl = w < 2 ? s0[2 * w] : s1[2 * w - 4], sh = w < 2 ? s0[2 * w + 1] : s1[2 * w - 3];
            const float x1l = bf_lo(a[w]), x1h = bf_hi(a[w]), x2l = bf_lo(b[w]), x2h = bf_hi(b[w]);
            ya[w] = cvtpk(x1l * cl - x2l * sl, x1h * ch - x2h * sh);
            yb[w] = cvtpk(x2l * cl + x1l * sl, x2h * ch + x1h * sh);
        }
        qr[C::ROFF + i] = *reinterpret_cast<bf16x8*>(&ya); qr[C::ROFF + C::RH + i] = *reinterpret_cast<bf16x8*>(&yb);
    }
}
#define ATT_VMW() asm volatile("s_waitcnt vmcnt(0)" ::: "memory")
#define ATT_VMWN(n) asm volatile("s_waitcnt vmcnt(%0)" :: "i"(n) : "memory")
#define ATT_SLOAD(R, k0) do { S.st_v0 = ATT_LD16((R).V, (size_t)(k0) * (C::VS * 2), kvoff); S.st_v1 = ATT_LD16((R).V, (size_t)((k0) + 32) * (C::VS * 2), kvoff);              \
                         S.st_k0 = ATT_LD16((R).K, (size_t)(k0) * (C::KS * 2), kvoff); S.st_k1 = ATT_LD16((R).K, (size_t)((k0) + 32) * (C::KS * 2), kvoff);              \
                         if constexpr (C::HAS_KR) S.st_k2 = ATT_LD16((R).KR, (size_t)(k0) * 128, kroff); } while (0)
#define ATT_SWRITE_K(bf) do { *(bf16x8*)(K_lds + (bf) * C::SHM_K + kws) = S.st_k0; *(bf16x8*)(K_lds + (bf) * C::SHM_K + kws + 32 * C::KSTR) = S.st_k1; \
                         if constexpr (C::HAS_KR) *(bf16x8*)(K_lds + (bf) * C::SHM_K + kws2) = S.st_k2; } while (0)
#define ATT_SWRITE_V(bf) do { *(bf16x8*)(V_lds + (bf) * SHM_V + vst0) = S.st_v0; *(bf16x8*)(V_lds + (bf) * SHM_V + vst1) = S.st_v1; } while (0)
#define ATT_SWRITE(bf) do { ATT_SWRITE_V(bf); ATT_SWRITE_K(bf); } while (0)
template <class C>
__device__ __forceinline__ void prime(const BlockRef& cur, char* lds, Seam<C::NCH>& S) {
    const int tid = tid_opaque(), wid = __builtin_amdgcn_readfirstlane(tid >> 6), lane = tid & 63, r32 = lane & 31, hi = lane >> 5;
    const int sr = tid >> 4, sc = (tid & 15) * 8, kws = kswz<C::DK>(sr, sc * 2); char* K_lds = lds;
    const int kr = tid >> 3, kc = (tid & 7) * 8, kws2 = kswz<C::DK>(kr, (128 + kc) * 2);
    static_assert(C::KS == C::VS, "K and V share one per-lane offset");
    const unsigned kvoff = (unsigned)(sr * C::KS + sc) * 2u, kroff = (unsigned)(kr * 64 + kc) * 2u;
    const unsigned qoff = (unsigned)((wid * QBLK + r32) * C::QS + hi * 8) * 2u;
#pragma unroll
    for (int d0 = 0; d0 < C::NCH; ++d0) S.qr[d0] = ATT_LD16(cur.Q, d0 * 32, qoff);
    ATT_SLOAD(cur, 0); ATT_VMW(); ATT_SWRITE_K(0);
    __syncthreads();
}
template <class C>
__device__ __forceinline__ void block(const BlockRef& cur, const BlockRef& nxt, char* lds, Seam<C::NCH>& S, const float* rcos, const float* rsin) {
    const int tid = tid_opaque(), wid = __builtin_amdgcn_readfirstlane(tid >> 6), lane = tid & 63, r32 = lane & 31, hi = lane >> 5;
    const int NT = (cur.P0 + QB) / KVBLK;
    const unsigned W = 1u << 30;
    const int qlo = cur.P0 + wid * QBLK, qm = qlo + r32 - 4 * hi;
    char* V_lds = lds + 2 * C::SHM_K; char* K_lds = lds;
    float* ws = (float*)(lds + 2 * SHM_V + 2 * C::SHM_K) + wid * 64; float* li_l = ws, * al_l = ws + 32;
    float m_reg = -1e30f, l_reg = 0; f32x16 o[4] = {};
    const int sr = tid >> 4, sc = (tid & 15) * 8, vst0 = v_st(sr, sc), vst1 = v_st(32 + sr, sc), kws = kswz<C::DK>(sr, sc * 2);
    const int kr = tid >> 3, kc = (tid & 7) * 8, kws2 = kswz<C::DK>(kr, (128 + kc) * 2);
    const unsigned kvoff = (unsigned)(sr * C::KS + sc) * 2u, kroff = (unsigned)(kr * 64 + kc) * 2u;
    const int vb0 = (int)(uintptr_t)V_lds + v_rd_base(lane);
    rope_q<C>(S.qr, rcos, rsin, qlo + r32, hi);
    char* qx = lds + C::QX_OFF + wid * C::QX_WAVE + lane * 16;
    if constexpr (C::NREG < C::NCH) {
#pragma unroll
        for (int i = 0; i < C::NCH - C::NREG; ++i) *reinterpret_cast<bf16x8*>(qx + i * 1024) = S.qr[C::NREG + i];
    }
#define ATT_RESC(a) do { if (__any((a) < 1.f)) { if (hi == 0) al_l[r32] = (a); asm volatile("s_waitcnt lgkmcnt(0)" ::: "memory");              \
                     for (int d_ = 0; d_ < 4; ++d_) for (int r = 0; r < 16; ++r) o[d_][r] *= al_l[crow(r, hi)]; } } while (0)
#define ATT_KBASE(t) ((t) * KVBLK)
#define ATT_MASKT(P0_, P1_, t) do { const int kb_ = ATT_KBASE(t); if (kb_ + KVBLK - 1 > qlo) mask_tile(P0_, P1_, qm - kb_, W); } while (0)
#define ATT_SEAM_K0() do { ATT_VMWN(C::NCH == 8 ? 8 : C::NCH - 8); ATT_SWRITE_K(0); ATT_SBAR(); } while (0)
    f32x16 pA0, pA1, pB0, pB1; float mnA, mnB, alA, alB; bf16x8 pa0, pa1, pa2, pa3;
    ATT_SWRITE_V(0); ATT_SBAR();
    if (NT > 1) { ATT_SLOAD(cur, ATT_KBASE(1)); }
    ATT_SBAR(); qkt<C::DK, 0, C::NREG>(pA0, pA1, K_lds, r32, hi, S.qr, qx);
    ATT_MASKT(pA0, pA1, 0); partialSM<C::SCALE_E6>(pA0, pA1, m_reg, mnA, alA);
    if (NT > 1) { ATT_VMW(); ATT_SWRITE(1); }
    __syncthreads();
#define ATT_HALF_STEP(PX0, PX1, mnX, alX, PY0, PY1, alY, t, KB, VB, SB) do {                                                      \
        ATT_SBAR(); qkt<C::DK, KB, C::NREG>(PX0, PX1, K_lds, r32, hi, S.qr, qx);                                             \
        finishSM(PY0, PY1, alY, l_reg, pa0, pa1, pa2, pa3); ATT_SBAR();                                                           \
        if ((t) + 1 < NT) { ATT_SLOAD(cur, ATT_KBASE((t) + 1)); ATT_SBAR(); }                                               \
        pv_tile<VB>(o, vb0, pa0, pa1, pa2, pa3); ATT_MASKT(PX0, PX1, (t)); partialSM<C::SCALE_E6>(PX0, PX1, m_reg, mnX, alX);                                        \
        __syncthreads();                                                                                                      \
        if ((t) + 1 < NT) { ATT_VMW(); ATT_SWRITE(SB); }                                                                          \
        ATT_RESC(alX); __syncthreads(); } while (0)
    for (int t = 1; t + 1 < NT; t += 2) {
        ATT_HALF_STEP(pB0, pB1, mnB, alB, pA0, pA1, alA, t, 1, 0, 0);
        ATT_HALF_STEP(pA0, pA1, mnA, alA, pB0, pB1, alB, t + 1, 0, 1, 1);
    }
    ATT_SBAR(); qkt<C::DK, 1, C::NREG>(pB0, pB1, K_lds, r32, hi, S.qr, qx); ATT_SBAR();
    const unsigned qoff = (unsigned)((wid * QBLK + r32) * C::QS + hi * 8) * 2u;
    if constexpr (C::NCH == 8) { ATT_SLOAD(nxt, 0); ATT_SBAR(); }
#pragma unroll
    for (int d0 = 0; d0 < 8; ++d0) S.qr[d0] = ATT_LD16(nxt.Q, d0 * 32, qoff);
    ATT_SBAR();
    finishSM(pA0, pA1, alA, l_reg, pa0, pa1, pa2, pa3); ATT_SBAR();
    if constexpr (C::NCH > 8) {
        ATT_SLOAD(nxt, 0); ATT_SBAR();
#pragma unroll
        for (int d0 = 8; d0 < C::NCH; ++d0) S.qr[d0] = ATT_LD16(nxt.Q, d0 * 32, qoff);
        ATT_SBAR(); }
    pv_tile<0>(o, vb0, pa0, pa1, pa2, pa3);
    ATT_MASKT(pB0, pB1, NT - 1); partialSM<C::SCALE_E6>(pB0, pB1, m_reg, mnB, alB); __syncthreads(); ATT_RESC(alB);
    finishSM(pB0, pB1, alB, l_reg, pa0, pa1, pa2, pa3); ATT_SBAR(); pv_tile<1>(o, vb0, pa0, pa1, pa2, pa3);
    ATT_SBAR(); ATT_SEAM_K0();
    if (hi == 0) li_l[r32] = l_reg; asm volatile("s_waitcnt lgkmcnt(0)" ::: "memory");
    float rli[16];
#pragma unroll
    for (int r = 0; r < 16; ++r) rli[r] = __builtin_amdgcn_rcpf(li_l[crow(r, hi)]);
    const unsigned ooff = (unsigned)((wid * QBLK + 4 * hi) * C::OS + r32);
#pragma unroll
    for (int r = 0; r < 16; ++r) {
#pragma unroll
        for (int d0 = 0; d0 < 4; ++d0) { const float v = fminf(fmaxf(o[d0][r] * rli[r] * O8_SCALE, -448.f), 448.f);
            *reinterpret_cast<unsigned char*>((char*)cur.O + (size_t)(((r & 3) + 8 * (r >> 2)) * C::OS + d0 * 32) + ooff) = (unsigned char)(__builtin_amdgcn_cvt_pk_fp8_f32(v, v, 0, false) & 0xff); } }
    __syncthreads();
#undef ATT_RESC
#undef ATT_KBASE
#undef ATT_MASKT
#undef ATT_SEAM_K0
#undef ATT_HALF_STEP
}
struct Item { int bh, qb0, qb1; };
template <class C, class RefFn>
__device__ __forceinline__ void phase(char* lds, int vcu, int G, int total  , const RefFn& ref, const float* rcos, const float* rsin) {
    int L = vcu; if (L >= total) return;
    Item it{L >> 3, L & 7, 15 - (L & 7)}; int pass = 0;
    BlockRef cur = ref(it.bh, it.qb0);
    Seam<C::NCH> S;
    prime<C>(cur, lds, S);
    for (;;) {
        const bool more_pass = pass == 0, more_item = L + G < total, last = !more_pass && !more_item;
        Item itn = it; int passn = pass + 1, Ln = L;
        if (!more_pass) { passn = 0; Ln = more_item ? L + G : L; itn = Item{Ln >> 3, Ln & 7, 15 - (Ln & 7)}; }
        const BlockRef nxt = last ? cur : ref(itn.bh, passn ? itn.qb1 : itn.qb0);
        block<C>(cur, nxt, lds, S, rcos, rsin);
        if (last) break;
        cur = nxt; it = itn; pass = passn; L = Ln;
    }
}
}
namespace att2 {
using att::bf16x8; using att::s16x4; using att::f32x16; using att::f32x4; using att::u32x4; using att::bf16;
using att::v_st; using att::v_rd_base; using att::crow; using att::cvtpk; using att::mask_tile;
constexpr int KVBLK = 64, QB = 128, SHM_V = 64 * 128 * 2  , DK = 128, KSTR = DK * 2 + 16, SHM_K = KVBLK * KSTR;
constexpr int OFF_K = 0, OFF_V0 = 2 * SHM_K, OFF_V1 = OFF_V0 + 2 * SHM_V, OFF_WS = OFF_V1 + 2 * SHM_V, OFF_P = OFF_WS + 2048, LDS_BYTES = OFF_P + 4 * 4096;
constexpr int QS = 3072, KS = 3072, VS = 3072, OS = 2048, RH = 4, SCALE_E6 = 88388;
struct BlockRef { const bf16* Q; const bf16* K; const bf16* V; bf16* O; int P0; };
struct Seam { bf16x8 q0, q1, q2, q3, q4, q5, q6, q7; bf16x8 st0, st1, st2, st3; };
#define A2_SBAR() __builtin_amdgcn_sched_barrier(0)
#define A2_SG(mask, n) __builtin_amdgcn_sched_group_barrier(mask, n, 0)
#define A2_QK_G1() do { A2_SG(0x008, 2); A2_SG(0x100, 2); A2_SG(0x002, 24); } while (0)
#define A2_QK_G2() do { A2_SG(0x008, 2); A2_SG(0x002, 24); } while (0)
#define A2_QK_SCHED() do { A2_SG(0x100, 6); A2_QK_G1(); A2_QK_G1(); A2_QK_G1(); A2_QK_G1(); A2_QK_G1(); A2_QK_G2(); A2_QK_G2(); A2_QK_G2(); } while (0)
#define A2_LD16(base, uoff, voff) (*reinterpret_cast<const bf16x8*>((const char*)(base) + (size_t)(uoff) + (voff)))
#define A2_QLOAD(R) do { S.q0 = A2_LD16((R).Q, 0, qoff); S.q1 = A2_LD16((R).Q, 32, qoff); S.q2 = A2_LD16((R).Q, 64, qoff); S.q3 = A2_LD16((R).Q, 96, qoff); \
        S.q4 = A2_LD16((R).Q, 128, qoff); S.q5 = A2_LD16((R).Q, 160, qoff); S.q6 = A2_LD16((R).Q, 192, qoff); S.q7 = A2_LD16((R).Q, 224, qoff); } while (0)
#define A2_VMW() asm volatile("s_waitcnt vmcnt(0)" ::: "memory")
#define A2_VMWN(n) asm volatile("s_waitcnt vmcnt(%0)" :: "i"(n) : "memory")
#define A2_MIDBAR() asm volatile("s_waitcnt lgkmcnt(0)\n\ts_barrier" ::: "memory")
#define A2_SLOAD_K(R, k0) do { S.st0 = A2_LD16((R).K, (size_t)(k0) * (KS * 2), koff); S.st1 = A2_LD16((R).K, (size_t)((k0) + 16) * (KS * 2), koff); S.st2 = A2_LD16((R).K, (size_t)((k0) + 32) * (KS * 2), koff); S.st3 = A2_LD16((R).K, (size_t)((k0) + 48) * (KS * 2), koff); } while (0)
#define A2_SLOAD_V(R, k0) do { S.st0 = A2_LD16((R).V, (size_t)(k0) * (VS * 2), voff); S.q0 = A2_LD16((R).V, (size_t)(k0) * (VS * 2) + 256, voff); \
        S.st1 = A2_LD16((R).V, (size_t)((k0) + 16) * (VS * 2), voff); S.q1 = A2_LD16((R).V, (size_t)((k0) + 16) * (VS * 2) + 256, voff); \
        S.st2 = A2_LD16((R).V, (size_t)((k0) + 32) * (VS * 2), voff); S.q2 = A2_LD16((R).V, (size_t)((k0) + 32) * (VS * 2) + 256, voff); \
        S.st3 = A2_LD16((R).V, (size_t)((k0) + 48) * (VS * 2), voff); S.q3 = A2_LD16((R).V, (size_t)((k0) + 48) * (VS * 2) + 256, voff); } while (0)
#define A2_SLOAD_KQ(R, k0) do { S.q4 = A2_LD16((R).K, (size_t)(k0) * (KS * 2), koff); S.q5 = A2_LD16((R).K, (size_t)((k0) + 16) * (KS * 2), koff); S.q6 = A2_LD16((R).K, (size_t)((k0) + 32) * (KS * 2), koff); S.q7 = A2_LD16((R).K, (size_t)((k0) + 48) * (KS * 2), koff); } while (0)
#define A2_SWRITE_KQ(bf) do { char* kp_ = lds + OFF_K + (bf) * SHM_K + kws; *(bf16x8*)(kp_) = S.q4; *(bf16x8*)(kp_ + 16 * KSTR) = S.q5; *(bf16x8*)(kp_ + 32 * KSTR) = S.q6; *(bf16x8*)(kp_ + 48 * KSTR) = S.q7; } while (0)
#define A2_SWRITE_K(bf) do { char* kp_ = lds + OFF_K + (bf) * SHM_K + kws; *(bf16x8*)(kp_) = S.st0; *(bf16x8*)(kp_ + 16 * KSTR) = S.st1; *(bf16x8*)(kp_ + 32 * KSTR) = S.st2; *(bf16x8*)(kp_ + 48 * KSTR) = S.st3; } while (0)
#define A2_SWRITE_V(bf) do { char* v0_ = lds + OFF_V0 + (bf) * SHM_V; char* v1_ = lds + OFF_V1 + (bf) * SHM_V; \
        *(bf16x8*)(v0_ + vst0) = S.st0; *(bf16x8*)(v1_ + vst0) = S.q0; *(bf16x8*)(v0_ + vst1) = S.st1; *(bf16x8*)(v1_ + vst1) = S.q1; \
        *(bf16x8*)(v0_ + vst2) = S.st2; *(bf16x8*)(v1_ + vst2) = S.q2; *(bf16x8*)(v0_ + vst3) = S.st3; *(bf16x8*)(v1_ + vst3) = S.q3; } while (0)
template <int KB> __device__ __forceinline__ void qkt(f32x16& p0, f32x16& p1, const char* lds, int r32, int hi, const Seam& S) {
    const bf16x8 qr[8] = {S.q0, S.q1, S.q2, S.q3, S.q4, S.q5, S.q6, S.q7};
    p0 = f32x16{}; p1 = f32x16{};
    const char* kb = lds + OFF_K + KB * SHM_K + r32 * KSTR + hi * 16;
    bf16x8 ka[3], kc[3];
#pragma unroll
    for (int d0 = 0; d0 < 3; ++d0) { ka[d0] = *reinterpret_cast<const bf16x8*>(kb + d0 * 32); kc[d0] = *reinterpret_cast<const bf16x8*>(kb + d0 * 32 + 32 * KSTR); }
#pragma unroll
    for (int d0 = 0; d0 < 8; ++d0) {
        p0 = __builtin_amdgcn_mfma_f32_32x32x16_bf16(ka[d0 % 3], qr[d0], p0, 0, 0, 0);
        p1 = __builtin_amdgcn_mfma_f32_32x32x16_bf16(kc[d0 % 3], qr[d0], p1, 0, 0, 0);
        if (d0 + 3 < 8) { ka[d0 % 3] = *reinterpret_cast<const bf16x8*>(kb + (d0 + 3) * 32); kc[d0 % 3] = *reinterpret_cast<const bf16x8*>(kb + (d0 + 3) * 32 + 32 * KSTR); } }
}
typedef att::Cfg<128, QS, KS, VS, OS, 0, RH, SCALE_E6> RopeCfg;
constexpr int OFF_CV = LDS_BYTES, CV_WAVE = 64 * 33 * 4, LDS_BYTES_CV = OFF_CV + 4 * CV_WAVE;
constexpr int CV_ITEMS = 32768 + 16384;
struct Conv { const float* wgu; const float* wdn; unsigned char* dgu; unsigned char* ddn; int it, stride, tick, pend;
    float c0, c1, c2, c3, c4, c5, c6, c7, c8, c9, c10, c11, c12, c13, c14, c15, c16, c17, c18, c19, c20, c21, c22, c23, c24, c25, c26, c27, c28, c29, c30, c31; };
struct CvItem { const float* W; unsigned char* WT; int N, k0, n0, dst; float scale; };
__device__ __forceinline__ CvItem cv_decode(const Conv& C) {
    CvItem I; const int it = C.it;
    if (it < 32768) { const int e = it >> 10, r = it & 1023, kb = r >> 6, nb = r & 63, n0 = 32 * nb, up = n0 >= 1024, nn = n0 & 1023;
        I.W = C.wgu + (size_t)e * 1024 * 2048; I.WT = C.dgu + (size_t)e * 2048 * 1024; I.N = 2048; I.k0 = 64 * kb; I.n0 = n0; I.dst = 256 * (nn >> 7) + 128 * up + (nn & 127); I.scale = 256.0f; }
    else { const int j = it - 32768, e = j >> 9, r = j & 511, kb = r >> 5, nb = r & 31;
        I.W = C.wdn + (size_t)e * 1024 * 1024; I.WT = C.ddn + (size_t)e * 1024 * 1024; I.N = 1024; I.k0 = 64 * kb; I.n0 = 32 * nb; I.dst = 32 * nb; I.scale = 512.0f; }
    return I;
}
#define A2_CV_ALL(M) M(0) M(1) M(2) M(3) M(4) M(5) M(6) M(7) M(8) M(9) M(10) M(11) M(12) M(13) M(14) M(15) M(16) M(17) M(18) M(19) M(20) M(21) M(22) M(23) M(24) M(25) M(26) M(27) M(28) M(29) M(30) M(31)
__device__ __forceinline__ void cv_stage_a(Conv& C, int lane) {
    const CvItem I = cv_decode(C);
    const float* p = I.W + (size_t)(I.k0 + (lane >> 5)) * I.N + I.n0 + (lane & 31);
#define A2_CV_LD(i) C.c##i = p[(size_t)(2 * i) * I.N];
    A2_CV_ALL(A2_CV_LD)
#undef A2_CV_LD
}
__device__ __forceinline__ void cv_stage_b(Conv& C, char* lds, int vw, int lane) {
    const CvItem I = cv_decode(C);
    float* scr = (float*)(lds + OFF_CV + vw * CV_WAVE);
    float* w = scr + (lane >> 5) * 33 + (lane & 31);
#define A2_CV_ST(i) w[(2 * i) * 33] = C.c##i;
    A2_CV_ALL(A2_CV_ST)
#undef A2_CV_ST
    asm volatile("s_waitcnt lgkmcnt(0)" ::: "memory");
    const int c = lane & 3;
#pragma unroll
    for (int j = 0; j < 2; ++j) { const int n = (lane >> 2) + 16 * j; const float* sp = scr + (16 * c) * 33 + n; const float sc = I.scale;
        u32x4 o;
#pragma unroll
        for (int q = 0; q < 4; ++q) o[q] = pg8::pk4_fp8(sp[(4 * q) * 33] * sc, sp[(4 * q + 1) * 33] * sc, sp[(4 * q + 2) * 33] * sc, sp[(4 * q + 3) * 33] * sc);
        *reinterpret_cast<u32x4*>(I.WT + (size_t)(I.dst + n) * 1024 + I.k0 + 16 * c) = o; }
    asm volatile("s_waitcnt lgkmcnt(0)" ::: "memory");
}
__device__ __forceinline__ void cv_tick(Conv& C, char* lds, int vw, int lane) {
    const int ph = C.tick & 3; ++C.tick;
    if (ph == 0) { if (!C.pend && C.it < CV_ITEMS) { cv_stage_a(C, lane); C.pend = 1; } }
    else if (ph == 2) { if (C.pend) { cv_stage_b(C, lds, vw, lane); C.pend = 0; C.it += C.stride; } }
}
__device__ __forceinline__ void cv_finish(Conv& C, char* lds, int vw, int lane) {
    if (C.pend) { cv_stage_b(C, lds, vw, lane); C.pend = 0; C.it += C.stride; }
    while (C.it < CV_ITEMS) { cv_stage_a(C, lane); cv_stage_b(C, lds, vw, lane); C.it += C.stride; }
}
template <bool SW> __device__ __forceinline__ void prime(const BlockRef& cur, char* lds, Seam& S) {
    const int tid = tid_opaque(), wid = __builtin_amdgcn_readfirstlane(tid >> 6), lane = tid & 63, r32 = lane & 31, hi = lane >> 5;
    const int sw = wid & 3, t8 = tid & 255;
    const unsigned koff = (unsigned)((t8 >> 4) * KS + (t8 & 15) * 8) * 2u, voff = (unsigned)((t8 >> 4) * VS + (t8 & 15) * 8) * 2u;
    const int kws = (t8 >> 4) * KSTR + (t8 & 15) * 16;
    if constexpr (SW) {
        const unsigned qoff = (unsigned)((sw * 32 + r32) * QS + hi * 8) * 2u;
        A2_QLOAD(cur);
    } else { A2_SLOAD_KQ(cur, 0); A2_SLOAD_V(cur, 0); A2_VMWN(8); A2_SWRITE_KQ(0); }
    __syncthreads();
}
template <bool SW> __device__ __forceinline__ void block(const BlockRef& cur, const BlockRef& nxt, char* lds, Seam& S, const float* rcos, const float* rsin, Conv& C) {
    const int tid = tid_opaque(), wid = __builtin_amdgcn_readfirstlane(tid >> 6), lane = tid & 63, r32 = lane & 31, hi = lane >> 5;
    const int sw = wid & 3, t8 = tid & 255;
    const int NT = (cur.P0 + QB) / KVBLK;
    const unsigned W = 1u << 30;
    const int qlo = cur.P0 + sw * 32, qm = qlo + r32 - 4 * hi;
    float* ws = (float*)(lds + OFF_WS) + sw * 128; float* li_l = ws, * al_l = ws + 32; float* fl_l = ws + 64;
    char* pb = lds + OFF_P + sw * 4096 + lane * 16;
    float m_reg = -1e30f, l_reg = 0; f32x16 o[4] = {};
    const unsigned koff = (unsigned)((t8 >> 4) * KS + (t8 & 15) * 8) * 2u, voff = (unsigned)((t8 >> 4) * VS + (t8 & 15) * 8) * 2u;
    const int kws = (t8 >> 4) * KSTR + (t8 & 15) * 16;
    const int vst0 = v_st((t8 >> 4), (t8 & 15) * 8), vst1 = v_st((t8 >> 4) + 16, (t8 & 15) * 8), vst2 = v_st((t8 >> 4) + 32, (t8 & 15) * 8), vst3 = v_st((t8 >> 4) + 48, (t8 & 15) * 8);
    const int vb0 = (int)(uintptr_t)(lds + (SW ? OFF_V0 : OFF_V1)) + v_rd_base(lane);
#define A2_KBASE(t) ((t) * KVBLK)
#define A2_MASKT(P0_, P1_, t) do { const int kb_ = A2_KBASE(t); if (kb_ + KVBLK - 1 > qlo) mask_tile(P0_, P1_, qm - kb_, W); } while (0)
#define A2_PUTP() do { *(bf16x8*)(pb) = pa0; *(bf16x8*)(pb + 1024) = pa1; *(bf16x8*)(pb + 2048) = pa2; *(bf16x8*)(pb + 3072) = pa3; } while (0)
#define A2_GETP() do { pa0 = *(const bf16x8*)(pb); pa1 = *(const bf16x8*)(pb + 1024); pa2 = *(const bf16x8*)(pb + 2048); pa3 = *(const bf16x8*)(pb + 3072); } while (0)
#define A2_PUTAL(a) do { const bool any_ = __any((a) < 1.f); if (hi == 0) al_l[r32] = (a); if (lane == 0) fl_l[0] = any_ ? 1.f : 0.f; } while (0)
#define A2_RESC() do { if (fl_l[0] != 0.f) { for (int d_ = 0; d_ < 4; ++d_) for (int r = 0; r < 16; ++r) o[d_][r] *= al_l[crow(r, hi)]; } } while (0)
    f32x16 pA0, pA1, pB0, pB1; float mnA, mnB, alA = 1.f, alB = 1.f; bf16x8 pa0, pa1, pa2, pa3;
    if constexpr (!SW) { A2_SWRITE_V(0); }
    A2_SBAR();
    if (NT > 1) { if constexpr (!SW) { A2_SLOAD_KQ(cur, A2_KBASE(1)); A2_SLOAD_V(cur, A2_KBASE(1)); } }
    A2_SBAR();
    if constexpr (SW) { qkt<0>(pA0, pA1, lds, r32, hi, S); A2_MASKT(pA0, pA1, 0); att::partialSM<SCALE_E6>(pA0, pA1, m_reg, mnA, alA); }
    if (NT > 1) { if constexpr (!SW) { A2_VMW(); A2_SWRITE_KQ(1); A2_SWRITE_V(1); } }
    __syncthreads();
#define A2_STEP(PX0, PX1, mnX, alX, PY0, PY1, alY, t, KB, VB, SB) do {                                                      \
        A2_SBAR();                                                                                                            \
        if constexpr (SW) { qkt<KB>(PX0, PX1, lds, r32, hi, S); att::finishSM(PY0, PY1, alY, l_reg, pa0, pa1, pa2, pa3); A2_QK_SCHED(); A2_PUTP(); A2_SBAR();   \
                  }                                                                                                           \
        else { if ((t) + 1 < NT) { A2_SLOAD_KQ(cur, A2_KBASE((t) + 1)); A2_SLOAD_V(cur, A2_KBASE((t) + 1)); } A2_SBAR(); cv_tick(C, lds, sw, lane); }                \
        A2_SBAR(); A2_MIDBAR();                                                                                               \
        if constexpr (!SW) { A2_GETP(); }                                                                                               \
        att::pv_tile<VB>(o, vb0, pa0, pa1, pa2, pa3);                                                                         \
        if constexpr (SW) { A2_MASKT(PX0, PX1, (t)); att::partialSM<SCALE_E6>(PX0, PX1, m_reg, mnX, alX); A2_PUTAL(alX); }              \
        __syncthreads();                                                                                                      \
        if ((t) + 1 < NT) { if constexpr (!SW) { A2_SWRITE_KQ(SB); A2_SWRITE_V(SB); } }                                            \
        A2_RESC(); __syncthreads(); } while (0)
    for (int t = 1; t + 1 < NT; t += 2) {
        A2_STEP(pB0, pB1, mnB, alB, pA0, pA1, alA, t, 1, 0, 0);
        A2_STEP(pA0, pA1, mnA, alA, pB0, pB1, alB, t + 1, 0, 1, 1);
    }
    A2_SBAR();
    if constexpr (SW) { qkt<1>(pB0, pB1, lds, r32, hi, S); A2_SBAR();
        const unsigned qoff = (unsigned)((sw * 32 + r32) * QS + hi * 8) * 2u;
        A2_QLOAD(nxt);
        A2_SBAR();
        att::finishSM(pA0, pA1, alA, l_reg, pa0, pa1, pa2, pa3); A2_PUTP(); }
    else { A2_SLOAD_KQ(nxt, 0); A2_SLOAD_V(nxt, 0); }
    A2_SBAR(); A2_MIDBAR();
    if constexpr (!SW) { A2_GETP(); }
    att::pv_tile<0>(o, vb0, pa0, pa1, pa2, pa3);
    if constexpr (SW) { A2_MASKT(pB0, pB1, NT - 1); att::partialSM<SCALE_E6>(pB0, pB1, m_reg, mnB, alB); A2_PUTAL(alB); }
    A2_SBAR(); A2_MIDBAR();
    A2_RESC();
    if constexpr (SW) { att::finishSM(pB0, pB1, alB, l_reg, pa0, pa1, pa2, pa3); A2_PUTP(); if (hi == 0) li_l[r32] = l_reg; }
    A2_SBAR(); A2_MIDBAR();
    if constexpr (!SW) { A2_GETP(); }
    att::pv_tile<1>(o, vb0, pa0, pa1, pa2, pa3);
    A2_SBAR();
    if constexpr (!SW) { A2_VMWN(8); A2_SWRITE_KQ(0); A2_SBAR(); }
    float rli[16];
#pragma unroll
    for (int r = 0; r < 16; ++r) rli[r] = __builtin_amdgcn_rcpf(li_l[crow(r, hi)]);
    const unsigned ooff = (unsigned)((sw * 32 + 4 * hi) * OS + (SW ? 0 : 128) + r32) * 2u;
#pragma unroll
    for (int r = 0; r < 16; ++r) {
#pragma unroll
        for (int d0 = 0; d0 < 4; ++d0) { const float v = o[d0][r] * rli[r];
            const float vn = __shfl_xor(v, 1);
            if ((r32 & 1) == 0) *reinterpret_cast<unsigned*>((char*)cur.O + (size_t)((((r & 3) + 8 * (r >> 2)) * OS + d0 * 32) * 2) + ooff) = cvtpk(v, vn); } }
    __syncthreads();
#undef A2_KBASE
#undef A2_MASKT
#undef A2_PUTP
#undef A2_GETP
#undef A2_PUTAL
#undef A2_RESC
#undef A2_STEP
}
template <bool SW, class RefFn>
__device__ __forceinline__ void run(char* lds, int vcu, int G, int total, const RefFn& ref, const float* rcos, const float* rsin, const Conv& C0) {
    int L = vcu;
    int cb = L >> 4, q0 = L & 15, q1 = 31 - (L & 15), pass = 0;
    BlockRef cur = ref(cb, q0);
    Seam S; Conv C = C0;
    prime<SW>(cur, lds, S);
    for (;;) {
        const bool more_pass = pass == 0, more_item = L + G < total, last = !more_pass && !more_item;
        int cbn = cb, q0n = q0, q1n = q1, passn = pass + 1, Ln = L;
        if (!more_pass) { passn = 0; Ln = more_item ? L + G : L; cbn = Ln >> 4; q0n = Ln & 15; q1n = 31 - (Ln & 15); }
        const BlockRef nxt = last ? cur : ref(cbn, passn ? q1n : q0n);
        block<SW>(cur, nxt, lds, S, rcos, rsin, C);
        if (last) break;
        cur = nxt; cb = cbn; q0 = q0n; q1 = q1n; pass = passn; L = Ln;
    }
    if constexpr (!SW) { const int lane = (int)threadIdx.x & 63, vw = __builtin_amdgcn_readfirstlane((int)threadIdx.x >> 6) & 3; cv_finish(C, lds, vw, lane); }
}
template <class RefFn>
__device__ __forceinline__ void phase(char* lds, int vcu, int G, int total, const RefFn& ref, const float* rcos, const float* rsin, const float* wgu, const float* wdn, unsigned char* dgu, unsigned char* ddn) {
    const int wid = __builtin_amdgcn_readfirstlane((int)threadIdx.x >> 6);
    Conv C0{}; C0.wgu = wgu; C0.wdn = wdn; C0.dgu = dgu; C0.ddn = ddn; C0.it = vcu * 4 + (wid & 3); C0.stride = G * 4; C0.tick = 0; C0.pend = 0;
    if (wid < 4) run<true>(lds, vcu, G, total, ref, rcos, rsin, C0); else run<false>(lds, vcu, G, total, ref, rcos, rsin, C0);
}
}
constexpr int NWAVES = 8;
#ifndef MK_PER_PHASE
#define MK_PER_PHASE 0
#endif
constexpr int NPHASE = 25;
constexpr int T = 32768, D = 1024, SEQ = 4096, NPROJ = 1792  , PROJ_LD = 768  , NEXP = 32, TOPK = 4;
constexpr int NASSIGN = T * TOPK, MAXBLK = 544, MAXROWS = MAXBLK * 256;
constexpr float LN_EPS = 1e-5f, RMS_EPS = 1e-6f, DN_ALPHA = 1.4142135623730951f;
constexpr float LAMBDA_INIT1 = 0.35550906759096927f;
constexpr size_t MiB = 1u << 20;
constexpr size_t WS_CTL = 0, CTL_ZERO_BYTES = 64 * 1024;
constexpr size_t WS_COS64 = 1 * MiB, WS_SIN64 = WS_COS64 + 512 * 1024, WS_COS128 = 2 * MiB, WS_SIN128 = 3 * MiB;
constexpr size_t WS_WIN = 4 * MiB, WS_WQU = 8 * MiB, WS_WKVU = 9 * MiB, WS_WO0 = 10 * MiB, WS_WR0 = 12 * MiB, WS_WQKV = 13 * MiB, WS_WO1 = 19 * MiB, WS_WR1 = 21 * MiB;
constexpr int TKR_OFF = 262144;
constexpr size_t WS_LOGIT = 22 * MiB, WS_TKE = 26 * MiB, WS_TKG = WS_TKE + 512 * 1024, WS_TKR = 27 * MiB, WS_TDEST = WS_TKR + 512 * 1024, WS_RGATE = 28 * MiB, WS_ROWTOK = WS_LOGIT  ;
constexpr size_t WS_VB = 224 * MiB;
constexpr size_t WS_XB = 32 * MiB, WS_WGU = 96 * MiB  , WS_WDN = 160 * MiB  , WS_X8 = 192 * MiB  , WS_OV = 288 * MiB;
constexpr size_t WS_XG = WS_OV, WS_ACT = WS_OV + 272 * MiB;
constexpr size_t WS_UG = WS_OV + 48 * MiB  , WS_PROJ = WS_OV, WS_QLN = WS_OV + 112 * MiB, WS_KVLN = WS_OV + 136 * MiB, WS_KROPE = WS_OV + 152 * MiB, WS_Q0 = WS_OV + 156 * MiB, WS_KV0 = WS_OV + 204 * MiB;
constexpr size_t WS_QKV = WS_OV, WS_O2 = WS_OV + 192 * MiB, WS_CAT = WS_OV + 332 * MiB;
constexpr size_t WS_END = WS_OV + 544 * MiB;
static_assert(WS_KV0 + 64 * MiB <= WS_CAT && WS_O2 + 128 * MiB <= WS_CAT && WS_CAT + 64 * MiB <= WS_END && WS_ACT + 272 * MiB <= WS_END, "d_ws map");
constexpr int CW_TMO = 0, CW_BAR = 4096, CW_CNT = 8192;
constexpr int RING_BYTES = 131072  , LDSCTL_OFF = 152576  , MISC_OFF = LDSCTL_OFF, MOE_OFF = LDSCTL_OFF + 256;
constexpr int LDS_BYTES = 155648;

#define GAS __attribute__((address_space(1)))
#define LAS __attribute__((address_space(3)))
typedef unsigned short bf16;
typedef unsigned v4u __attribute__((ext_vector_type(4)));
typedef unsigned v2u __attribute__((ext_vector_type(2)));
typedef float f32x4 __attribute__((ext_vector_type(4)));
typedef float f32x2 __attribute__((ext_vector_type(2)));
typedef GAS unsigned gu32;
#define RLX_AGENT __ATOMIC_RELAXED, __HIP_MEMORY_SCOPE_AGENT
#define LDS_WAIT() asm volatile("s_waitcnt lgkmcnt(0)" ::: "memory")
#define VM_WAIT() asm volatile("s_waitcnt vmcnt(0)" ::: "memory")
__device__ __forceinline__ unsigned pk2(float lo, float hi) { unsigned r; asm volatile("v_cvt_pk_bf16_f32 %0, %1, %2" : "=v"(r) : "v"(lo), "v"(hi)); return r; }
__device__ __forceinline__ float bflo(unsigned w) { return __uint_as_float(w << 16); }
__device__ __forceinline__ float bfhi(unsigned w) { return __uint_as_float(w & 0xffff0000u); }
__device__ __forceinline__ float sigmoidf_(float z) { return __builtin_amdgcn_rcpf(1.0f + __builtin_amdgcn_exp2f(-1.4426950408889634f * z)); }

#define XB_TMO      128
#define XB_XCNT(j)  (256  + 64 * (j))
#define XB_XSUB(j)  (1280 + 64 * (j))
#define XB_XGEN(j)  (2304 + 64 * (j))
#define XB_TOP      3328
#define XB_TOPGEN   3392
#define XCD_BAR_WORDS 3456
#define XB_SPIN_CAP (1u << 18)
__device__ __forceinline__ unsigned xb_ld(unsigned* p)              { return __hip_atomic_load(p, __ATOMIC_RELAXED, __HIP_MEMORY_SCOPE_AGENT); }
__device__ __forceinline__ unsigned xb_add(unsigned* p, unsigned v) { return __hip_atomic_fetch_add(p, v, __ATOMIC_RELAXED, __HIP_MEMORY_SCOPE_AGENT); }
__device__ __forceinline__ unsigned xb_xcc_id() { return (unsigned)__builtin_amdgcn_s_getreg((3 << 11) | 20) & 0xFu; }
#define XB_SPIN(cond, bar) do { unsigned _sp = 0; while (cond) { __builtin_amdgcn_s_sleep(1); \
    if ((++_sp & 255u) == 0u) { if (xb_ld(&(bar)[XB_TMO])) break; if (_sp > XB_SPIN_CAP) { atomicAdd(&(bar)[XB_TMO], 1u); break; } } } } while (0)
struct XcdBarrier { unsigned* bar; unsigned x; volatile LAS unsigned* st; };
__device__ __forceinline__ XcdBarrier xcd_barrier_post(unsigned* bar, volatile LAS unsigned* st) {
    XcdBarrier b; b.bar = bar; b.x = xb_xcc_id(); b.st = st;
    if (threadIdx.x == 0) (void)xb_add(&bar[XB_XCNT(b.x)], 1u);
    return b;
}
__device__ __forceinline__ void xcd_barrier_complete(unsigned* bar, unsigned x, unsigned& nloc, unsigned& nx) {
    const unsigned G = gridDim.x * gridDim.y * gridDim.z;
    unsigned sum, cnt, mine, sp = 0u;
    for (;;) {
        sum = 0u; cnt = 0u; mine = 0u;
#pragma unroll
        for (unsigned j = 0; j < 16; ++j) { const unsigned c = xb_ld(&bar[XB_XCNT(j)]); sum += c; cnt += (c > 0u) ? 1u : 0u; mine = (j == x) ? c : mine; }
        if (sum == G) break;
        __builtin_amdgcn_s_sleep(1);
        if ((++sp & 255u) == 0u) { if (xb_ld(&bar[XB_TMO])) break; if (sp > XB_SPIN_CAP) { atomicAdd(&bar[XB_TMO], 1u); break; } }
    }
    nloc = mine > 0u ? mine : 1u; nx = cnt > 0u ? cnt : 1u;
}
__device__ __forceinline__ void xcd_barrier(const XcdBarrier& b) {
    asm volatile("s_waitcnt vmcnt(0)" ::: "memory");
    __syncthreads();
    if (threadIdx.x == 0) {
        unsigned* bar = b.bar;
        __builtin_amdgcn_s_waitcnt(0);
        unsigned nloc = b.st[0], nx = b.st[1];
        if (nloc == 0u) { xcd_barrier_complete(bar, b.x, nloc, nx); b.st[0] = nloc; b.st[1] = nx; }
        const unsigned old = xb_add(&bar[XB_XSUB(b.x)], 1u);
        const unsigned gen = old / nloc;
        if (old + 1u == (gen + 1u) * nloc) {
            __builtin_amdgcn_fence(__ATOMIC_RELEASE, "agent");
            asm volatile("s_waitcnt vmcnt(0)" ::: "memory");
            const unsigned og = xb_add(&bar[XB_TOP], 1u);
            const unsigned tg = og / nx;
            if (og + 1u == (tg + 1u) * nx) xb_add(&bar[XB_TOPGEN], 1u);
            else XB_SPIN(xb_ld(&bar[XB_TOPGEN]) == tg, bar);
            __builtin_amdgcn_fence(__ATOMIC_ACQUIRE, "agent");
            xb_add(&bar[XB_XGEN(b.x)], 1u);
            asm volatile("s_waitcnt vmcnt(0)" ::: "memory");
        } else {
            XB_SPIN(xb_ld(&bar[XB_XGEN(b.x)]) == gen, bar);
            __builtin_amdgcn_fence(__ATOMIC_ACQUIRE, "agent");
            asm volatile("s_waitcnt vmcnt(0)" ::: "memory");
        }
    }
    __syncthreads();
}

struct Frame {
    LAS unsigned char* lds; gu32* ctl;
    int tid, lane, wave, vcu, G, gw, NGW;
};
__device__ __forceinline__ float wave_sum(float v) {
#define WS_DPP(x, ctrl, rmask) __int_as_float(__builtin_amdgcn_update_dpp(0, __float_as_int(x), ctrl, rmask, 0xF, false))
    v += WS_DPP(v, 0xB1, 0xF);
    v += WS_DPP(v, 0x4E, 0xF);
    v += WS_DPP(v, 0x124, 0xF);
    v += WS_DPP(v, 0x128, 0xF);
    v += WS_DPP(v, 0x142, 0xA);
    v += WS_DPP(v, 0x143, 0xC);
#undef WS_DPP
    return __int_as_float(__builtin_amdgcn_readlane(__float_as_int(v), 63));
}
__device__ __forceinline__ unsigned pk4_fp8(float a, float b, float c, float d) { return pg8::pk4_fp8(a, b, c, d); }
constexpr float XSC = 16.0f, WGU_SC = 256.0f, ACT_SC = 8.0f, WDN_SC = 512.0f, YSC = 64.0f, CAT_SC = 64.0f;
__device__ __forceinline__ void transpose_item(const float* W, int K, int N, bf16* WT, int k0, int n0, int dst_row, LAS float* scr, int lane) {
#pragma unroll 8
    for (int i = 0; i < 32; ++i) { const int kk = 2 * i + (lane >> 5); scr[kk * 33 + (lane & 31)] = W[(size_t)(k0 + kk) * N + n0 + (lane & 31)]; }
    LDS_WAIT(); asm volatile("" ::: "memory");
    const int c = lane & 7;
#pragma unroll
    for (int j = 0; j < 4; ++j) { const int n = (lane >> 3) + 8 * j; const LAS float* s = scr + (8 * c) * 33 + n;
        v4u o; o.x = pk2(s[0 * 33], s[1 * 33]); o.y = pk2(s[2 * 33], s[3 * 33]); o.z = pk2(s[4 * 33], s[5 * 33]); o.w = pk2(s[6 * 33], s[7 * 33]);
        *(GAS v4u*)(WT + (size_t)(dst_row + n) * K + k0 + 8 * c) = o; }
    LDS_WAIT(); asm volatile("" ::: "memory");
}
template <int MODE> __device__ __forceinline__ void convert_matrix(const Frame& F, const float* W, int K, int N, bf16* WT, int nexp) {
    LAS float* scr = (LAS float*)(F.lds + F.wave * 16384);
    const int nblk = N / 32, per = (K / 64) * nblk, total = per * nexp;
    for (int it = F.gw; it < total; it += F.NGW) {
        const int e = it / per, r = it - e * per, kb = r / nblk, nb = r - kb * nblk, n0 = 32 * nb;
        int dst = n0;
        if (MODE == 1) { const int up = n0 >= 1024, nn = n0 & 1023; dst = 256 * (nn >> 7) + 128 * up + (nn & 127); }
        if (MODE == 3 && n0 >= 704) { const int g = n0 >= 1216, cc = n0 - (g ? 1216 : 704); dst = 768 + 256 * (cc >> 7) + 128 * g + (cc & 127); }
        if (MODE == 2 && n0 < 2048) { const int qk = n0 & ~1023, cc = n0 & 1023, h8 = cc >> 7, d0 = cc & 127; dst = qk + (h8 >> 1) * 256 + (d0 >> 6) * 128 + (h8 & 1) * 64 + (d0 & 63); }
        transpose_item(W + (size_t)e * K * N, K, N, WT + (size_t)e * N * K, 64 * kb, n0, dst, scr, F.lane);
    }
}
__device__ __forceinline__ void transpose_item8(const float* W, int K, int N, unsigned char* WT, int k0, int n0, int dst_row, LAS float* scr, int lane, float scale) {
#pragma unroll 8
    for (int i = 0; i < 32; ++i) { const int kk = 2 * i + (lane >> 5); scr[kk * 33 + (lane & 31)] = W[(size_t)(k0 + kk) * N + n0 + (lane & 31)]; }
    LDS_WAIT(); asm volatile("" ::: "memory");
    const int c = lane & 3;
#pragma unroll
    for (int j = 0; j < 2; ++j) { const int n = (lane >> 2) + 16 * j; const LAS float* s = scr + (16 * c) * 33 + n;
        v4u o;
#pragma unroll
        for (int q = 0; q < 4; ++q) o[q] = pk4_fp8(s[(4 * q) * 33] * scale, s[(4 * q + 1) * 33] * scale, s[(4 * q + 2) * 33] * scale, s[(4 * q + 3) * 33] * scale);
        *(GAS v4u*)(WT + (size_t)(dst_row + n) * K + k0 + 16 * c) = o; }
    LDS_WAIT(); asm volatile("" ::: "memory");
}
template <int MODE> __device__ __forceinline__ void convert_matrix8(const Frame& F, const float* W, int K, int N, unsigned char* WT, int nexp, float scale) {
    LAS float* scr = (LAS float*)(F.lds + F.wave * 16384);
    const int nblk = N / 32, per = (K / 64) * nblk, total = per * nexp;
    for (int it = F.gw; it < total; it += F.NGW) {
        const int e = it / per, r = it - e * per, kb = r / nblk, nb = r - kb * nblk, n0 = 32 * nb;
        int dst = n0;
        if (MODE == 1) { const int up = n0 >= 1024, nn = n0 & 1023; dst = 256 * (nn >> 7) + 128 * up + (nn & 127); }
        if (MODE == 3 && n0 >= 704) { const int g = n0 >= 1216, cc = n0 - (g ? 1216 : 704); dst = 768 + 256 * (cc >> 7) + 128 * g + (cc & 127); }
        if (MODE == 2 && n0 < 2048) { const int qk = n0 & ~1023, cc = n0 & 1023, h8 = cc >> 7, d0 = cc & 127; dst = qk + (h8 >> 1) * 256 + (d0 >> 6) * 128 + (h8 & 1) * 64 + (d0 & 63); }
        transpose_item8(W + (size_t)e * K * N, K, N, WT + (size_t)e * N * K, 64 * kb, n0, dst, scr, F.lane, scale);
    }
}
__device__ __forceinline__ void zero_bytes16(const Frame& F, void* p, size_t bytes) {
    GAS v4u* q = (GAS v4u*)p; const size_t n = bytes / 16;
    for (size_t i = (size_t)F.vcu * 512 + F.tid; i < n; i += (size_t)F.G * 512) q[i] = (v4u){0u, 0u, 0u, 0u};
}
__device__ __forceinline__ void rope_tables(const Frame& F, float* cs, float* sn, int half  ) {
    const int n = SEQ * half;
    for (int i = F.vcu * 512 + F.tid; i < n; i += F.G * 512) {
        const int pos = i / half, f = i - pos * half;
        const float inv = __builtin_amdgcn_exp2f(-(float)f / (float)half * 13.287712379549449f);
        const float ang = (float)pos * inv;
        double rev = (double)ang * 0.15915494309189535; rev -= __builtin_floor(rev);
        const float rf = (float)rev;
        cs[i] = __builtin_amdgcn_cosf(rf); sn[i] = __builtin_amdgcn_sinf(rf);
    }
}
__device__ __forceinline__ void rows_to_bf16(const Frame& F, const float* x, bf16* xb, unsigned char* x8) {
    for (int m0 = F.gw * 4; m0 < T; m0 += F.NGW * 4) {
        f32x4 v[4][4];
#pragma unroll
        for (int r = 0; r < 4; ++r)
#pragma unroll
            for (int j = 0; j < 4; ++j) v[r][j] = *((const GAS f32x4*)(x + (size_t)(m0 + r) * D) + F.lane + 64 * j);
#pragma unroll
        for (int r = 0; r < 4; ++r)
#pragma unroll
            for (int j = 0; j < 4; ++j) { *((GAS v2u*)(xb + (size_t)(m0 + r) * D) + F.lane + 64 * j) = (v2u){pk2(v[r][j].x, v[r][j].y), pk2(v[r][j].z, v[r][j].w)};
                *((GAS unsigned*)(x8 + (size_t)(m0 + r) * D) + F.lane + 64 * j) = pk4_fp8(v[r][j].x * XSC, v[r][j].y * XSC, v[r][j].z * XSC, v[r][j].w * XSC); }
    }
}
constexpr int NRM = 8;
__device__ __forceinline__ void mid0_rows(const Frame& F, const bf16* proj, const float* qg, const float* kvg, const float* cs64, const float* sn64, bf16* qln, bf16* kvln, bf16* krope) {
    float gq[3][2], gk[2][2];
#pragma unroll
    for (int j = 0; j < 3; ++j) { const f32x2 g = *(const f32x2*)(qg + 2 * (F.lane + 64 * j)); gq[j][0] = g.x; gq[j][1] = g.y; }
#pragma unroll
    for (int j = 0; j < 2; ++j) { const f32x2 g = *(const f32x2*)(kvg + 2 * (F.lane + 64 * j)); gk[j][0] = g.x; gk[j][1] = g.y; }
    for (int t0 = F.gw * NRM; t0 < T; t0 += F.NGW * NRM) {
        unsigned w[NRM][3], v[NRM][2]; unsigned short kx[NRM]; float cc[NRM], sc[NRM];
#pragma unroll
        for (int r = 0; r < NRM; ++r) { const GAS unsigned* prow = (const GAS unsigned*)(proj + (size_t)(t0 + r) * PROJ_LD);
#pragma unroll
            for (int j = 0; j < 3; ++j) w[r][j] = prow[F.lane + 64 * j];
#pragma unroll
            for (int j = 0; j < 2; ++j) v[r][j] = prow[192 + F.lane + 64 * j];
            kx[r] = ((const GAS bf16*)prow)[640 + F.lane];
            const int pos = (t0 + r) & (SEQ - 1); cc[r] = cs64[pos * 32 + (F.lane & 31)]; sc[r] = sn64[pos * 32 + (F.lane & 31)]; }
#pragma unroll
        for (int r = 0; r < NRM; ++r) { const int t = t0 + r;
            float ss = 0.f;
#pragma unroll
            for (int j = 0; j < 3; ++j) { const float a = bflo(w[r][j]), b = bfhi(w[r][j]); ss += a * a + b * b; }
            float rstd = 1.0f / sqrtf(wave_sum(ss) * (1.0f / 384.0f) + RMS_EPS);
            GAS unsigned* qo = (GAS unsigned*)(qln + (size_t)t * 384);
#pragma unroll
            for (int j = 0; j < 3; ++j) qo[F.lane + 64 * j] = pk2(bflo(w[r][j]) * rstd * gq[j][0], bfhi(w[r][j]) * rstd * gq[j][1]);
            ss = 0.f;
#pragma unroll
            for (int j = 0; j < 2; ++j) { const float a = bflo(v[r][j]), b = bfhi(v[r][j]); ss += a * a + b * b; }
            rstd = 1.0f / sqrtf(wave_sum(ss) * (1.0f / 256.0f) + RMS_EPS);
            GAS unsigned* ko = (GAS unsigned*)(kvln + (size_t)t * 256);
#pragma unroll
            for (int j = 0; j < 2; ++j) ko[F.lane + 64 * j] = pk2(bflo(v[r][j]) * rstd * gk[j][0], bfhi(v[r][j]) * rstd * gk[j][1]);
            const float xk = __uint_as_float((unsigned)kx[r] << 16), xp = __shfl_xor(xk, 32);
            const float y = F.lane < 32 ? xk * cc[r] - xp * sc[r] : xk * cc[r] + xp * sc[r];
            ((GAS bf16*)krope)[(size_t)t * 64 + F.lane] = (bf16)(pk2(y, 0.f) & 0xffffu); }
    }
}
#ifndef NHB
#define NHB 1
#endif
__device__ __forceinline__ void conv_stage(const Frame& F, const bf16* ug, int tile, LAS unsigned char* B) {
    const int t0 = tile * 32, pos0 = t0 & (SEQ - 1);
    for (int rr = __builtin_amdgcn_readfirstlane(F.wave); rr < 62; rr += NWAVES) {
        if (pos0 - 30 + rr >= 0) __builtin_amdgcn_global_load_lds((const unsigned*)((const GAS unsigned char*)ug + (size_t)(t0 - 30 + rr) * 1024 + F.lane * 16), (LAS unsigned*)(B + rr * 1024), 16, 0, 0);
        else *(LAS v4u*)(B + rr * 1024 + F.lane * 16) = (v4u){0u, 0u, 0u, 0u};
    }
}
constexpr int CONV_U1 = 66560;
__device__ __forceinline__ void conv_prefetch(const Frame& F, const bf16* ug) { if (F.vcu < T / 32) conv_stage(F, ug, F.vcu, F.lds); }
__device__ __forceinline__ void conv_phase(const Frame& F, const bf16* proj, const float* cw, const float* cb, const float* lg, const float* lb, bf16* cat) {
    LAS float* part = (LAS float*)(F.lds + 65536);
    const int cp = F.tid & 255, th = F.tid >> 8;
    f32x2 wv2[31];
#pragma unroll
    for (int j = 0; j < 31; ++j) wv2[j] = *(const f32x2*)(cw + j * 512 + 2 * cp);
    const f32x2 bia = *(const f32x2*)(cb + 2 * cp), g2 = *(const f32x2*)(lg + 2 * cp), b2 = *(const f32x2*)(lb + 2 * cp);
    int it = 0;
    for (int tile = F.vcu; tile < T / 32; tile += F.G, ++it) {
        const int t0 = tile * 32;
        LAS unsigned char* U = F.lds + (it & 1) * CONV_U1;
        asm volatile("s_waitcnt vmcnt(0)" ::: "memory");
        __syncthreads();
        if (tile + F.G < T / 32) conv_stage(F, proj, tile + F.G, F.lds + ((it + 1) & 1) * CONV_U1);
        f32x2 acc[16];
#pragma unroll
        for (int i = 0; i < 16; ++i) acc[i] = bia;
#pragma unroll
        for (int r = 0; r < 46; ++r) {
            const unsigned uu = *(const LAS unsigned*)(U + (th * 16 + r) * 1024 + cp * 4); const f32x2 u2 = (f32x2){bflo(uu), bfhi(uu)};
#pragma unroll
            for (int i = 0; i < 16; ++i) { const int j = r - i; if (j >= 0 && j <= 30) acc[i] = __builtin_elementwise_fma(wv2[j], u2, acc[i]); }
        }
        {
            float rs[32];
#pragma unroll
            for (int i = 0; i < 16; ++i) { rs[2 * i] = acc[i].x + acc[i].y; rs[2 * i + 1] = acc[i].x * acc[i].x + acc[i].y * acc[i].y; }
#define WS_DPP(x, ctrl, rmask) __int_as_float(__builtin_amdgcn_update_dpp(0, __float_as_int(x), ctrl, rmask, 0xF, false))
#pragma unroll
            for (int k = 0; k < 32; ++k) rs[k] += __int_as_float(__builtin_amdgcn_mov_dpp(__float_as_int(rs[k]), 0xB1, 0xF, 0xF, true));
#pragma unroll
            for (int k = 0; k < 32; ++k) rs[k] += __int_as_float(__builtin_amdgcn_mov_dpp(__float_as_int(rs[k]), 0x4E, 0xF, 0xF, true));
#pragma unroll
            for (int k = 0; k < 32; ++k) rs[k] += __int_as_float(__builtin_amdgcn_mov_dpp(__float_as_int(rs[k]), 0x124, 0xF, 0xF, true));
#pragma unroll
            for (int k = 0; k < 32; ++k) rs[k] += __int_as_float(__builtin_amdgcn_mov_dpp(__float_as_int(rs[k]), 0x128, 0xF, 0xF, true));
#pragma unroll
            for (int k = 0; k < 32; ++k) rs[k] += WS_DPP(rs[k], 0x142, 0xA);
#pragma unroll
            for (int k = 0; k < 32; ++k) rs[k] += WS_DPP(rs[k], 0x143, 0xC);
#undef WS_DPP
            if (F.lane == 63) {
#pragma unroll
                for (int i = 0; i < 16; ++i) *(LAS f32x2*)(part + ((th * 16 + i) * 4 + (F.wave & 3)) * 2) = (f32x2){rs[2 * i], rs[2 * i + 1]}; }
        }
        __syncthreads();
        int cpo_ = cp; asm volatile("" : "+v"(cpo_));
        GAS unsigned char* const cbase_ = (GAS unsigned char*)cat + (size_t)(t0 + th * 16) * D + 512 + 2 * cpo_;
#pragma unroll
        for (int i = 0; i < 16; ++i) {
            const LAS f32x2* pp = (const LAS f32x2*)(part + (th * 16 + i) * 8);
            const f32x2 p0 = pp[0], p1 = pp[1], p2 = pp[2], p3 = pp[3];
            const float mean = ((p0.x + p1.x) + (p2.x + p3.x)) * (1.0f / 512.0f), ex2 = ((p0.y + p1.y) + (p2.y + p3.y)) * (1.0f / 512.0f);
            const float rstd = 1.0f / sqrtf(fmaxf(ex2 - mean * mean, 0.f) + LN_EPS);
            const float v0 = (acc[i].x - mean) * rstd * g2.x + b2.x, v1 = (acc[i].y - mean) * rstd * g2.y + b2.y;
            *(GAS unsigned short*)(cbase_ + (unsigned)(i * D)) = (unsigned short)__builtin_amdgcn_cvt_pk_fp8_f32(fminf(v0 * sigmoidf_(v0) * CAT_SC, 448.f), fminf(v1 * sigmoidf_(v1) * CAT_SC, 448.f), 0, false);
        }
    }
    __syncthreads();
}
__device__ __forceinline__ f32x4 bf4(v2u w) { f32x4 r; r.x = bflo(w.x); r.y = bfhi(w.x); r.z = bflo(w.y); r.w = bfhi(w.y); return r; }
__device__ __forceinline__ f32x4 fp8x4(unsigned w) { const f32x2 a = __builtin_amdgcn_cvt_pk_f32_fp8((int)w, false), b = __builtin_amdgcn_cvt_pk_f32_fp8((int)w, true); f32x4 r; r.x = a.x; r.y = a.y; r.z = b.x; r.w = b.y; return r; }
template <bool MOE_SUM, bool FINAL, int NRX = 0> __device__ __forceinline__ void ln_phase(const Frame& F, const bf16* vin, const float* g, const float* b, bf16* xb, unsigned char* x8, float* outf, const unsigned char* ys, const int* tok_dest, const float* tok_gate, int row_first = -1, int row_step = 0, int row_end = 0) {
    constexpr int NR = NRX ? NRX : (MOE_SUM ? 2 : 4);
    if (row_first < 0) { row_first = F.gw * NR; row_step = F.NGW * NR; row_end = T; }
    f32x4 gam[4], bet[4];
#pragma unroll
    for (int j = 0; j < 4; ++j) { gam[j] = *((const GAS f32x4*)g + F.lane + 64 * j); bet[j] = *((const GAS f32x4*)b + F.lane + 64 * j); }
    int nE[MOE_SUM ? NR : 1][4], nR[MOE_SUM ? NR : 1][4]; float nG[MOE_SUM ? NR : 1][4];
    if (MOE_SUM) {
#pragma unroll
        for (int r = 0; r < NR; ++r)
#pragma unroll
            for (int k = 0; k < 4; ++k) { const int a_ = 4 * (row_first + r) + k; nE[r][k] = tok_dest[a_]; nR[r][k] = tok_dest[a_ + TKR_OFF]; nG[r][k] = tok_gate[a_]; }
    }
    for (int t0 = row_first; t0 < row_end; t0 += row_step) {
        v2u vi[NR][4]; unsigned y4[MOE_SUM ? NR : 1][4][4]; float gt[MOE_SUM ? NR : 1][4];
        int cE[MOE_SUM ? NR : 1][4], cR[MOE_SUM ? NR : 1][4];
        if (MOE_SUM) {
            const int tn = (t0 + row_step < row_end) ? t0 + row_step : t0;
#pragma unroll
            for (int r = 0; r < NR; ++r)
#pragma unroll
                for (int k = 0; k < 4; ++k) { cE[r][k] = nE[r][k]; cR[r][k] = nR[r][k]; gt[r][k] = nG[r][k] * (1.0f / YSC);
                    const int a_ = 4 * (tn + r) + k; nE[r][k] = tok_dest[a_]; nR[r][k] = tok_dest[a_ + TKR_OFF]; nG[r][k] = tok_gate[a_]; }
        }
#pragma unroll
        for (int r = 0; r < NR; ++r) {
#pragma unroll
            for (int j = 0; j < 4; ++j) vi[r][j] = *((const GAS v2u*)(vin + (size_t)(t0 + r) * D) + F.lane + 64 * j);
            if (MOE_SUM) {
#pragma unroll
                for (int k = 0; k < 4; ++k) { const int d = ((const LAS int*)(F.lds + MOE_OFF))[cE[r][k]] + cR[r][k];
#pragma unroll
                    for (int j = 0; j < 4; ++j) y4[r][k][j] = *((const GAS unsigned*)(ys + (size_t)d * D) + F.lane + 64 * j); }
            }
        }
#pragma unroll
        for (int r = 0; r < NR; ++r) { const int t = t0 + r;
            f32x4 v[4];
#pragma unroll
            for (int j = 0; j < 4; ++j) v[j] = bf4(vi[r][j]);
            if (MOE_SUM) {
#pragma unroll
                for (int j = 0; j < 4; ++j) { v[j] = v[j] * DN_ALPHA;
#pragma unroll
                    for (int k = 0; k < 4; ++k) v[j] += fp8x4(y4[r][k][j]) * gt[r][k]; }
            }
            float s = 0.f;
#pragma unroll
            for (int j = 0; j < 4; ++j) s += (v[j].x + v[j].y) + (v[j].z + v[j].w);
            const float mean = wave_sum(s) * (1.f / D); float s2 = 0.f;
#pragma unroll
            for (int j = 0; j < 4; ++j) { v[j] = v[j] - mean; s2 += (v[j].x * v[j].x + v[j].y * v[j].y) + (v[j].z * v[j].z + v[j].w * v[j].w); }
            const float rstd = 1.f / sqrtf(wave_sum(s2) * (1.f / D) + LN_EPS);
#pragma unroll
            for (int j = 0; j < 4; ++j) { const f32x4 gg = gam[j], bb = bet[j];
                const f32x4 y = v[j] * rstd * gg + bb;
                if (FINAL) *((GAS f32x4*)(outf + (size_t)t * D) + F.lane + 64 * j) = y;
                else *((GAS v2u*)(xb + (size_t)t * D) + F.lane + 64 * j) = (v2u){pk2(y.x, y.y), pk2(y.z, y.w)};
                if (!FINAL) *((GAS unsigned*)(x8 + (size_t)t * D) + F.lane + 64 * j) = pk4_fp8(y.x * XSC, y.y * XSC, y.z * XSC, y.w * XSC); }
        }
    }
}
__device__ __forceinline__ void topk_phase(const Frame& F, const bf16* xb, const bf16* wrt, const float* rb, unsigned* cnt, int* tk_e, float* tk_g, int* tk_rank, int* row_tok, const bf16* vb = nullptr, const float* lng = nullptr, const float* lnb = nullptr, unsigned char* x8 = nullptr) {
    typedef short bf16x8 __attribute__((ext_vector_type(8)));
    LAS unsigned char* WL = F.lds;
    LAS float* lgt = (LAS float*)(F.lds + 67584);
    LAS int* se = (LAS int*)(F.lds + 86016); LAS float* sg = (LAS float*)(F.lds + 88064); LAS unsigned* hist = (LAS unsigned*)(F.lds + 90112); LAS unsigned* base = (LAS unsigned*)(F.lds + 90240);
    v4u wreg[8];
#pragma unroll
    for (int j = 0; j < 8; ++j) { const int i = F.tid + 512 * j, row = i >> 7, ch = i & 127; wreg[j] = *(const GAS v4u*)(wrt + (size_t)row * 1024 + ch * 8); }
    bool filled = false;
    const int fr = F.lane & 15, fq = F.lane >> 4;
    for (int ch = F.vcu; ch < T / 128; ch += F.G) {
        if (F.tid < 32) hist[F.tid] = 0u;
        if (vb != nullptr) { const int r0_ = ch * 128 + 16 * F.wave; ln_phase<false, false, 8>(F, vb, lng, lnb, const_cast<bf16*>(xb), x8, nullptr, nullptr, nullptr, nullptr, r0_, 8, r0_ + 16);
            asm volatile("s_waitcnt vmcnt(0)" ::: "memory"); __builtin_amdgcn_fence(__ATOMIC_ACQ_REL, "workgroup"); }
        if (!filled) { filled = true;
#pragma unroll
            for (int j = 0; j < 8; ++j) { const int i = F.tid + 512 * j, row = i >> 7, c16 = i & 127; *(LAS v4u*)(WL + row * 2064 + c16 * 16) = wreg[j]; }
            __syncthreads(); }
        {
            f32x4 acc0 = {0.f, 0.f, 0.f, 0.f}, acc1 = {0.f, 0.f, 0.f, 0.f};
            const bf16* arow = xb + (size_t)(ch * 128 + 16 * F.wave + fr) * D + fq * 8;
            const LAS unsigned char* b0p = WL + fr * 2064 + fq * 16; const LAS unsigned char* b1p = b0p + 16 * 2064;
#pragma unroll
            for (int k0 = 0; k0 < D; k0 += 32) {
                const bf16x8 a = *(const GAS bf16x8*)(arow + k0);
                const bf16x8 b0 = *(const LAS bf16x8*)(b0p + k0 * 2), b1 = *(const LAS bf16x8*)(b1p + k0 * 2);
                acc0 = __builtin_amdgcn_mfma_f32_16x16x32_bf16(b0, a, acc0, 0, 0, 0);
                acc1 = __builtin_amdgcn_mfma_f32_16x16x32_bf16(b1, a, acc1, 0, 0, 0);
            }
            const f32x4 bb0 = *(const GAS f32x4*)(rb + 4 * fq), bb1 = *(const GAS f32x4*)(rb + 16 + 4 * fq);
            LAS float* lp = lgt + (16 * F.wave + fr) * 33 + 4 * fq;
#pragma unroll
            for (int q = 0; q < 4; ++q) { lp[q] = acc0[q] + bb0[q]; lp[16 + q] = acc1[q] + bb1[q]; }
        }
        __syncthreads();
        if (F.tid < 128) {
            float v[32];
#pragma unroll
            for (int e = 0; e < 32; ++e) v[e] = lgt[F.tid * 33 + e];
            float tv[4]; int ti[4];
#pragma unroll
            for (int k = 0; k < 4; ++k) {
                float best = v[0]; int bi = 0;
#pragma unroll
                for (int e = 1; e < 32; ++e) if (v[e] > best) { best = v[e]; bi = e; }
                tv[k] = best; ti[k] = bi;
#pragma unroll
                for (int e = 0; e < 32; ++e) v[e] = (e == bi) ? -__builtin_inff() : v[e];
            }
            const float e1 = __expf(tv[1] - tv[0]), e2 = __expf(tv[2] - tv[0]), e3 = __expf(tv[3] - tv[0]), inv = 1.0f / (1.0f + e1 + e2 + e3);
            se[F.tid * 4 + 0] = ti[0]; se[F.tid * 4 + 1] = ti[1]; se[F.tid * 4 + 2] = ti[2]; se[F.tid * 4 + 3] = ti[3];
            sg[F.tid * 4 + 0] = inv; sg[F.tid * 4 + 1] = e1 * inv; sg[F.tid * 4 + 2] = e2 * inv; sg[F.tid * 4 + 3] = e3 * inv;
        }
        __syncthreads();
        const int e = se[F.tid]; const float gt = sg[F.tid];
        const unsigned lr = __hip_atomic_fetch_add(hist + e, 1u, __ATOMIC_RELAXED, __HIP_MEMORY_SCOPE_WORKGROUP);
        __syncthreads();
        if (F.tid < 32) base[F.tid] = __hip_atomic_fetch_add(cnt + F.tid, hist[F.tid], __ATOMIC_RELAXED, __HIP_MEMORY_SCOPE_AGENT);
        __syncthreads();
        const int a = ch * 512 + F.tid;
        tk_e[a] = e; tk_g[a] = gt; tk_rank[a] = (int)(base[e] + lr); row_tok[e * T + (int)(base[e] + lr)] = a >> 2;
        __syncthreads();
    }
}
__device__ __forceinline__ void moe_tables(const Frame& F, const unsigned* cnt) {
    LAS int* tb = (LAS int*)(F.lds + MOE_OFF);
    if (F.tid < 32) {
        const int pc = (((int)__hip_atomic_load(cnt + F.tid, RLX_AGENT) + 255) >> 8) << 8; int s = pc;
#pragma unroll
        for (int d = 1; d < 32; d <<= 1) { const int t = __shfl_up(s, d, 32); if (F.tid >= d) s += t; }
        tb[F.tid] = s - pc; if (F.tid == 31) { tb[32] = s; tb[33] = s >> 8; } }
    __syncthreads();
    for (int bk = F.tid; bk < MAXBLK; bk += 512) { const int r0 = bk << 8; int e = 0;
        for (int q = 1; q < NEXP; ++q) e += (tb[q] <= r0) ? 1 : 0;
        tb[64 + bk] = e; }
    __syncthreads();
}
__device__ __forceinline__ void gather_phase(const Frame& F, const unsigned char* x8, const int* tk_e, const int* tk_rank, unsigned char* xg, int* tok_dest) {
    const LAS int* tb = (const LAS int*)(F.lds + MOE_OFF);
    for (int a0 = F.gw * 64; a0 < NASSIGN; a0 += F.NGW * 64) {
        const int a = a0 + F.lane, dest = tb[tk_e[a]] + tk_rank[a];
        tok_dest[a] = dest;
        for (int i0 = 0; i0 < 64; i0 += 8) {
            v4u r[8];
#pragma unroll
            for (int i = 0; i < 8; ++i) r[i] = *((const GAS v4u*)(x8 + (size_t)((a0 + i0 + i) >> 2) * D) + F.lane);
#pragma unroll
            for (int i = 0; i < 8; ++i) { const int d = __builtin_amdgcn_readlane(dest, i0 + i); *((GAS v4u*)(xg + (size_t)d * D) + F.lane) = r[i]; }
        }
    }
}
__device__ __forceinline__ void index_phase(const Frame& F, const int* tk_e, const int* tk_rank, int* tok_dest, int* row_tok) {
    const LAS int* tb = (const LAS int*)(F.lds + MOE_OFF);
    for (int a = F.vcu * 512 + F.tid; a < NASSIGN; a += F.G * 512) { const int dest = tb[tk_e[a]] + tk_rank[a]; tok_dest[a] = dest; row_tok[dest] = a >> 2; }
}
__device__ __forceinline__ void ropek_phase(const Frame& F, bf16* qkv, const float* cs, const float* sn) {
    for (int t0 = F.gw * 2; t0 < T; t0 += F.NGW * 2) {
        unsigned short x1[2][8], x2[2][8]; float c[2], s[2];
#pragma unroll
        for (int r = 0; r < 2; ++r) { const int pos = (t0 + r) & (SEQ - 1); c[r] = cs[pos * 64 + F.lane]; s[r] = sn[pos * 64 + F.lane];
            const GAS bf16* kr = (const GAS bf16*)(qkv + (size_t)(t0 + r) * 3072 + 1024);
#pragma unroll
            for (int hh = 0; hh < 8; ++hh) { x1[r][hh] = kr[hh * 128 + F.lane]; x2[r][hh] = kr[hh * 128 + 64 + F.lane]; } }
#pragma unroll
        for (int r = 0; r < 2; ++r) { GAS bf16* kr = (GAS bf16*)(qkv + (size_t)(t0 + r) * 3072 + 1024);
#pragma unroll
            for (int hh = 0; hh < 8; ++hh) { const float a = __uint_as_float((unsigned)x1[r][hh] << 16), b = __uint_as_float((unsigned)x2[r][hh] << 16);
                kr[hh * 128 + F.lane] = (bf16)(pk2(a * c[r] - b * s[r], 0.f) & 0xffffu); kr[hh * 128 + 64 + F.lane] = (bf16)(pk2(b * c[r] + a * s[r], 0.f) & 0xffffu); } }
    }
}
__device__ __forceinline__ void comb_phase(const Frame& F, const bf16* o2, const float* lq1, const float* lk1, const float* lq2, const float* lk2, const float* sg, unsigned char* cat8) {
    const float d1 = wave_sum(lq1[F.lane] * lk1[F.lane] + lq1[64 + F.lane] * lk1[64 + F.lane]), d2 = wave_sum(lq2[F.lane] * lk2[F.lane] + lq2[64 + F.lane] * lk2[64 + F.lane]);
    const float lam = __expf(d1) - __expf(d2) + LAMBDA_INIT1;
    const f32x4 g4 = *((const GAS f32x4*)sg + F.lane);
    for (int t0 = F.gw * 2; t0 < T; t0 += F.NGW * 2) {
        v2u a[2][4], b[2][4];
#pragma unroll
        for (int r = 0; r < 2; ++r)
#pragma unroll
            for (int h = 0; h < 4; ++h) { a[r][h] = *((const GAS v2u*)(o2 + (size_t)(t0 + r) * 2048 + h * 512) + F.lane); b[r][h] = *((const GAS v2u*)(o2 + (size_t)(t0 + r) * 2048 + h * 512 + 256) + F.lane); }
#pragma unroll
        for (int r = 0; r < 2; ++r)
#pragma unroll
            for (int h = 0; h < 4; ++h) {
                f32x4 v; v.x = bflo(a[r][h].x) - lam * bflo(b[r][h].x); v.y = bfhi(a[r][h].x) - lam * bfhi(b[r][h].x); v.z = bflo(a[r][h].y) - lam * bflo(b[r][h].y); v.w = bfhi(a[r][h].y) - lam * bfhi(b[r][h].y);
                const float rstd = 1.0f / sqrtf(wave_sum((v.x * v.x + v.y * v.y) + (v.z * v.z + v.w * v.w)) * (1.0f / 256.0f) + RMS_EPS) * (1.0f - LAMBDA_INIT1);
                *((GAS unsigned*)(cat8 + (size_t)(t0 + r) * D + h * 256) + F.lane) = pk4_fp8(v.x * rstd * g4.x * CAT_SC, v.y * rstd * g4.y * CAT_SC, v.z * rstd * g4.z * CAT_SC, v.w * rstd * g4.w * CAT_SC);
            }
    }
}
typedef att::Cfg<192, 768, 1024, 1024, 1024, 8, 2, 72169> AttL0;
typedef att::Cfg<128, 3072, 3072, 3072, 2048, 0, 4, 88388> AttL1;
static_assert(AttL0::LDS_BYTES <= LDSCTL_OFF && att2::LDS_BYTES_CV <= LDSCTL_OFF && MOE_OFF + (64 + MAXBLK) * 4 <= LDS_BYTES, "LDS map");
struct Args { const float* in[38]; float* out; unsigned char* ws; int ph_lo, ph_hi, li, pad; };
__global__ void __launch_bounds__(NWAVES * 64, 2) mega_fwd(Args args) {
    extern __shared__ __attribute__((aligned(16))) unsigned char lds[];
    Frame F;
    F.lds = (LAS unsigned char*)lds;
    F.tid = threadIdx.x; F.lane = F.tid & 63; F.wave = __builtin_amdgcn_readfirstlane(F.tid >> 6);
    F.G = gridDim.x; { const int bx = blockIdx.x; F.vcu = (F.G % 8 == 0) ? (bx % 8) * (F.G / 8) + bx / 8 : bx; }
    F.gw = F.vcu * NWAVES + F.wave; F.NGW = F.G * NWAVES;
    unsigned char* ws = args.ws;
    F.ctl = (gu32*)(ws + WS_CTL);
    for (int u = F.tid; u < (LDS_BYTES - LDSCTL_OFF) / 4; u += NWAVES * 64) ((LAS unsigned*)(F.lds + LDSCTL_OFF))[u] = 0u;
    __syncthreads();
    XcdBarrier bar; bar.bar = (unsigned*)(F.ctl + CW_BAR); bar.x = 0; bar.st = nullptr;
    if (!MK_PER_PHASE) bar = xcd_barrier_post((unsigned*)(F.ctl + CW_BAR), (volatile LAS unsigned*)(F.lds + MISC_OFF) + 8);
#define GRID_BAR() do { if (!MK_PER_PHASE) xcd_barrier(bar); } while (0)
#define PH_BEGIN() do { F.tid = tid_opaque(); F.lane = F.tid & 63; } while (0)
    const int lo = args.ph_lo, hi = args.ph_hi;
#define IN(k) (lo <= (k) && (k) < hi)
#define BOTH(k) (IN(k) && IN((k) + 1))
    const float* x = args.in[0]; float* OUT = args.out; bf16* VB = (bf16*)(ws + WS_VB);
    bf16* WIN = (bf16*)(ws + WS_WIN); bf16* WQU = (bf16*)(ws + WS_WQU); bf16* WKVU = (bf16*)(ws + WS_WKVU); bf16* WO0 = (bf16*)(ws + WS_WO0); bf16* WR0 = (bf16*)(ws + WS_WR0);
    bf16* WQKV = (bf16*)(ws + WS_WQKV); bf16* WO1 = (bf16*)(ws + WS_WO1); bf16* WR1 = (bf16*)(ws + WS_WR1); unsigned char* WGU = ws + WS_WGU; unsigned char* WDN = ws + WS_WDN; unsigned char* X8 = ws + WS_X8;
    float* COS64 = (float*)(ws + WS_COS64); float* SIN64 = (float*)(ws + WS_SIN64); float* COS128 = (float*)(ws + WS_COS128); float* SIN128 = (float*)(ws + WS_SIN128);
    bf16* XB = (bf16*)(ws + WS_XB); bf16* PROJ = (bf16*)(ws + WS_PROJ); bf16* UG = (bf16*)(ws + WS_UG); bf16* QLN = (bf16*)(ws + WS_QLN); bf16* KVLN = (bf16*)(ws + WS_KVLN); bf16* KROPE = (bf16*)(ws + WS_KROPE);
    bf16* Q0 = (bf16*)(ws + WS_Q0); bf16* KV0 = (bf16*)(ws + WS_KV0); bf16* CAT = (bf16*)(ws + WS_CAT); bf16* QKV = (bf16*)(ws + WS_QKV); bf16* O2 = (bf16*)(ws + WS_O2);
    unsigned char* YS = ws + WS_XG + 136 * MiB; unsigned char* ACT = ws + WS_ACT;
    int* TKE = (int*)(ws + WS_TKE); float* TKG = (float*)(ws + WS_TKG); int* TKR = (int*)(ws + WS_TKR); int* TDEST = (int*)(ws + WS_TDEST); int* ROWTOK = (int*)(ws + WS_ROWTOK);
    const LAS int* tb = (const LAS int*)(F.lds + MOE_OFF);

    if (IN(0)) { PH_BEGIN();
        convert_matrix8<3>(F, args.in[1], 1024, 1728, (unsigned char*)WIN, 1, WGU_SC);  zero_bytes16(F, (unsigned char*)WIN + (size_t)704 * 1024, (size_t)64 * 1024);
        convert_matrix<0>(F, args.in[3], 384, 768, WQU, 1);
        convert_matrix<0>(F, args.in[5], 256, 1024, WKVU, 1);
        convert_matrix8<0>(F, args.in[10], 1024, 1024, (unsigned char*)WO0, 1, WDN_SC);
        convert_matrix<0>(F, args.in[13], 1024, 32, WR0, 1);
        convert_matrix8<2>(F, args.in[21], 1024, 3072, (unsigned char*)WQKV, 1, WGU_SC);
        convert_matrix8<0>(F, args.in[27], 1024, 1024, (unsigned char*)WO1, 1, WDN_SC);
        convert_matrix<0>(F, args.in[30], 1024, 32, WR1, 1);
        convert_matrix8<1>(F, args.in[15], 1024, 2048, WGU, NEXP, WGU_SC);
        convert_matrix8<0>(F, args.in[17], 1024, 1024, WDN, NEXP, WDN_SC);
        rows_to_bf16(F, x, XB, X8);
        rope_tables(F, COS64, SIN64, 32); rope_tables(F, COS128, SIN128, 64);
        if (BOTH(0)) GRID_BAR();
    }
    if (IN(1)) { PH_BEGIN();
        pg8::Gemm g{(const bf16*)X8, WIN, T, NPROJ, 512}; pg8::StaticOrder S; S.init(T, NPROJ, F.G, (int)blockIdx.x);
        pg8::EpiInProj E{PROJ, UG, 1.0f / (XSC * WGU_SC)};
        pg8::gemm_phase<pg8::EpiInProj, pg8::StaticOrder, true, true, true>(F.lds, g, S, E);
        if (BOTH(1)) GRID_BAR();
    }
    if (IN(2)) { PH_BEGIN();
        conv_prefetch(F, UG);
        mid0_rows(F, PROJ, args.in[2], args.in[4], COS64, SIN64, QLN, KVLN, KROPE);
        conv_phase(F, UG, args.in[6], args.in[7], args.in[8], args.in[9], CAT);
        if (BOTH(2)) GRID_BAR();
    }
    if (IN(3)) { PH_BEGIN();
        { pg8::Gemm g{QLN, WQU, T, 768, 384}; pg8::StaticOrder S; S.init(T, 768, F.G, (int)blockIdx.x); pg8::EpiBf16 E{Q0, 768, 1.0f};
          pg8::gemm_phase<pg8::EpiBf16, pg8::StaticOrder, true, true>(F.lds, g, S, E); }
        { pg8::Gemm g{KVLN, WKVU, T, 1024, 256}; pg8::StaticOrder S; S.init(T, 1024, F.G, (int)blockIdx.x); pg8::EpiBf16 E{KV0, 1024, 1.0f};
          pg8::gemm_phase<pg8::EpiBf16, pg8::StaticOrder, true, true>(F.lds, g, S, E); }
        if (BOTH(3)) GRID_BAR();
    }
    if (IN(4)) { PH_BEGIN();
        const bf16* q = Q0; const bf16* kv = KV0; const bf16* krp = KROPE; bf16* cat = CAT;
        auto ref = [=](int bh, int qb) { const int b = bh >> 2, h = bh & 3; const size_t rb = (size_t)b * SEQ, r0 = rb + (size_t)qb * 256;
            return att::BlockRef{q + r0 * 768 + h * 192, kv + rb * 1024 + h * 256, krp + rb * 64, kv + rb * 1024 + h * 256 + 128, (bf16*)((unsigned char*)cat + r0 * 1024 + h * 128)  , qb * 256}; };
        att::phase<AttL0>((char*)lds, F.vcu, F.G, 8 * 4 * 8, ref, COS64, SIN64);
        if (BOTH(4)) GRID_BAR();
    }
    if (IN(5)) { PH_BEGIN();
        pg8::Gemm g{CAT, WO0, T, D, D / 2}; pg8::StaticOrder S; S.init(T, D, F.G, (int)blockIdx.x); pg8::EpiResBf16 E{XB, VB, DN_ALPHA, 1.0f / (CAT_SC * WDN_SC)};
        pg8::gemm_phase<pg8::EpiResBf16, pg8::StaticOrder, true, true, true>(F.lds, g, S, E);
        if (BOTH(5)) GRID_BAR();
    }
    if (IN(8)) { PH_BEGIN(); topk_phase(F, XB, WR0, args.in[14], (unsigned*)(F.ctl + CW_CNT), TKE, TKG, TKR, ROWTOK, VB, args.in[11], args.in[12], X8); if (BOTH(8)) GRID_BAR(); }
    if (IN(10)) { PH_BEGIN();
        moe_tables(F, (const unsigned*)(F.ctl + CW_CNT));
        pg8::Gemm g{(const bf16*)X8, (const bf16*)WGU, MAXROWS, 2048, D / 2}; const pg8::GatherA GA{ROWTOK, (LAS int*)(F.lds + RING_BYTES), T - 1, tb, T}; pg8::MoeOrder S; S.init(tb[33], 8, F.G, (int)blockIdx.x, tb + 64); pg8::EpiSwiGLU E{ACT, args.in[16], 1.0f / (XSC * WGU_SC), ACT_SC, (LAS float*)(F.lds + RING_BYTES + 2048)};
        pg8::gemm_phase<pg8::EpiSwiGLU, pg8::MoeOrder, true, true, true, true>(F.lds, g, S, E, GA);
        if (BOTH(10)) GRID_BAR();
    }
    if (IN(11)) { PH_BEGIN();
        if (MK_PER_PHASE) moe_tables(F, (const unsigned*)(F.ctl + CW_CNT));
        pg8::Gemm g{(const bf16*)ACT, (const bf16*)WDN, MAXROWS, D, D / 2}; pg8::MoeOrder S; S.init(tb[33], 4, F.G, (int)blockIdx.x, tb + 64); pg8::EpiDown E{YS, args.in[18], 1.0f / (ACT_SC * WDN_SC), YSC, (LAS float*)(F.lds + RING_BYTES + 2048)};
        pg8::gemm_phase<pg8::EpiDown, pg8::MoeOrder, true, true, true>(F.lds, g, S, E);
        if (BOTH(11)) GRID_BAR();
    }
    if (IN(12)) { PH_BEGIN();
        if (MK_PER_PHASE) moe_tables(F, (const unsigned*)(F.ctl + CW_CNT));
        ln_phase<true, false>(F, XB, args.in[19], args.in[20], XB, X8, nullptr, YS, TKE, TKG);
        if (BOTH(12)) GRID_BAR();
    }
    if (IN(13)) { PH_BEGIN();
        pg8::Gemm g{(const bf16*)X8, WQKV, T, 3072, D / 2}; pg8::StaticOrder S; S.init(T, 3072, F.G, (int)blockIdx.x); pg8::EpiQKV E{QKV, COS128, SIN128, 1.0f / (XSC * WGU_SC), F.lds + RING_BYTES + 4096};
        pg8::gemm_phase<pg8::EpiQKV, pg8::StaticOrder, true, true, true>(F.lds, g, S, E);
        if (BOTH(13)) GRID_BAR();
    }
    if (IN(15)) { PH_BEGIN();
        const bf16* qkv = QKV; bf16* o2 = O2;
        auto ref = [=](int cb, int qb) { const int hm = cb & 7, b = cb >> 3; const size_t rb = (size_t)b * SEQ, r0 = rb + (size_t)qb * 128;
            return att2::BlockRef{qkv + r0 * 3072 + hm * 128, qkv + rb * 3072 + 1024 + hm * 128, qkv + rb * 3072 + 2048 + (hm >> 1) * 256, o2 + r0 * 2048 + hm * 256, qb * 128}; };
        att2::phase((char*)lds, F.vcu, F.G, 8 * 8 * 16, ref, COS128, SIN128, args.in[32], args.in[34], WGU, WDN);
        if (BOTH(15)) GRID_BAR();
    }
    if (IN(16)) { PH_BEGIN(); comb_phase(F, O2, args.in[22], args.in[23], args.in[24], args.in[25], args.in[26], (unsigned char*)CAT);     if (BOTH(16)) GRID_BAR(); }
    if (IN(17)) { PH_BEGIN();
        pg8::Gemm g{CAT, WO1, T, D, D / 2}; pg8::StaticOrder S; S.init(T, D, F.G, (int)blockIdx.x); pg8::EpiResBf16 E{XB, VB, DN_ALPHA, 1.0f / (CAT_SC * WDN_SC)};
        pg8::gemm_phase<pg8::EpiResBf16, pg8::StaticOrder, true, true, true>(F.lds, g, S, E);
        if (BOTH(17)) GRID_BAR();
    }
    if (IN(20)) { PH_BEGIN(); topk_phase(F, XB, WR1, args.in[31], (unsigned*)(F.ctl + CW_CNT + 64), TKE, TKG, TKR, ROWTOK, VB, args.in[28], args.in[29], X8); if (BOTH(20)) GRID_BAR(); }
    if (IN(22)) { PH_BEGIN();
        moe_tables(F, (const unsigned*)(F.ctl + CW_CNT + 64));
        pg8::Gemm g{(const bf16*)X8, (const bf16*)WGU, MAXROWS, 2048, D / 2}; const pg8::GatherA GA{ROWTOK, (LAS int*)(F.lds + RING_BYTES), T - 1, tb, T}; pg8::MoeOrder S; S.init(tb[33], 8, F.G, (int)blockIdx.x, tb + 64); pg8::EpiSwiGLU E{ACT, args.in[33], 1.0f / (XSC * WGU_SC), ACT_SC, (LAS float*)(F.lds + RING_BYTES + 2048)};
        pg8::gemm_phase<pg8::EpiSwiGLU, pg8::MoeOrder, true, true, true, true>(F.lds, g, S, E, GA);
        if (BOTH(22)) GRID_BAR();
    }
    if (IN(23)) { PH_BEGIN();
        if (MK_PER_PHASE) moe_tables(F, (const unsigned*)(F.ctl + CW_CNT + 64));
        pg8::Gemm g{(const bf16*)ACT, (const bf16*)WDN, MAXROWS, D, D / 2}; pg8::MoeOrder S; S.init(tb[33], 4, F.G, (int)blockIdx.x, tb + 64); pg8::EpiDown E{YS, args.in[35], 1.0f / (ACT_SC * WDN_SC), YSC, (LAS float*)(F.lds + RING_BYTES + 2048)};
        pg8::gemm_phase<pg8::EpiDown, pg8::MoeOrder, true, true, true>(F.lds, g, S, E);
        if (BOTH(23)) GRID_BAR();
    }
    if (IN(24)) { PH_BEGIN(); if (MK_PER_PHASE) moe_tables(F, (const unsigned*)(F.ctl + CW_CNT + 64)); ln_phase<true, true>(F, XB, args.in[36], args.in[37], nullptr, nullptr, OUT, YS, TKE, TKG); }
#undef IN
#undef BOTH
#undef GRID_BAR
}

extern "C" void kernel_launch(void* const* d_in, const int* in_sizes, int n_in, void* d_out, int out_size, void* d_ws, size_t ws_size, hipStream_t stream) {
    static int grid = 0;
    if (grid == 0) {
        if (n_in != 38 || in_sizes[0] != T * D || out_size != T * D || ws_size < WS_END) { fprintf(stderr, "kernel_launch: unexpected shapes (n_in %d, in0 %d, out %d, ws %zu < %zu)\n", n_in, n_in > 0 ? in_sizes[0] : -1, out_size, ws_size, (size_t)WS_END); grid = -1; return; }
        int dev = 0, cus = 0, per_cu = 0;
        if (hipGetDevice(&dev) != hipSuccess || hipDeviceGetAttribute(&cus, hipDeviceAttributeMultiprocessorCount, dev) != hipSuccess) { grid = -1; return; }
        if (hipFuncSetAttribute((const void*)mega_fwd, hipFuncAttributeMaxDynamicSharedMemorySize, LDS_BYTES) != hipSuccess) { fprintf(stderr, "kernel_launch: hipFuncSetAttribute failed\n"); grid = -1; return; }
        if (hipOccupancyMaxActiveBlocksPerMultiprocessor(&per_cu, (const void*)mega_fwd, NWAVES * 64, LDS_BYTES) != hipSuccess || per_cu < 1) { fprintf(stderr, "kernel_launch: occupancy query says %d\n", per_cu); }
        (void)hipGetLastError();
        grid = cus;
    }
    if (grid < 0) return;
    if (hipMemsetAsync((char*)d_ws + WS_CTL, 0, CTL_ZERO_BYTES, stream) != hipSuccess) return;
    Args a{};
    for (int i = 0; i < 38; ++i) a.in[i] = (const float*)d_in[i];
    a.out = (float*)d_out; a.ws = (unsigned char*)d_ws; a.li = 0; a.pad = 0;
#if MK_PER_PHASE
    for (int p = 0; p < NPHASE; ++p) { a.ph_lo = p; a.ph_hi = p + 1; hipLaunchKernelGGL(mega_fwd, dim3(grid), dim3(NWAVES * 64), LDS_BYTES, stream, a); }
#else
    a.ph_lo = 0; a.ph_hi = NPHASE;
    hipLaunchKernelGGL(mega_fwd, dim3(grid), dim3(NWAVES * 64), LDS_BYTES, stream, a);
#endif
}
```
